# Optimizing an MI355X kernel written in HIP

```python
import math
import jax, jax.numpy as jnp
from jax import lax
import numpy as np

D_MODEL = 2048
BATCH = 2
SEQ = 8192
DEPTH = 1

GRID_W = 64
CTX_LEN = 256
D_MIX = D_MODEL
GDN_HEADS = 8
GDN_DK = 128
GDN_DV = 128
GDN_QK = GDN_HEADS * GDN_DK
GDN_V = GDN_HEADS * GDN_DV
GDN_QKV = 2 * GDN_QK + GDN_V
GDN_CONV_W = 5
GDN_CHUNK = 64
N_DIR = 2
SC_WIDTH = D_MIX - GDN_V
SC_GROUPS = 8
SC_GROUP_DIM = SC_WIDTH // SC_GROUPS
SC_H_CH = (SC_GROUPS // 2) * SC_GROUP_DIM
SC_CONV_W = 3
GDN_IN_COLS = GDN_QKV + 2 * N_DIR * GDN_HEADS
D_IN = GDN_IN_COLS + GDN_V + 3 * SC_WIDTH
N_EXPERTS = 32
TOP_K = 4
D_EXPERT = D_MODEL
SWIGLU_LIMIT = 7.0
SWIGLU_ALPHA = 1.702
MOE_BLOCK = 256
LN_EPS = 1e-5
RMS_EPS = 1e-6
DEEPNORM_ALPHA = (2 * DEPTH) ** 0.25
DEEPNORM_BETA = (8 * DEPTH) ** -0.25

kernel_name = 'hybrid_gdn_shortconv_moe_deepnorm_dit'


def _layer_norm(x, g, b):
    xf = x.astype(jnp.float32)
    mu = jnp.mean(xf, axis=-1, keepdims=True)
    var = jnp.mean(jnp.square(xf - mu), axis=-1, keepdims=True)
    return ((xf - mu) * lax.rsqrt(var + LN_EPS) * g + b).astype(x.dtype)


def _l2norm(x):
    xf = x.astype(jnp.float32)
    return xf * lax.rsqrt(jnp.sum(xf * xf, axis=-1, keepdims=True) + 1e-6)


def _dwconv(u, w, axis):
    r = w.shape[0] // 2
    n = u.shape[axis]
    pad = [(0, 0)] * u.ndim
    pad[axis] = (r, r)
    up = jnp.pad(u, pad)
    out = lax.slice_in_dim(up, 0, n, axis=axis) * w[0]
    for i in range(1, w.shape[0]):
        out = out + lax.slice_in_dim(up, i, i + n, axis=axis) * w[i]
    return out


def _gdn_inputs(p, conv_w, a_log, dt_bias):
    b_, t_, _ = p.shape
    qkv = jax.nn.silu(_dwconv(p[..., :GDN_QKV], conv_w, axis=1))
    q = _l2norm(qkv[..., :GDN_QK].reshape(b_, t_, GDN_HEADS, GDN_DK)) * (GDN_DK ** -0.5)
    k = _l2norm(qkv[..., GDN_QK:2 * GDN_QK].reshape(b_, t_, GDN_HEADS, GDN_DK))
    v = qkv[..., 2 * GDN_QK:].reshape(b_, t_, GDN_HEADS, GDN_DV).astype(jnp.float32)
    ab = p[..., GDN_QKV:GDN_IN_COLS].astype(jnp.float32).reshape(b_, t_, 2, N_DIR, GDN_HEADS)
    g = -jnp.exp(a_log.astype(jnp.float32)) * jax.nn.softplus(ab[:, :, 0] + dt_bias.astype(jnp.float32))
    beta = jax.nn.sigmoid(ab[:, :, 1])
    return q, k, v, g, beta


def _gdn_chunked(q, k, v, g, beta, s0):
    b_, t_, h_, _ = q.shape
    n, cl = t_ // GDN_CHUNK, GDN_CHUNK

    def blocks(a):
        a = a.astype(jnp.float32).reshape((b_, n, cl, h_) + a.shape[3:])
        return jnp.moveaxis(a, 3, 1)

    q, k, v, g, beta = blocks(q), blocks(k), blocks(v), blocks(g), blocks(beta)
    gc = jnp.cumsum(g, axis=-1)
    lower_incl = jnp.tril(jnp.ones((cl, cl), dtype=bool))
    strict = jnp.tril(jnp.ones((cl, cl), dtype=bool), -1)
    diff = gc[..., :, None] - gc[..., None, :]
    decay = jnp.where(lower_incl, jnp.exp(jnp.where(lower_incl, diff, 0.0)), 0.0)
    k_beta = k * beta[..., None]
    v_beta = v * beta[..., None]
    a_mat = jnp.where(strict, jnp.einsum('bhnid,bhnjd->bhnij', k_beta, k) * decay, 0.0)
    eye = jnp.eye(cl, dtype=jnp.float32)
    t_mat = lax.linalg.triangular_solve(a_mat + eye, jnp.broadcast_to(eye, a_mat.shape),
                                        left_side=True, lower=True, unit_diagonal=True)
    u = jnp.einsum('bhnij,bhnjd->bhnid', t_mat, v_beta)
    w = jnp.einsum('bhnij,bhnjd->bhnid', t_mat, k_beta * jnp.exp(gc)[..., None])
    qk = jnp.einsum('bhnid,bhnjd->bhnij', q, k) * decay
    g_last = gc[..., -1]
    q_dec = q * jnp.exp(gc)[..., None]
    k_dec = k * jnp.exp(g_last[..., None] - gc)[..., None]
    xs = (jnp.moveaxis(q_dec, 2, 0), jnp.moveaxis(qk, 2, 0), jnp.moveaxis(u, 2, 0),
          jnp.moveaxis(w, 2, 0), jnp.moveaxis(k_dec, 2, 0), jnp.moveaxis(jnp.exp(g_last), 2, 0))

    def step(s, inp):
        q_i, qk_i, u_i, w_i, k_i, dl = inp
        v_new = u_i - jnp.einsum('bhck,bhkv->bhcv', w_i, s)
        o_i = jnp.einsum('bhck,bhkv->bhcv', q_i, s) + jnp.einsum('bhij,bhjv->bhiv', qk_i, v_new)
        s = s * dl[..., None, None] + jnp.einsum('bhck,bhcv->bhkv', k_i, v_new)
        return s, o_i

    s_fin, o = lax.scan(step, s0, xs)
    o = jnp.transpose(o, (1, 0, 3, 2, 4)).reshape(b_, t_, h_, o.shape[-1])
    return o, s_fin


def _flip(a, rev):
    return jnp.flip(a, axis=1) if rev else a


def _gdn_bidirectional(lat, ctx, ctx_out):
    ql, kl, vl, gl, bl = lat
    qc, kc, vc, gcx, bcx = ctx
    o_lat, o_ctx = None, None
    for d in range(N_DIR):
        rev = d == 1
        s0 = jnp.zeros((qc.shape[0], GDN_HEADS, GDN_DK, GDN_DV), jnp.float32)
        oc, s_ctx = _gdn_chunked(_flip(qc, rev), _flip(kc, rev), _flip(vc, rev),
                                 _flip(gcx[:, :, d], rev), _flip(bcx[:, :, d], rev), s0)
        ol, _ = _gdn_chunked(_flip(ql, rev), _flip(kl, rev), _flip(vl, rev),
                             _flip(gl[:, :, d], rev), _flip(bl[:, :, d], rev), s_ctx)
        ol = _flip(ol, rev)
        o_lat = ol if o_lat is None else o_lat + ol
        if ctx_out:
            oc = _flip(oc, rev)
            o_ctx = oc if o_ctx is None else o_ctx + oc
    return o_lat, o_ctx


def _gated_rmsnorm(o, z, w):
    of = o.astype(jnp.float32)
    of = of * lax.rsqrt(jnp.mean(of * of, axis=-1, keepdims=True) + RMS_EPS)
    return of * w * jax.nn.silu(z.astype(jnp.float32))


def _grid_short_conv(u, w, rows):
    b_, t_, ch = u.shape
    u = u.reshape(b_, rows, GRID_W, ch)
    uh = _dwconv(u[..., :SC_H_CH], w[:, :SC_H_CH], axis=2)
    uv = _dwconv(u[..., SC_H_CH:], w[:, SC_H_CH:], axis=1)
    return jnp.concatenate([uh, uv], axis=-1).reshape(b_, t_, ch)


def _seq_short_conv(u, w):
    return _dwconv(u, w, axis=1)


def _mixer_output(p, o, norm_w, conv_sc, w_out, sc_conv):
    b_, t_, _ = p.shape
    z = p[..., GDN_IN_COLS:GDN_IN_COLS + GDN_V].reshape(b_, t_, GDN_HEADS, GDN_DV)
    y_gdn = _gated_rmsnorm(o, z, norm_w).reshape(b_, t_, GDN_V).astype(p.dtype)
    s = GDN_IN_COLS + GDN_V
    sb = p[..., s:s + SC_WIDTH]
    sc = p[..., s + SC_WIDTH:s + 2 * SC_WIDTH]
    sx = p[..., s + 2 * SC_WIDTH:s + 3 * SC_WIDTH]
    y_sc = sb * sc_conv(sc * sx, conv_sc)
    return jnp.concatenate([y_gdn, y_sc], axis=-1) @ w_out


def _mixer(h_lat, h_ctx, rows, w_in, conv_qkv, a_log, dt_bias, norm_w, conv_sc, w_out, ctx_out):
    p_lat = h_lat @ w_in
    p_ctx = h_ctx @ w_in if ctx_out else h_ctx @ w_in[:, :GDN_IN_COLS]
    lat_in = _gdn_inputs(p_lat[..., :GDN_IN_COLS], conv_qkv, a_log, dt_bias)
    ctx_in = _gdn_inputs(p_ctx[..., :GDN_IN_COLS], conv_qkv, a_log, dt_bias)
    o_lat, o_ctx = _gdn_bidirectional(lat_in, ctx_in, ctx_out)
    y_lat = _mixer_output(p_lat, o_lat, norm_w, conv_sc, w_out,
                          lambda u, w: _grid_short_conv(u, w, rows))
    y_ctx = _mixer_output(p_ctx, o_ctx, norm_w, conv_sc, w_out, _seq_short_conv) if ctx_out else None
    return y_lat, y_ctx


def _clamped_swiglu(glu, lin):
    glu = jnp.minimum(glu, SWIGLU_LIMIT)
    lin = jnp.clip(lin, -SWIGLU_LIMIT, SWIGLU_LIMIT)
    return glu * jax.nn.sigmoid(SWIGLU_ALPHA * glu) * (lin + 1.0)


def _moe(t, w_router, b_router, w_gate, b_gate, w_up, b_up, w_down, b_down):
    n_tok, d_ = t.shape
    logits = (t @ w_router + b_router).astype(jnp.float32)
    top_logit, top_idx = lax.top_k(logits, TOP_K)
    gates = jax.nn.softmax(top_logit, axis=-1)
    nk = n_tok * TOP_K
    e_flat = top_idx.reshape(nk)
    tok_flat = jnp.arange(nk, dtype=jnp.int32) // TOP_K
    order = jnp.argsort(e_flat)
    e_s, tok_s, g_s = e_flat[order], tok_flat[order], gates.reshape(nk)[order]
    counts = jnp.bincount(e_flat, length=N_EXPERTS)
    starts = jnp.cumsum(counts) - counts
    padded = (counts + MOE_BLOCK - 1) // MOE_BLOCK * MOE_BLOCK
    pad_end = jnp.cumsum(padded)
    pad_start = pad_end - padded
    dest = pad_start[e_s] + jnp.arange(nk, dtype=jnp.int32) - starts[e_s]
    n_blk = (nk + MOE_BLOCK - 1) // MOE_BLOCK + N_EXPERTS
    row_tok = jnp.zeros((n_blk * MOE_BLOCK,), jnp.int32).at[dest].set(tok_s)
    row_gate = jnp.zeros((n_blk * MOE_BLOCK,), jnp.float32).at[dest].set(g_s)
    blk_exp = jnp.minimum(jnp.searchsorted(pad_end, jnp.arange(n_blk, dtype=jnp.int32) * MOE_BLOCK,
                                           side='right'), N_EXPERTS - 1)

    def expert_block(args):
        tok, e = args
        xb = t[tok]
        glu = xb @ w_gate[e] + b_gate[e]
        lin = xb @ w_up[e] + b_up[e]
        return _clamped_swiglu(glu, lin) @ w_down[e] + b_down[e]

    out = lax.map(expert_block, (row_tok.reshape(n_blk, MOE_BLOCK), blk_exp))
    out = out.reshape(-1, d_).astype(jnp.float32) * row_gate[:, None]
    return jax.ops.segment_sum(out, row_tok, num_segments=n_tok).astype(t.dtype)


def setup_inputs(seed: int = 0) -> dict:
    key = jax.random.key(seed)
    ks = jax.random.split(key, 32)
    f32 = jnp.float32

    def nrm(k, shape, s):
        return jax.random.normal(k, shape, f32) * s

    dt = jnp.exp(jax.random.uniform(ks[11], (DEPTH, N_DIR, GDN_HEADS), f32,
                                    math.log(1e-3), math.log(1e-1)))
    return {
        'x': nrm(ks[0], (BATCH, SEQ, D_MODEL), 1.0),
        'c': nrm(ks[1], (BATCH, D_MODEL), 1.0),
        'ctx': nrm(ks[2], (BATCH, CTX_LEN, D_MODEL), 1.0),
        'c_ctx': nrm(ks[3], (D_MODEL,), 1.0),
        'ln0_g': 1.0 + nrm(ks[4], (D_MODEL,), 0.1),
        'ln0_b': nrm(ks[5], (D_MODEL,), 0.02),
        'w_ada': nrm(ks[6], (DEPTH, D_MODEL, 6 * D_MODEL), 0.5 * D_MODEL ** -0.5),
        'b_ada': nrm(ks[7], (DEPTH, 6 * D_MODEL), 0.02),
        'w_in': nrm(ks[8], (DEPTH, D_MODEL, D_IN), D_MODEL ** -0.5),
        'conv_qkv': nrm(ks[9], (DEPTH, GDN_CONV_W, GDN_QKV), GDN_CONV_W ** -0.5),
        'A_log': jnp.log(jax.random.uniform(ks[10], (DEPTH, N_DIR, GDN_HEADS), f32, 1.0, 16.0)),
        'dt_bias': dt + jnp.log(-jnp.expm1(-dt)),
        'gdn_norm_w': 1.0 + nrm(ks[12], (DEPTH, GDN_DV), 0.1),
        'conv_sc': nrm(ks[13], (DEPTH, SC_CONV_W, SC_WIDTH), SC_CONV_W ** -0.5),
        'w_out': nrm(ks[14], (DEPTH, D_MIX, D_MODEL), DEEPNORM_BETA * D_MIX ** -0.5),
        'ln1_g': 1.0 + nrm(ks[15], (DEPTH, D_MODEL), 0.1),
        'ln1_b': nrm(ks[16], (DEPTH, D_MODEL), 0.02),
        'w_router': nrm(ks[17], (DEPTH, D_MODEL, N_EXPERTS), D_MODEL ** -0.5),
        'b_router': nrm(ks[18], (DEPTH, N_EXPERTS), 0.01),
        'w_gate': nrm(ks[19], (DEPTH, N_EXPERTS, D_MODEL, D_EXPERT), D_MODEL ** -0.5),
        'b_gate': nrm(ks[20], (DEPTH, N_EXPERTS, D_EXPERT), 0.02),
        'w_up': nrm(ks[21], (DEPTH, N_EXPERTS, D_MODEL, D_EXPERT), D_MODEL ** -0.5),
        'b_up': nrm(ks[22], (DEPTH, N_EXPERTS, D_EXPERT), 0.02),
        'w_down': nrm(ks[23], (DEPTH, N_EXPERTS, D_EXPERT, D_MODEL), DEEPNORM_BETA * D_EXPERT ** -0.5),
        'b_down': nrm(ks[24], (DEPTH, N_EXPERTS, D_MODEL), 0.02),
        'ln2_g': 1.0 + nrm(ks[25], (DEPTH, D_MODEL), 0.1),
        'ln2_b': nrm(ks[26], (DEPTH, D_MODEL), 0.02),
    }


def reference(x, c, ctx, c_ctx, ln0_g, ln0_b, w_ada, b_ada, w_in, conv_qkv, A_log, dt_bias,
              gdn_norm_w, conv_sc, w_out, ln1_g, ln1_b, w_router, b_router, w_gate, b_gate,
              w_up, b_up, w_down, b_down, ln2_g, ln2_b):
    b_, t_, d_ = x.shape
    rows = t_ // GRID_W
    h = _layer_norm(x, ln0_g, ln0_b)
    hc = _layer_norm(ctx, ln0_g, ln0_b)
    for l in range(DEPTH):
        ctx_out = l < DEPTH - 1
        mod = jax.nn.silu(c) @ w_ada[l] + b_ada[l]
        mod_c = jax.nn.silu(c_ctx) @ w_ada[l] + b_ada[l]
        sh1, sc1, gt1, sh2, sc2, gt2 = jnp.split(mod[:, None, :], 6, axis=-1)
        csh1, csc1, cgt1, csh2, csc2, cgt2 = jnp.split(mod_c, 6)
        y, yc = _mixer(h * (1.0 + sc1) + sh1, hc * (1.0 + csc1) + csh1, rows,
                       w_in[l], conv_qkv[l], A_log[l], dt_bias[l], gdn_norm_w[l],
                       conv_sc[l], w_out[l], ctx_out)
        h = _layer_norm(DEEPNORM_ALPHA * h + gt1 * y, ln1_g[l], ln1_b[l])
        u = h * (1.0 + sc2) + sh2
        if ctx_out:
            hc = _layer_norm(DEEPNORM_ALPHA * hc + cgt1 * yc, ln1_g[l], ln1_b[l])
            uc = hc * (1.0 + csc2) + csh2
            flat = jnp.concatenate([u.reshape(-1, d_), uc.reshape(-1, d_)], axis=0)
        else:
            flat = u.reshape(-1, d_)
        f = _moe(flat, w_router[l], b_router[l], w_gate[l], b_gate[l], w_up[l], b_up[l],
                 w_down[l], b_down[l])
        h = _layer_norm(DEEPNORM_ALPHA * h + gt2 * f[:b_ * t_].reshape(b_, t_, d_), ln2_g[l], ln2_b[l])
        if ctx_out:
            hc = _layer_norm(DEEPNORM_ALPHA * hc + cgt2 * f[b_ * t_:].reshape(b_, -1, d_),
                             ln2_g[l], ln2_b[l])
    return h
```

```cpp
#include <hip/hip_runtime.h>
#include <cstdio>
#include <cstdint>

#ifndef MK_N_LAUNCHES
#define MK_N_LAUNCHES 1
#endif

#define LAS __attribute__((address_space(3)))
#define GAS __attribute__((address_space(1)))
typedef unsigned short bf16_t;
typedef short bf16x8 __attribute__((ext_vector_type(8)));
typedef float f32x4 __attribute__((ext_vector_type(4)));
typedef float f32x2 __attribute__((ext_vector_type(2)));
typedef unsigned u32x4 __attribute__((ext_vector_type(4)));
typedef unsigned u32x2 __attribute__((ext_vector_type(2)));

constexpr int D = 2048, NBATCH = 2, SEQ = 8192, ML = NBATCH * SEQ, CTXL = 256, MC = NBATCH * CTXL, MTOT = ML + MC;
constexpr int NH = 8, DK = 128, GQK = 1024, GQKV = 3072, GIN = 3104, NIN = 7200, NINP = 7424;
constexpr int COL_A = 3072, COL_B = 3088, COL_Z = 3104, COL_SB = 4128, COL_SC = 5152, COL_SX = 6176;
constexpr int NE = 32, TOPK = 4, MAXROWS = ML * TOPK + NE * 256, MAXTILES = MAXROWS / 256;
constexpr float LN_EPS = 1e-5f, RMS_EPS = 1e-6f;
constexpr float DN_ALPHA = 1.189207115002721f;
constexpr int NPART = 8;

constexpr size_t MiB = 1ull << 20;
constexpr size_t WS_CTL = 0, CTL_BYTES = 64 * 1024;
constexpr size_t WS_MODP = 1 * MiB;
constexpr size_t WS_MODF = 3 * MiB;
constexpr size_t WS_STAT0 = 4 * MiB;
constexpr size_t WS_STAT1 = 4 * MiB + 512 * 1024;
constexpr size_t WS_TOKE = 5 * MiB;
constexpr size_t WS_TOKP = WS_TOKE + 256 * 1024;
constexpr size_t WS_TOKG = WS_TOKP + 256 * 1024;
constexpr size_t WS_LIST = 6 * MiB;
constexpr size_t WS_WIN = 8 * MiB;
constexpr size_t WS_WOUT = 38 * MiB;
constexpr size_t WS_WG = 48 * MiB, WS_WU = 304 * MiB, WS_WD = 560 * MiB;
constexpr size_t WS_HM = 816 * MiB;
constexpr size_t WS_P = 882 * MiB;
constexpr size_t WS_PREP = 1122 * MiB;
constexpr size_t WS_OGB = 1424 * MiB;
constexpr size_t WS_Y = 1488 * MiB;
constexpr size_t WS_V = 1552 * MiB;
constexpr size_t WS_H1B = 1616 * MiB;
constexpr size_t WS_U = 1680 * MiB;
constexpr size_t WS_H = 882 * MiB;
constexpr size_t WS_O = 1170 * MiB;
constexpr size_t WS_END = 1744 * MiB;
constexpr size_t WS_QKVB = WS_V;
constexpr size_t WS_GBF = WS_U;
#ifdef GDN_NAIVE
constexpr size_t WS_QKV = 1744 * MiB;
constexpr size_t WS_GB = 1942 * MiB;
constexpr size_t WS_OG = 1946 * MiB;
#endif
constexpr int NCHUNK = (CTXL + SEQ) / 64, NUNITS = NBATCH * NCHUNK * NH * 2;
constexpr int UNIT_BYTES = 74752, UO_NW = 0, UO_QD = 16384, UO_KDT = 32768, UO_QK = 49152, UO_U = 57344, UO_DL = 73728, UNIT_DMA = 74752;
static_assert(WS_WIN + (size_t)NINP * D * 2 <= WS_WOUT && WS_P + (size_t)MTOT * NINP * 2 <= WS_PREP && WS_PREP + (size_t)NUNITS * UNIT_BYTES <= WS_OGB, "ws map");
static_assert(WS_H + (size_t)MAXROWS * D * 2 <= WS_O && WS_O + (size_t)MAXROWS * D * 2 <= WS_Y && WS_OGB + (size_t)2 * ML * 1024 * 2 <= WS_Y, "ws map 2");
constexpr int CW_CNT = 1024;
constexpr int CW_BAR = 8192;

constexpr int LDS_BYTES = 155648;
constexpr int MISC_OFF = 155136;
constexpr int GTAB_OFF = 131072, GTAB_UNITS = 18;
constexpr int TAB_OFF = 151552;

__device__ __forceinline__ unsigned cvt_pk_bf16(float lo, float hi) { unsigned r; asm volatile("v_cvt_pk_bf16_f32 %0, %1, %2" : "=v"(r) : "v"(lo), "v"(hi)); return r; }
__device__ __forceinline__ float bf_lo(unsigned w) { return __uint_as_float(w << 16); }
__device__ __forceinline__ float bf_hi(unsigned w) { return __uint_as_float(w & 0xffff0000u); }
__device__ __forceinline__ float bf2f(bf16_t b) { return __uint_as_float(((unsigned)b) << 16); }
__device__ __forceinline__ float silu_f(float x) { return x * __builtin_amdgcn_rcpf(1.0f + __expf(-x)); }
__device__ __forceinline__ float sigmoid_f(float x) { return __builtin_amdgcn_rcpf(1.0f + __expf(-x)); }
__device__ __forceinline__ float softplus_f(float x) { return x > 20.f ? x : log1pf(__expf(x)); }
__device__ __forceinline__ float wave_sum(float v) {
#pragma unroll
    for (int o = 1; o < 64; o <<= 1) v += __shfl_xor(v, o);
    return v;
}
typedef int i32x8 __attribute__((ext_vector_type(8)));
typedef int i32x4 __attribute__((ext_vector_type(4)));
__device__ __forceinline__ unsigned pk_fp8x4(float a, float b, float c, float d) { int w = __builtin_amdgcn_cvt_pk_fp8_f32(a, b, 0, false); w = __builtin_amdgcn_cvt_pk_fp8_f32(c, d, w, true); return (unsigned)w; }
constexpr float W8_SCALE = 64.f, H8_SCALE = 8.f, O8_SCALE = 16.f;
#define LDS_WAIT() asm volatile("s_waitcnt lgkmcnt(0)" ::: "memory")
#define VM_WAIT() asm volatile("s_waitcnt vmcnt(0)" ::: "memory")

#define XB_TMO      128
#define XB_XCNT(j)  (256  + 64 * (j))
#define XB_XSUB(j)  (1280 + 64 * (j))
#define XB_XGEN(j)  (2304 + 64 * (j))
#define XB_TOP      3328
#define XB_TOPGEN   3392
#define XCD_BAR_WORDS 3456
#define XB_SPIN_CAP (1u << 22)

__device__ __forceinline__ unsigned xb_ld(unsigned* p)              { return __hip_atomic_load(p, __ATOMIC_RELAXED, __HIP_MEMORY_SCOPE_AGENT); }
__device__ __forceinline__ unsigned xb_add(unsigned* p, unsigned v) { return __hip_atomic_fetch_add(p, v, __ATOMIC_RELAXED, __HIP_MEMORY_SCOPE_AGENT); }
__device__ __forceinline__ unsigned xb_xcc_id() { return (unsigned)__builtin_amdgcn_s_getreg((3 << 11) | 20) & 0xFu; }
#define XB_SPIN(cond, bar) do { unsigned _sp = 0; while (cond) { __builtin_amdgcn_s_sleep(1); \
    if ((++_sp & 255u) == 0u) { if (xb_ld(&(bar)[XB_TMO])) break; if (_sp > XB_SPIN_CAP) { atomicAdd(&(bar)[XB_TMO], 1u); break; } } } } while (0)

struct XcdBarrier { unsigned* bar; unsigned x; volatile LAS unsigned* st; };

__device__ __forceinline__ XcdBarrier xcd_barrier_post(unsigned* bar, volatile LAS unsigned* st) {
    XcdBarrier b; b.bar = bar; b.x = xb_xcc_id(); b.st = st;
    if (threadIdx.x == 0) (void)xb_add(&bar[XB_XCNT(b.x)], 1u);
    return b;
}
__device__ __forceinline__ void xcd_barrier_complete(unsigned* bar, unsigned x, unsigned& nloc, unsigned& nx) {
    const unsigned G = gridDim.x * gridDim.y * gridDim.z;
    unsigned sum, cnt, mine, sp = 0u;
    for (;;) {
        sum = 0u; cnt = 0u; mine = 0u;
#pragma unroll
        for (unsigned j = 0; j < 16; ++j) { const unsigned c = xb_ld(&bar[XB_XCNT(j)]); sum += c; cnt += (c > 0u) ? 1u : 0u; mine = (j == x) ? c : mine; }
        if (sum == G) break;
        __builtin_amdgcn_s_sleep(1);
        if ((++sp & 255u) == 0u) { if (xb_ld(&bar[XB_TMO])) break; if (sp > XB_SPIN_CAP) { atomicAdd(&bar[XB_TMO], 1u); break; } }
    }
    nloc = mine > 0u ? mine : 1u; nx = cnt > 0u ? cnt : 1u;
}
__device__ __forceinline__ void xcd_barrier(const XcdBarrier& b) {
    asm volatile("s_waitcnt vmcnt(0)" ::: "memory");
    __syncthreads();
    if (threadIdx.x == 0) {
        unsigned* bar = b.bar;
        __builtin_amdgcn_s_waitcnt(0);
        unsigned nloc = b.st[0], nx = b.st[1];
        if (nloc == 0u) { xcd_barrier_complete(bar, b.x, nloc, nx); b.st[0] = nloc; b.st[1] = nx; }
        const unsigned old = xb_add(&bar[XB_XSUB(b.x)], 1u);
        const unsigned gen = old / nloc;
        if (old + 1u == (gen + 1u) * nloc) {
            __builtin_amdgcn_fence(__ATOMIC_RELEASE, "agent");
            asm volatile("s_waitcnt vmcnt(0)" ::: "memory");
            const unsigned og = xb_add(&bar[XB_TOP], 1u);
            const unsigned tg = og / nx;
            if (og + 1u == (tg + 1u) * nx) xb_add(&bar[XB_TOPGEN], 1u);
            else XB_SPIN(xb_ld(&bar[XB_TOPGEN]) == tg, bar);
            __builtin_amdgcn_fence(__ATOMIC_ACQUIRE, "agent");
            xb_add(&bar[XB_XGEN(b.x)], 1u);
            asm volatile("s_waitcnt vmcnt(0)" ::: "memory");
        } else {
            XB_SPIN(xb_ld(&bar[XB_XGEN(b.x)]) == gen, bar);
            __builtin_amdgcn_fence(__ATOMIC_ACQUIRE, "agent");
            asm volatile("s_waitcnt vmcnt(0)" ::: "memory");
        }
    }
    __syncthreads();
}

struct Args { const float* in[27]; float* out; unsigned char* ws; int ph_lo, ph_hi, li, pad; };
enum { I_X = 0, I_C, I_CTX, I_CCTX, I_LN0G, I_LN0B, I_WADA, I_BADA, I_WIN, I_CONVQKV, I_ALOG, I_DTB, I_GNW, I_CONVSC, I_WOUT, I_LN1G, I_LN1B, I_WR, I_BR,
       I_WGATE, I_BGATE, I_WUP, I_BUP, I_WDOWN, I_BDOWN, I_LN2G, I_LN2B };

namespace pg8 {
constexpr int BM = 256, BK = 64, HALF = 128, HTB = HALF * BK * 2, STAGE_BYTES = 8 * HTB, NXCD = 8, WGM = 8;
__host__ __device__ __forceinline__ int lds_byte(int r, int c) { const int st = (r >> 4) * 2 + (c >> 5), rr = r & 15, cc = c & 31, ob = rr * 64 + cc * 2; return st * 1024 + (ob ^ (((ob >> 9) & 1) << 5)); }
__host__ __device__ __forceinline__ void stage_rc(int b, int& R, int& C) { const int st = b / 1024, sb = b % 1024, swz = sb ^ (((sb >> 9) & 1) << 5); R = (st >> 1) * 16 + swz / 64; C = (st & 1) * 32 + (swz % 64) / 2; }
__host__ __device__ __forceinline__ int perm32(int rho) { const int n = rho >> 4, i = rho & 15; return 8 * (i >> 2) + 4 * n + (i & 3); }

struct Unit { int pm, pn, e; };
__device__ __forceinline__ void tile_order(int L, int nM, int nN, int& pm, int& pn) {
    const int nwg = nM * nN; int wgid = L;
    { const int q = nwg / NXCD, r = nwg % NXCD, xcd = wgid % NXCD, off = wgid / NXCD; wgid = (xcd < r ? xcd * (q + 1) : r * (q + 1) + (xcd - r) * q) + off; }
    const int nig = WGM * nN, gid = wgid / nig, fm = gid * WGM, gsz = (nM - fm) < WGM ? (nM - fm) : WGM;
    pm = fm + ((wgid % nig) % gsz); pn = (wgid % nig) / gsz;
}

template <class P>
__device__ __forceinline__ void gemm_phase(LAS unsigned char* lds, const P& S) {
    int tid = threadIdx.x; asm volatile("" : "+v"(tid));
    const int wid = __builtin_amdgcn_readfirstlane(tid >> 6), lane = tid & 63, wr = wid >> 2, wc = wid & 3, fr = lane & 15, fq = lane >> 4;
    const int K = S.K, nt = K / BK;
    unsigned voffB[2]; int RA[2], CA[2];
#pragma unroll
    for (int i = 0; i < 2; ++i) { int R, C; stage_rc(tid * 16 + i * 8192, R, C); const int Rb = P::PERM ? ((R & ~31) + perm32(R & 31)) : R;
        RA[i] = R; CA[i] = C; if constexpr (P::BBLK) voffB[i] = (unsigned)((C >> 3) * S.NB + Rb) * 16u; else voffB[i] = (unsigned)(Rb * K + C) * 2u; }
    const size_t kstep = (size_t)(BK * 2);
    size_t kstepB = kstep; if constexpr (P::BBLK) kstepB = (size_t)128 * (size_t)S.NB;
    const unsigned ldsw = (unsigned)wid * 1024u;
    const int aoff = lds_byte(wr * 64 + fr, fq * 8), boff = lds_byte(wc * 32 + fr, fq * 8);
#define PG8_SA(b, h) (((b) * 2 + (h)) * HTB)
#define PG8_SB(b, h) ((4 + (b) * 2 + (h)) * HTB)
#define PG8_STAGE_B(bufoff, gbase) do { _Pragma("unroll") for (int _i = 0; _i < 2; ++_i) \
        __builtin_amdgcn_global_load_lds((const unsigned*)((const char*)(gbase) + voffB[_i]), (LAS unsigned*)(lds + (bufoff) + ldsw + _i * 8192), 16, 0, 0); } while (0)
#define PG8_STAGE_A(bufoff, AO, h, kb) do { _Pragma("unroll") for (int _i = 0; _i < 2; ++_i) \
        __builtin_amdgcn_global_load_lds((const unsigned*)(S.A + (size_t)(AO)[h][_i] + (size_t)(kb)), (LAS unsigned*)(lds + (bufoff) + ldsw + _i * 8192), 16, 0, 0); } while (0)
#define PG8_LDA(dst, b, h) do { _Pragma("unroll") for (int m = 0; m < 4; ++m) { dst[m].lo = *(const LAS i32x4*)(lds + PG8_SA(b, h) + aoff + m * 2048); dst[m].hi = *(const LAS i32x4*)(lds + PG8_SA(b, h) + aoff + m * 2048 + 1024); } } while (0)
#define PG8_LDB(dst, b, h) do { _Pragma("unroll") for (int n = 0; n < 2; ++n) { dst[n].lo = *(const LAS i32x4*)(lds + PG8_SB(b, h) + boff + n * 2048); dst[n].hi = *(const LAS i32x4*)(lds + PG8_SB(b, h) + boff + n * 2048 + 1024); } } while (0)
#define PG8_MMA(ai, bj, At, Bt) do { __builtin_amdgcn_s_setprio(1); \
        if constexpr (P::FP8) { _Pragma("unroll") for (int m = 0; m < 4; ++m) _Pragma("unroll") for (int n = 0; n < 2; ++n) \
            { FP8_MMA_ONE(acc[ai][bj][m][n], Bt[n], At[m]); } } \
        else { _Pragma("unroll") for (int m = 0; m < 4; ++m) _Pragma("unroll") for (int n = 0; n < 2; ++n) { \
            const i32x4 _bl = __builtin_shufflevector(Bt[n], Bt[n], 0, 1, 2, 3), _bh = __builtin_shufflevector(Bt[n], Bt[n], 4, 5, 6, 7), _al = __builtin_shufflevector(At[m], At[m], 0, 1, 2, 3), _ah = __builtin_shufflevector(At[m], At[m], 4, 5, 6, 7); \
            acc[ai][bj][m][n] = __builtin_amdgcn_mfma_f32_16x16x32_bf16(__builtin_bit_cast(bf16x8, _bl), __builtin_bit_cast(bf16x8, _al), acc[ai][bj][m][n], 0, 0, 0); \
            acc[ai][bj][m][n] = __builtin_amdgcn_mfma_f32_16x16x32_bf16(__builtin_bit_cast(bf16x8, _bh), __builtin_bit_cast(bf16x8, _ah), acc[ai][bj][m][n], 0, 0, 0); } } \
        __builtin_amdgcn_s_setprio(0); } while (0)
typedef int i32x2 __attribute__((ext_vector_type(2)));
#ifdef FP8_LEGACY_MFMA
#define FP8_MMA_ONE(c, b8, a8) do { \
        const i32x2 _b0 = __builtin_shufflevector(b8, b8, 0, 1), _b1 = __builtin_shufflevector(b8, b8, 2, 3), _b2 = __builtin_shufflevector(b8, b8, 4, 5), _b3 = __builtin_shufflevector(b8, b8, 6, 7); \
        const i32x2 _a0 = __builtin_shufflevector(a8, a8, 0, 1), _a1 = __builtin_shufflevector(a8, a8, 2, 3), _a2 = __builtin_shufflevector(a8, a8, 4, 5), _a3 = __builtin_shufflevector(a8, a8, 6, 7); \
        asm volatile("s_nop 1\n\tv_mfma_f32_16x16x32_fp8_fp8 %0, %1, %2, %0\n\ts_nop 7\n\tv_mfma_f32_16x16x32_fp8_fp8 %0, %3, %4, %0\n\ts_nop 7\n\tv_mfma_f32_16x16x32_fp8_fp8 %0, %5, %6, %0\n\ts_nop 7\n\tv_mfma_f32_16x16x32_fp8_fp8 %0, %7, %8, %0" \
                     : "+v"(c) : "v"(_b0), "v"(_a0), "v"(_b1), "v"(_a1), "v"(_b2), "v"(_a2), "v"(_b3), "v"(_a3)); } while (0)
#else
#define FP8_MMA_ONE(c, b8, a8) asm volatile("v_mfma_f32_16x16x128_f8f6f4 %0, %1, %2, %0" : "+v"(c) : "v"(b8), "v"(a8))
#endif
#define PG8_WAIT_V(n) asm volatile("s_waitcnt vmcnt(" #n ")" ::: "memory")
#define PG8_WAIT_L(n) asm volatile("s_waitcnt lgkmcnt(" #n ")" ::: "memory")
#define PG8_BAR __builtin_amdgcn_s_barrier()
#define PG8_SCHED __builtin_amdgcn_sched_barrier(0)
#define PG8_AOFF(AO, u, ord) do { _Pragma("unroll") for (int _h = 0; _h < 2; ++_h) _Pragma("unroll") for (int _i = 0; _i < 2; ++_i) \
        (AO)[_h][_i] = (unsigned)((size_t)S.arow_i((ord), (u), _h * HALF + RA[_i]) * (size_t)K + (size_t)CA[_i]) * 2u; } while (0)
    Unit cur, nxt; int ui = 0;
    if (!S.next(0, cur)) return;
    f32x4 acc[2][2][4][2];
#pragma unroll
    for (int a = 0; a < 2; ++a)
#pragma unroll
        for (int b = 0; b < 2; ++b)
#pragma unroll
            for (int m = 0; m < 4; ++m)
#pragma unroll
                for (int n = 0; n < 2; ++n) acc[a][b][m][n] = (f32x4){0.f, 0.f, 0.f, 0.f};
    i32x8 At[4], B0[2], B1[2];
    unsigned ac[2][2], a2[2][2];
    PG8_AOFF(ac, cur, 0);
    const char* cB0 = S.bptr(cur, 0); const char* cB1 = S.bptr(cur, 1);
    PG8_STAGE_B(PG8_SB(0, 0), cB0); PG8_STAGE_A(PG8_SA(0, 0), ac, 0, 0); PG8_STAGE_B(PG8_SB(0, 1), cB1); PG8_STAGE_A(PG8_SA(0, 1), ac, 1, 0);
    if (wr == 1) PG8_BAR;
    PG8_WAIT_V(4); PG8_BAR;
    PG8_STAGE_B(PG8_SB(1, 0), cB0 + kstepB); PG8_STAGE_A(PG8_SA(1, 0), ac, 0, kstep); PG8_STAGE_B(PG8_SB(1, 1), cB1 + kstepB);
    PG8_WAIT_V(6); PG8_BAR;
    for (;;) {
        const bool has_next = S.next(ui + 1, nxt);
        const char* nB0 = has_next ? S.bptr(nxt, 0) : cB0; const char* nB1 = has_next ? S.bptr(nxt, 1) : cB1;
        typename P::Pre pre{};
        for (int t = 0; t < nt; t += 2) {
            const bool last = (t == nt - 2);
            if (last) pre = S.prefetch(cur, wr, wc, fr, fq);
            if (last && has_next) { PG8_AOFF(a2, nxt, ui + 1); } else {
#pragma unroll
                for (int _h = 0; _h < 2; ++_h)
#pragma unroll
                    for (int _i = 0; _i < 2; ++_i) a2[_h][_i] = last ? ac[_h][_i] : ac[_h][_i] + (unsigned)((t + 2) * (BK * 2)); }
            const size_t k1 = (size_t)(t + 1) * kstep;
            const char* b20 = last ? nB0 : cB0 + (size_t)(t + 2) * kstepB; const char* b21 = last ? nB1 : cB1 + (size_t)(t + 2) * kstepB;
            PG8_LDB(B0, 0, 0); PG8_SCHED; PG8_LDA(At, 0, 0); PG8_STAGE_A(PG8_SA(1, 1), ac, 1, k1);
            PG8_WAIT_L(8); PG8_BAR; PG8_WAIT_L(0); PG8_MMA(0, 0, At, B0); PG8_BAR; PG8_SCHED;
            PG8_LDB(B1, 0, 1); PG8_STAGE_B(PG8_SB(0, 0), b20);
            PG8_BAR; PG8_WAIT_L(0); PG8_MMA(0, 1, At, B1); PG8_BAR;
            PG8_LDA(At, 0, 1); PG8_STAGE_A(PG8_SA(0, 0), a2, 0, 0);
            PG8_BAR; PG8_WAIT_L(0); PG8_MMA(1, 0, At, B0); PG8_BAR; PG8_SCHED;
            PG8_STAGE_B(PG8_SB(0, 1), b21);
            PG8_WAIT_V(6); PG8_BAR; PG8_MMA(1, 1, At, B1); PG8_BAR;
            PG8_LDB(B0, 1, 0); PG8_SCHED; PG8_LDA(At, 1, 0); PG8_STAGE_A(PG8_SA(0, 1), a2, 1, 0);
            PG8_WAIT_L(8); PG8_BAR; PG8_WAIT_L(0); PG8_MMA(0, 0, At, B0); PG8_BAR; PG8_SCHED;
            PG8_LDB(B1, 1, 1); PG8_STAGE_B(PG8_SB(1, 0), b20 + kstepB);
            PG8_BAR; PG8_WAIT_L(0); PG8_MMA(0, 1, At, B1); PG8_BAR;
            PG8_LDA(At, 1, 1); PG8_STAGE_A(PG8_SA(1, 0), a2, 0, kstep);
            PG8_BAR; PG8_WAIT_L(0); PG8_MMA(1, 0, At, B0); PG8_BAR; PG8_SCHED;
            PG8_STAGE_B(PG8_SB(1, 1), b21 + kstepB);
            PG8_WAIT_V(6); PG8_BAR; PG8_MMA(1, 1, At, B1); PG8_BAR;
        }
        if constexpr (P::FP8) asm volatile("s_nop 15\n\ts_nop 15" ::: "memory");
        S.epi(acc, cur, wr, wc, fr, fq, pre);
        if (!has_next) break;
#pragma unroll
        for (int a = 0; a < 2; ++a)
#pragma unroll
            for (int b = 0; b < 2; ++b)
#pragma unroll
                for (int m = 0; m < 4; ++m)
#pragma unroll
                    for (int n = 0; n < 2; ++n) acc[a][b][m][n] = (f32x4){0.f, 0.f, 0.f, 0.f};
        cur = nxt; cB0 = nB0; cB1 = nB1; ++ui;
#pragma unroll
        for (int _h = 0; _h < 2; ++_h)
#pragma unroll
            for (int _i = 0; _i < 2; ++_i) ac[_h][_i] = a2[_h][_i];
    }
    PG8_WAIT_V(0);
    if (wr == 0) PG8_BAR;
    PG8_BAR;
#undef PG8_SA
#undef PG8_SB
#undef PG8_STAGE_A
#undef PG8_STAGE_B
#undef PG8_LDA
#undef PG8_LDB
#undef PG8_MMA
#undef PG8_WAIT_V
#undef PG8_WAIT_L
#undef PG8_BAR
#undef PG8_SCHED
#undef PG8_AOFF
}
}
using pg8::Unit;

struct Frame {
    LAS unsigned char* lds;
    volatile LAS unsigned* MISC;
    unsigned* ctl;
    unsigned char* ws;
    int tid, lane, wave, G, bid;
    const float* const* in;
    float* out;
};
#define WSP(T, off) ((T*)(F.ws + (off)))

__device__ __forceinline__ void transpose_load(const float* __restrict__ W, int N, int item, int lane, f32x4 (&v)[16]) {
    const int nblk = (N + 63) / 64, kb = item / nblk, nb = item % nblk, k0 = 64 * kb, n0 = 64 * nb;
    const int lk = lane >> 4, ln = (lane & 15) * 4; const bool ok = n0 + ln < N;
#pragma unroll
    for (int i = 0; i < 16; ++i) v[i] = ok ? *(const f32x4*)(W + (size_t)(k0 + 4 * i + lk) * N + n0 + ln) : (f32x4){0.f, 0.f, 0.f, 0.f};
}
__device__ __forceinline__ void transpose_finish(int K, int N, bf16_t* __restrict__ WT, int row_off, LAS float* scr, int item, int lane, const f32x4 (&v)[16]) {
    const int nblk = (N + 63) / 64, kb = item / nblk, nb = item % nblk, k0 = 64 * kb, n0 = 64 * nb;
    const int lk = lane >> 4, ln = (lane & 15) * 4;
#pragma unroll
    for (int i = 0; i < 16; ++i) { LAS float* d = scr + (4 * i + lk) * 65 + ln; d[0] = v[i].x; d[1] = v[i].y; d[2] = v[i].z; d[3] = v[i].w; }
    LDS_WAIT(); asm volatile("" ::: "memory");
    const int c = lane & 7;
#pragma unroll
    for (int j = 0; j < 8; ++j) { const int n = (lane >> 3) + 8 * j; const LAS float* s = scr + (8 * c) * 65 + n;
        if (n0 + n < N) { u32x4 o; o.x = cvt_pk_bf16(s[0 * 65], s[1 * 65]); o.y = cvt_pk_bf16(s[2 * 65], s[3 * 65]); o.z = cvt_pk_bf16(s[4 * 65], s[5 * 65]); o.w = cvt_pk_bf16(s[6 * 65], s[7 * 65]);
            *(u32x4*)(WT + (size_t)(row_off + n0 + n) * K + k0 + 8 * c) = o; } }
    LDS_WAIT(); asm volatile("" ::: "memory");
}
constexpr int TI_PER_MAT = (D / 64) * (D / 64);
constexpr int TI_WIN = (D / 64) * ((NIN + 63) / 64);
constexpr int TI_SMALL = TI_WIN + TI_PER_MAT;
constexpr int TI_EXP = 3 * NE * TI_PER_MAT;
#ifndef NCONV_SCAN
#define NCONV_SCAN 168
#endif
#ifndef NCONV_WG
#define NCONV_WG 20
#endif
#ifndef TI_EARLY_PCT
#define TI_EARLY_PCT 12
#endif
__host__ __device__ constexpr int ti_early(int G) { return (G > 2 * NCONV_WG) ? (TI_EXP / 100) * TI_EARLY_PCT : 0; }
__device__ __forceinline__ void transpose_small_load(Frame& F, int it, f32x4 (&v)[16]) {
    if (it < TI_WIN) transpose_load(F.in[I_WIN], NIN, it, F.lane, v); else transpose_load(F.in[I_WOUT], D, it - TI_WIN, F.lane, v);
}
__device__ __forceinline__ void transpose_small_finish(Frame& F, int it, LAS float* scr, const f32x4 (&v)[16]) {
    if (it < TI_WIN) transpose_finish(D, NIN, WSP(bf16_t, WS_WIN), 0, scr, it, F.lane, v); else transpose_finish(D, D, WSP(bf16_t, WS_WOUT), 0, scr, it - TI_WIN, F.lane, v);
}
__device__ __forceinline__ void convert_load(Frame& F, int it, f32x4 (&v)[16]) {
    const int mat = it / TI_PER_MAT, r = it % TI_PER_MAT, type = mat / NE, e = mat % NE, kb = r >> 3, n4 = (r & 7) * 256 + F.lane * 4;
    const float* src = F.in[type == 0 ? I_WGATE : (type == 1 ? I_WUP : I_WDOWN)] + (size_t)e * D * D + (size_t)(kb * 16) * D + n4;
#pragma unroll
    for (int i = 0; i < 16; ++i) v[i] = __builtin_nontemporal_load((const f32x4*)(src + (size_t)i * D));
}
__device__ __forceinline__ void convert_store(Frame& F, int it, const f32x4 (&v)[16]) {
    const int mat = it / TI_PER_MAT, r = it % TI_PER_MAT, type = mat / NE, e = mat % NE, kb = r >> 3, n4 = (r & 7) * 256 + F.lane * 4;
    unsigned char* dst = F.ws + (type == 0 ? WS_WG : (type == 1 ? WS_WU : WS_WD)) + (size_t)e * D * D + ((size_t)kb * D + n4) * 16;
#pragma unroll
    for (int nn = 0; nn < 4; ++nn)
        *(u32x4*)(dst + nn * 16) = (u32x4){pk_fp8x4(v[0][nn] * W8_SCALE, v[1][nn] * W8_SCALE, v[2][nn] * W8_SCALE, v[3][nn] * W8_SCALE), pk_fp8x4(v[4][nn] * W8_SCALE, v[5][nn] * W8_SCALE, v[6][nn] * W8_SCALE, v[7][nn] * W8_SCALE),
                                          pk_fp8x4(v[8][nn] * W8_SCALE, v[9][nn] * W8_SCALE, v[10][nn] * W8_SCALE, v[11][nn] * W8_SCALE), pk_fp8x4(v[12][nn] * W8_SCALE, v[13][nn] * W8_SCALE, v[14][nn] * W8_SCALE, v[15][nn] * W8_SCALE)};
}
__device__ __forceinline__ void convert_experts(Frame& F, int gw, int NGW, int it0, int it1) {
    f32x4 A[16], B[16];
    for (int it = it0 + gw; it < it1; it += 2 * NGW) {
        const int i2 = it + NGW; const bool h2 = i2 < it1;
        convert_load(F, it, A); convert_load(F, h2 ? i2 : it, B); __builtin_amdgcn_sched_barrier(0);
        convert_store(F, it, A);
        if (h2) convert_store(F, i2, B);
    }
}
__device__ __forceinline__ void p0_prologue(Frame& F) {
    LAS float* red = (LAS float*)F.lds;
    const float* c = F.in[I_C]; const float* cctx = F.in[I_CCTX]; const float* wada = F.in[I_WADA];
    float* modp = WSP(float, WS_MODP);
    const int gw = F.bid * 8 + F.wave, NGW = F.G * 8;
    f32x4 tc[16], tn[16];
    if (gw < TI_SMALL) transpose_small_load(F, gw, tc);
    for (int it = F.bid; it < NPART * 32; it += F.G) {
        const int kq = it / 32, cg = it % 32, kb = kq * 256 + F.wave * 32, col = cg * 384 + F.lane * 4, col2 = cg * 384 + 256 + (F.lane & 31) * 4; const bool ex = F.lane < 32;
        f32x4 a0 = {0.f, 0.f, 0.f, 0.f}, a1 = a0, a2 = a0, b0 = a0, b1 = a0, b2 = a0;
#pragma unroll 8
        for (int i = 0; i < 32; ++i) { const int k = kb + i; const f32x4 wv = *(const f32x4*)(wada + (size_t)k * (6 * D) + col); f32x4 wx = {0.f, 0.f, 0.f, 0.f}; if (ex) wx = *(const f32x4*)(wada + (size_t)k * (6 * D) + col2);
            const float s0 = silu_f(c[k]), s1 = silu_f(c[D + k]), s2 = silu_f(cctx[k]); a0 += wv * s0; a1 += wv * s1; a2 += wv * s2; b0 += wx * s0; b1 += wx * s1; b2 += wx * s2; }
        *(LAS f32x4*)(red + (F.wave * 3 + 0) * 384 + F.lane * 4) = a0; *(LAS f32x4*)(red + (F.wave * 3 + 1) * 384 + F.lane * 4) = a1; *(LAS f32x4*)(red + (F.wave * 3 + 2) * 384 + F.lane * 4) = a2;
        if (ex) { *(LAS f32x4*)(red + (F.wave * 3 + 0) * 384 + 256 + F.lane * 4) = b0; *(LAS f32x4*)(red + (F.wave * 3 + 1) * 384 + 256 + F.lane * 4) = b1; *(LAS f32x4*)(red + (F.wave * 3 + 2) * 384 + 256 + F.lane * 4) = b2; }
        __syncthreads();
        for (int idx = F.tid; idx < 3 * 384; idx += 512) { const int v = idx / 384, cc = idx % 384; float s = 0.f;
#pragma unroll
            for (int w = 0; w < 8; ++w) s += red[(w * 3 + v) * 384 + cc];
            modp[(size_t)(kq * 3 + v) * (6 * D) + cg * 384 + cc] = s; }
        __syncthreads();
    }
    LAS float* scr = (LAS float*)(F.lds + F.wave * (64 * 65 * 4));
    for (int it = gw; it < TI_SMALL; it += NGW) {
        if (it + NGW < TI_SMALL) transpose_small_load(F, it + NGW, tn);
        transpose_small_finish(F, it, scr, tc);
#pragma unroll
        for (int i = 0; i < 16; ++i) tc[i] = tn[i];
    }
}

__device__ __forceinline__ const float* row_src(Frame& F, int row) { return row < ML ? F.in[I_X] + (size_t)row * D : F.in[I_CTX] + (size_t)(row - ML) * D; }
__device__ __forceinline__ int row_vec(int row) { return row < SEQ ? 0 : (row < ML ? 1 : 2); }
__device__ __forceinline__ void p1_ln0(Frame& F) {
    const int rpw = (MTOT + F.G - 1) / F.G, r0 = F.bid * rpw, r1 = (r0 + rpw < MTOT) ? r0 + rpw : MTOT;
    const float* modp = WSP(const float, WS_MODP); const float* bada = F.in[I_BADA];
    LAS float* SC = (LAS float*)F.lds;
    LAS float* SH = SC + 3 * D;
    if (r0 < r1) {
        const int vlo = row_vec(r0), vhi = row_vec(r1 - 1);
        for (int v = vlo; v <= vhi; ++v)
            for (int d = F.tid; d < D; d += 512) { float sh = bada[d], sc = bada[D + d];
#pragma unroll
                for (int p = 0; p < NPART; ++p) { sh += modp[(size_t)(p * 3 + v) * (6 * D) + d]; sc += modp[(size_t)(p * 3 + v) * (6 * D) + D + d]; }
                const float g0 = F.in[I_LN0G][d], b0 = F.in[I_LN0B][d];
                SC[v * D + d] = g0 * (1.f + sc); SH[v * D + d] = b0 * (1.f + sc) + sh; }
    }
    __syncthreads();
    bf16_t* HM = WSP(bf16_t, WS_HM); f32x2* st = WSP(f32x2, WS_STAT0);
    f32x4 xn[8];
    if (r0 + F.wave < r1) { const f32x4* xr = (const f32x4*)row_src(F, r0 + F.wave) + F.lane;
#pragma unroll
        for (int j = 0; j < 8; ++j) xn[j] = xr[64 * j]; }
    for (int row = r0 + F.wave; row < r1; row += 8) {
        const int v = row_vec(row);
        f32x4 x[8]; float s = 0.f;
#pragma unroll
        for (int j = 0; j < 8; ++j) { x[j] = xn[j]; s += (x[j].x + x[j].y) + (x[j].z + x[j].w); }
        if (row + 8 < r1) { const f32x4* xr = (const f32x4*)row_src(F, row + 8) + F.lane;
#pragma unroll
            for (int j = 0; j < 8; ++j) xn[j] = xr[64 * j]; }
        const float mean = wave_sum(s) * (1.f / D); float s2 = 0.f;
#pragma unroll
        for (int j = 0; j < 8; ++j) { x[j] = x[j] - mean; s2 += (x[j].x * x[j].x + x[j].y * x[j].y) + (x[j].z * x[j].z + x[j].w * x[j].w); }
        const float rstd = 1.f / sqrtf(wave_sum(s2) * (1.f / D) + LN_EPS);
        if (F.lane == 0) st[row] = (f32x2){mean, rstd};
        u32x2* o = (u32x2*)(HM + (size_t)row * D) + F.lane;
#pragma unroll
        for (int j = 0; j < 8; ++j) { const int d = 4 * F.lane + 256 * j; const f32x4 a = *(const LAS f32x4*)(SC + v * D + d), b = *(const LAS f32x4*)(SH + v * D + d);
            const f32x4 y = x[j] * rstd * a + b; u32x2 w; w.x = cvt_pk_bf16(y.x, y.y); w.y = cvt_pk_bf16(y.z, y.w); o[64 * j] = w; }
    }
    float* modf = WSP(float, WS_MODF);
    for (int idx = F.bid * 512 + F.tid; idx < 3 * 6 * D; idx += F.G * 512) { const int v = idx / (6 * D), n = idx % (6 * D); float s = bada[n];
#pragma unroll
        for (int p = 0; p < NPART; ++p) s += modp[(size_t)(p * 3 + v) * (6 * D) + n];
        modf[idx] = s; }
}

struct NoPre {};
struct InProj {
    static constexpr bool PERM = true, GATHER = false, FP8 = false, BBLK = false; typedef NoPre Pre;
    __device__ __forceinline__ Pre prefetch(const Unit&, int, int, int, int) const { return Pre{}; }
    int K; const char* A; const char* Bt; bf16_t* P; int G, c;
    __device__ __forceinline__ bool next(int i, Unit& u) const {
        const int L = i * G + c; constexpr int NMAIN = (ML / 256) * (NINP / 256), NCTXT = (GIN + 255) / 256;
        if (L < NMAIN) { pg8::tile_order(L, ML / 256, NINP / 256, u.pm, u.pn); u.e = 0; return true; }
        const int j = L - NMAIN; if (j >= (MC / 256) * NCTXT) return false;
        u.pm = ML / 256 + j / NCTXT; u.pn = j % NCTXT; u.e = 0; return true;
    }
    __device__ __forceinline__ const char* bptr(const Unit& u, int half) const { return Bt + (size_t)(u.pn * 256 + half * 128) * K * 2; }
    __device__ __forceinline__ unsigned arow_i(int, const Unit& u, int r) const { return (unsigned)(u.pm * 256 + r); }
    __device__ __forceinline__ void epi(const f32x4 (&acc)[2][2][4][2], const Unit& u, int wr, int wc, int fr, int fq, const Pre&) const {
        const int row0 = u.pm * 256 + wr * 64 + fr, col0 = u.pn * 256 + wc * 32 + 8 * fq;
#pragma unroll
        for (int ai = 0; ai < 2; ++ai)
#pragma unroll
            for (int m = 0; m < 4; ++m) { bf16_t* rowp = P + (size_t)(row0 + ai * 128 + m * 16) * NINP + col0;
#pragma unroll
                for (int bj = 0; bj < 2; ++bj) { const f32x4 v0 = acc[ai][bj][m][0], v1 = acc[ai][bj][m][1];
                    u32x4 w; w.x = cvt_pk_bf16(v0[0], v0[1]); w.y = cvt_pk_bf16(v0[2], v0[3]); w.z = cvt_pk_bf16(v1[0], v1[1]); w.w = cvt_pk_bf16(v1[2], v1[3]);
                    *(u32x4*)(rowp + bj * 128) = w; } }
    }
};

typedef float f32x16 __attribute__((ext_vector_type(16)));
typedef __bf16 bf2_t __attribute__((ext_vector_type(2)));
__device__ __forceinline__ unsigned pk(float a, float b) { f32x2 v = {a, b}; return __builtin_bit_cast(unsigned, __builtin_convertvector(v, bf2_t)); }
__device__ __forceinline__ bf16_t f2bf(float a) { return (bf16_t)(pk(a, 0.f) & 0xffffu); }
#define MFMA16(a, b, c) __builtin_amdgcn_mfma_f32_16x16x32_bf16((a), (b), (c), 0, 0, 0)
#define MFMA32(a, b, c) __builtin_amdgcn_mfma_f32_32x32x16_bf16((a), (b), (c), 0, 0, 0)
__device__ __forceinline__ void unit_rows(int b, int cidx, int& rowbase, int& segbase, int& len) {
    if (cidx < CTXL / 64) { segbase = ML + b * CTXL; len = CTXL; rowbase = segbase + cidx * 64; }
    else { segbase = b * SEQ; len = SEQ; rowbase = segbase + (cidx - CTXL / 64) * 64; }
}
constexpr int TOKB = 9;
__device__ __forceinline__ int tok_seg(int r) { return r < ML ? r / SEQ : NBATCH + (r - ML) / CTXL; }
template <bool MASKED>
__device__ __forceinline__ void tok_block(const bf16_t* P, bf16_t* QKVb, const float* cw, int b0, int nrow, int lane) {
#pragma unroll 1
    for (int jj = 0; jj < 6; ++jj) {
        const int col = jj * 512 + lane * 8;
        u32x4 R[TOKB + 4];
#pragma unroll
        for (int t = 0; t < TOKB + 4; ++t) { const int r = b0 - 2 + t; const bool ok = !MASKED || (r >= 0 && r < MTOT);
            R[t] = (u32x4){0u, 0u, 0u, 0u}; if (ok) R[t] = *(const u32x4*)(P + (size_t)r * NINP + col); }
        f32x4 cwr[5][2];
#pragma unroll
        for (int i = 0; i < 5; ++i) { cwr[i][0] = *(const f32x4*)(cw + i * GQKV + col); cwr[i][1] = *(const f32x4*)(cw + i * GQKV + col + 4); }
#pragma unroll
        for (int rr = 0; rr < TOKB; ++rr) {
            if (rr < nrow) { const int row = b0 + rr;
                float a[8];
#pragma unroll
                for (int q = 0; q < 8; ++q) a[q] = 0.f;
#pragma unroll
                for (int i = 0; i < 5; ++i) { const f32x4 w0 = cwr[i][0], w1 = cwr[i][1]; u32x4 p = R[rr + i];
                    if (MASKED) { const int tr = row + i - 2; const bool v = tr >= 0 && tr < MTOT && tok_seg(tr < 0 ? 0 : (tr < MTOT ? tr : MTOT - 1)) == tok_seg(row); if (!v) p = (u32x4){0u, 0u, 0u, 0u}; }
                    a[0] += bf_lo(p.x) * w0.x; a[1] += bf_hi(p.x) * w0.y; a[2] += bf_lo(p.y) * w0.z; a[3] += bf_hi(p.y) * w0.w;
                    a[4] += bf_lo(p.z) * w1.x; a[5] += bf_hi(p.z) * w1.y; a[6] += bf_lo(p.w) * w1.z; a[7] += bf_hi(p.w) * w1.w; }
                float ss = 0.f;
#pragma unroll
                for (int q = 0; q < 8; ++q) { a[q] = silu_f(a[q]); ss += a[q] * a[q]; }
                if (jj < 4) { ss += __shfl_xor(ss, 1); ss += __shfl_xor(ss, 2); ss += __shfl_xor(ss, 4); ss += __shfl_xor(ss, 8);
                    float sc = __builtin_amdgcn_rsqf(ss + 1e-6f); if (jj < 2) sc *= 0.08838834764831845f;
#pragma unroll
                    for (int q = 0; q < 8; ++q) a[q] *= sc; }
                *(u32x4*)(QKVb + (size_t)row * GQKV + col) = (u32x4){pk(a[0], a[1]), pk(a[2], a[3]), pk(a[4], a[5]), pk(a[6], a[7])}; }
        }
    }
}
__device__ __forceinline__ void p3a_tokens(Frame& F) {
    const bf16_t* P = WSP(const bf16_t, WS_P); bf16_t* QKVb = WSP(bf16_t, WS_QKVB); float* GBf = WSP(float, WS_GBF);
    const float* cw = F.in[I_CONVQKV];
    int tz_ = threadIdx.x; asm volatile("" : "+v"(tz_));
    const int lane_ = tz_ & 63, wave_ = __builtin_amdgcn_readfirstlane(tz_ >> 6);
    for (int blk = F.bid * 8 + wave_; blk * TOKB < MTOT; blk += F.G * 8) {
        const int b0 = blk * TOKB, nrow = (b0 + TOKB <= MTOT) ? TOKB : MTOT - b0;
        const bool clean = b0 >= 2 && b0 + TOKB + 1 < MTOT && tok_seg(b0 - 2) == tok_seg(b0 + TOKB + 1);
        if (clean) tok_block<false>(P, QKVb, cw, b0, nrow, lane_); else tok_block<true>(P, QKVb, cw, b0, nrow, lane_);
        if (lane_ < 32) { const int i = lane_ & 15; float gv[TOKB];
#pragma unroll
            for (int rr = 0; rr < TOKB; ++rr) gv[rr] = (rr < nrow) ? bf2f(P[(size_t)(b0 + rr) * NINP + (lane_ < 16 ? COL_A : COL_B) + i]) : 0.f;
            const float al = -__expf(F.in[I_ALOG][i]), dt = F.in[I_DTB][i];
#pragma unroll
            for (int rr = 0; rr < TOKB; ++rr) if (rr < nrow) { const float v = gv[rr]; GBf[(size_t)(b0 + rr) * 32 + lane_] = (lane_ < 16) ? al * softplus_f(v + dt) : sigmoid_f(v); } }
    }
}
constexpr int PL_QS = 0, PL_KS = 17408, PL_KBG = 34816, PL_VB = 53248, PL_AM = 71680, PL_QKM = 89088, PL_TB = 106496, PL_EGC = 115712, PL_EKD = 115968, PL_TF = 116224, PL_GC = 133632, PL_BETA = 133888;
constexpr int QP = 136, TP = 72, FP = 68;
#define MFMA4F(a, b, c) __builtin_amdgcn_mfma_f32_16x16x4f32((a), (b), (c), 0, 0, 0)
__device__ __forceinline__ void p3_prep(Frame& F) {
    const bf16_t* QKVb = WSP(const bf16_t, WS_QKVB); const float* GBf = WSP(const float, WS_GBF);
    LAS bf16_t* Qs = (LAS bf16_t*)(F.lds + PL_QS); LAS bf16_t* Ks = (LAS bf16_t*)(F.lds + PL_KS); LAS bf16_t* KbgT = (LAS bf16_t*)(F.lds + PL_KBG); LAS bf16_t* VbT = (LAS bf16_t*)(F.lds + PL_VB);
    LAS float* Am = (LAS float*)(F.lds + PL_AM); LAS float* QKm = (LAS float*)(F.lds + PL_QKM); LAS bf16_t* Tb = (LAS bf16_t*)(F.lds + PL_TB); LAS float* Tf = (LAS float*)(F.lds + PL_TF);
    LAS float* egc_s = (LAS float*)(F.lds + PL_EGC); LAS float* ekd_s = (LAS float*)(F.lds + PL_EKD); LAS float* gc_s = (LAS float*)(F.lds + PL_GC); LAS float* beta_s = (LAS float*)(F.lds + PL_BETA);
    LAS bf16_t* Ws = Qs; LAS bf16_t* Us = Ks;
    int tz = threadIdx.x; asm volatile("" : "+v"(tz));
    const int tid = tz, lane = tz & 63, w = __builtin_amdgcn_readfirstlane(tz >> 6), l15 = lane & 15, l4 = lane >> 4, r31 = lane & 31, hh = lane >> 5;
    u32x4 pre[3][2]; float pg = 0.f, pb = 0.f;
#define PREP_LOAD(uid_) do { const int _dir = (uid_) & 1, _h = ((uid_) >> 1) & 7, _cb = (uid_) >> 4, _cidx = _cb % NCHUNK, _b = _cb / NCHUNK; int _rb, _sb, _ln; unit_rows(_b, _cidx, _rb, _sb, _ln); \
        _Pragma("unroll") for (int _p = 0; _p < 3; ++_p) _Pragma("unroll") for (int _hf = 0; _hf < 2; ++_hf) { const int _r = 2 * (tid >> 4) + _hf; \
            pre[_p][_hf] = *(const u32x4*)(QKVb + (size_t)(_rb + (_dir ? 63 - _r : _r)) * GQKV + _p * GQK + _h * 128 + (tid & 15) * 8); } \
        { const size_t _pr = (size_t)(_rb + (_dir ? 63 - lane : lane)); pg = GBf[_pr * 32 + _dir * 8 + _h]; pb = GBf[_pr * 32 + 16 + _dir * 8 + _h]; } } while (0)
    if (F.bid < NUNITS) PREP_LOAD(F.bid);
    for (int uid = F.bid; uid < NUNITS; uid += F.G) {
        unsigned char* ub = F.ws + WS_PREP + (size_t)uid * UNIT_BYTES;
        float gc = pg; const float beta = pb;
#pragma unroll
        for (int off = 1; off < 64; off <<= 1) { const float t = __shfl_up(gc, off); if (lane >= off) gc += t; }
        const float glast = __shfl(gc, 63), egcv = __expf(gc);
        if (w == 0) { egc_s[lane] = egcv; ekd_s[lane] = __expf(glast - gc); gc_s[lane] = gc; beta_s[lane] = beta; }
        { const int r0 = 2 * (tid >> 4), c16 = tid & 15;
          const float br0 = __shfl(beta, r0), br1 = __shfl(beta, r0 + 1), sk0 = br0 * __shfl(egcv, r0), sk1 = br1 * __shfl(egcv, r0 + 1);
          const int rs = (((r0 >> 3) ^ (c16 >> 1)) << 3) + (r0 & 7);
          *(LAS u32x4*)(Qs + r0 * QP + c16 * 8) = pre[0][0]; *(LAS u32x4*)(Qs + (r0 + 1) * QP + c16 * 8) = pre[0][1];
          *(LAS u32x4*)(Ks + r0 * QP + c16 * 8) = pre[1][0]; *(LAS u32x4*)(Ks + (r0 + 1) * QP + c16 * 8) = pre[1][1];
#pragma unroll
          for (int e = 0; e < 4; ++e) { const unsigned k0 = pre[1][0][e], k1 = pre[1][1][e], v0 = pre[2][0][e], v1 = pre[2][1][e];
              *(LAS unsigned*)(KbgT + (c16 * 8 + 2 * e) * TP + rs) = pk(bf_lo(k0) * sk0, bf_lo(k1) * sk1); *(LAS unsigned*)(KbgT + (c16 * 8 + 2 * e + 1) * TP + rs) = pk(bf_hi(k0) * sk0, bf_hi(k1) * sk1);
              *(LAS unsigned*)(VbT + (c16 * 8 + 2 * e) * TP + rs) = pk(bf_lo(v0) * br0, bf_lo(v1) * br1); *(LAS unsigned*)(VbT + (c16 * 8 + 2 * e + 1) * TP + rs) = pk(bf_hi(v0) * br0, bf_hi(v1) * br1); } }
        if (uid + F.G < NUNITS) PREP_LOAD(uid + F.G);
        __syncthreads();
        { const bool isq = w >= 4; const int rt = w & 3; const LAS bf16_t* X = isq ? Qs : Ks; LAS float* OUT = isq ? QKm : Am;
          bf16x8 af[4], bfr[4][4];
#pragma unroll
          for (int ks = 0; ks < 4; ++ks) af[ks] = *(const LAS bf16x8*)(X + (rt * 16 + l15) * QP + 32 * ks + 8 * l4);
#pragma unroll
          for (int st = 0; st < 4; ++st)
#pragma unroll
              for (int ks = 0; ks < 4; ++ks) bfr[st][ks] = *(const LAS bf16x8*)(Ks + (st * 16 + l15) * QP + 32 * ks + 8 * l4);
          const f32x4 gcr4 = *(const LAS f32x4*)(gc_s + rt * 16 + 4 * l4), br4 = *(const LAS f32x4*)(beta_s + rt * 16 + 4 * l4);
          float gcs4[4];
#pragma unroll
          for (int st = 0; st < 4; ++st) gcs4[st] = gc_s[st * 16 + l15];
          const int moff = isq ? 0 : 1; const f32x4 mul4 = isq ? (f32x4){1.f, 1.f, 1.f, 1.f} : br4;
#pragma unroll
          for (int st = 0; st < 4; ++st) { f32x4 acc = {0.f, 0.f, 0.f, 0.f};
#pragma unroll
              for (int ks = 0; ks < 4; ++ks) acc = MFMA16(af[ks], bfr[st][ks], acc);
              const int sidx = st * 16 + l15; const float gcs = gcs4[st];
#pragma unroll
              for (int reg = 0; reg < 4; ++reg) { const int ridx = rt * 16 + 4 * l4 + reg;
                  const float e = __expf(fminf(gcr4[reg] - gcs, 0.f));
                  OUT[ridx * FP + sidx] = (ridx >= sidx + moff) ? mul4[reg] * acc[reg] * e : 0.f; } } }
#pragma unroll
        for (int q2 = 0; q2 < 2; ++q2) { const int frag = w + 8 * q2;
            { const int mt = frag >> 3, kt = (frag >> 1) & 3, s2 = frag & 1, row = 32 * mt + r31, col0 = 32 * kt + 16 * s2 + 4 * hh; const float e = egc_s[row];
              const u32x2 lo = *(const LAS u32x2*)(Qs + row * QP + col0), hi = *(const LAS u32x2*)(Qs + row * QP + col0 + 8);
              *(u32x4*)(ub + UO_QD + frag * 1024 + lane * 16) = (u32x4){pk(bf_lo(lo.x) * e, bf_hi(lo.x) * e), pk(bf_lo(lo.y) * e, bf_hi(lo.y) * e), pk(bf_lo(hi.x) * e, bf_hi(hi.x) * e), pk(bf_lo(hi.y) * e, bf_hi(hi.y) * e)}; }
            { const int kt = frag >> 2, ct = (frag >> 1) & 1, s2 = frag & 1; float v[8];
#pragma unroll
              for (int j = 0; j < 8; ++j) { const int tok = 32 * ct + 16 * s2 + 8 * (j >> 2) + 4 * hh + (j & 3); v[j] = bf2f(Ks[tok * QP + 32 * kt + r31]); }
              { const int t0 = 32 * ct + 16 * s2 + 4 * hh; const f32x4 e0 = *(const LAS f32x4*)(ekd_s + t0), e1 = *(const LAS f32x4*)(ekd_s + t0 + 8);
                v[0] *= e0.x; v[1] *= e0.y; v[2] *= e0.z; v[3] *= e0.w; v[4] *= e1.x; v[5] *= e1.y; v[6] *= e1.z; v[7] *= e1.w; }
              *(u32x4*)(ub + UO_KDT + frag * 1024 + lane * 16) = (u32x4){pk(v[0], v[1]), pk(v[2], v[3]), pk(v[4], v[5]), pk(v[6], v[7])}; } }
        __syncthreads();
        if (w < 4) { float t[16];
            f32x4 ar[4];
#pragma unroll
            for (int c4 = 0; c4 < 4; ++c4) ar[c4] = *(const LAS f32x4*)(Am + (16 * w + l15) * FP + 16 * w + 4 * c4);
#pragma unroll
            for (int i = 0; i < 16; ++i) { float a0 = (i == lane) ? 1.f : 0.f;
#pragma unroll
                for (int m = 0; m < i; ++m) { const float av = ar[m >> 2][m & 3];
                    a0 -= __builtin_bit_cast(float, __builtin_amdgcn_readlane(__builtin_bit_cast(int, av), i)) * t[m]; }
                t[i] = a0; __builtin_amdgcn_sched_barrier(0); }
            if (lane < 16) {
#pragma unroll
                for (int i = 0; i < 16; ++i) Tf[(16 * w + i) * FP + 16 * w + lane] = t[i]; } }
        __syncthreads();
#pragma unroll
        for (int lv = 1; lv < 4; ++lv) {
            if (w < 4 - lv) { const int bj = w, bi = w + lv;
                f32x4 aop[3]; float bop[3][4];
#pragma unroll
                for (int t = 0; t < lv; ++t) { const int bk = bj + t; aop[t] = *(const LAS f32x4*)(Am + (16 * bi + l15) * FP + 16 * bk + 4 * l4);
#pragma unroll
                    for (int ks = 0; ks < 4; ++ks) bop[t][ks] = Tf[(16 * bk + 4 * l4 + ks) * FP + 16 * bj + l15]; }
                const f32x4 tdg = *(const LAS f32x4*)(Tf + (16 * bi + l15) * FP + 16 * bi + 4 * l4);
                f32x4 x = {0.f, 0.f, 0.f, 0.f};
#pragma unroll
                for (int t = 0; t < lv; ++t)
#pragma unroll
                    for (int ks = 0; ks < 4; ++ks) x = MFMA4F(aop[t][ks], bop[t][ks], x);
                f32x4 y = {0.f, 0.f, 0.f, 0.f};
#pragma unroll
                for (int ks = 0; ks < 4; ++ks) y = MFMA4F(tdg[ks], x[ks], y);
#pragma unroll
                for (int reg = 0; reg < 4; ++reg) Tf[(16 * bi + 4 * l4 + reg) * FP + 16 * bj + l15] = -y[reg]; }
            __syncthreads();
        }
#pragma unroll
        for (int q = 0; q < 4; ++q) { const int idx = tid + 512 * q, i = idx >> 5, j = (idx & 31) * 2; const f32x2 tv = *(const LAS f32x2*)(Tf + i * FP + j);
            *(LAS unsigned*)(Tb + i * TP + j) = pk(j <= i ? tv.x : 0.f, j + 1 <= i ? tv.y : 0.f); }
        __syncthreads();
        { bf16x8 bu[2], bw[2];
#pragma unroll
          for (int ks = 0; ks < 2; ++ks) { const int ch = 8 * ((4 * ks + l4) ^ w);
              bu[ks] = *(const LAS bf16x8*)(VbT + (w * 16 + l15) * TP + ch); bw[ks] = *(const LAS bf16x8*)(KbgT + (w * 16 + l15) * TP + ch); }
#pragma unroll
          for (int rt = 0; rt < 4; ++rt) { const bf16x8 a0 = *(const LAS bf16x8*)(Tb + (rt * 16 + l15) * TP + 8 * l4), a1 = *(const LAS bf16x8*)(Tb + (rt * 16 + l15) * TP + 32 + 8 * l4);
              f32x4 au = {0.f, 0.f, 0.f, 0.f}, aw = {0.f, 0.f, 0.f, 0.f};
              au = MFMA16(bu[0], a0, au); au = MFMA16(bu[1], a1, au); aw = MFMA16(bw[0], a0, aw); aw = MFMA16(bw[1], a1, aw);
              { const int r = rt * 16 + l15, f0 = w * 16 + 4 * l4;
                *(LAS u32x2*)(Us + r * QP + f0) = (u32x2){pk(au[0], au[1]), pk(au[2], au[3])}; *(LAS u32x2*)(Ws + r * QP + f0) = (u32x2){pk(-aw[0], -aw[1]), pk(-aw[2], -aw[3])}; } } }
        __syncthreads();
#pragma unroll
        for (int q2 = 0; q2 < 2; ++q2) { const int frag = w + 8 * q2, mt = frag >> 3, kt = (frag >> 1) & 3, s2 = frag & 1, row = 32 * mt + r31, col0 = 32 * kt + 16 * s2 + 4 * hh;
            const u32x2 lo = *(const LAS u32x2*)(Ws + row * QP + col0), hi = *(const LAS u32x2*)(Ws + row * QP + col0 + 8);
            *(u32x4*)(ub + UO_NW + frag * 1024 + lane * 16) = (u32x4){lo.x, lo.y, hi.x, hi.y}; }
        { const int mt = w >> 2, nt = w & 3; unsigned o[8];
#pragma unroll
          for (int p = 0; p < 8; ++p) { const int reg0 = 2 * p, row0 = 32 * mt + (reg0 & 3) + 8 * (reg0 >> 2) + 4 * hh;
              o[p] = (unsigned)Us[row0 * QP + 32 * nt + r31] | ((unsigned)Us[(row0 + 1) * QP + 32 * nt + r31] << 16); }
          *(u32x4*)(ub + UO_U + w * 2048 + lane * 32) = (u32x4){o[0], o[1], o[2], o[3]}; *(u32x4*)(ub + UO_U + w * 2048 + lane * 32 + 16) = (u32x4){o[4], o[5], o[6], o[7]}; }
        { const int mt = w >> 2, ct = (w >> 1) & 1, s2 = w & 1, row = 32 * mt + r31, col0 = 32 * ct + 16 * s2 + 4 * hh;
          const f32x4 x0 = *(const LAS f32x4*)(QKm + row * FP + col0), x1 = *(const LAS f32x4*)(QKm + row * FP + col0 + 8);
          *(u32x4*)(ub + UO_QK + w * 1024 + lane * 16) = (u32x4){pk(x0.x, x0.y), pk(x0.z, x0.w), pk(x1.x, x1.y), pk(x1.z, x1.w)}; }
        if (tid == 0) *(float*)(ub + UO_DL) = __expf(glast);
        __syncthreads();
    }
#undef PREP_LOAD
}

__device__ __forceinline__ bf16x8 pack_step(const f32x16& x, int s) { return __builtin_bit_cast(bf16x8, ((u32x4){pk(x[8 * s], x[8 * s + 1]), pk(x[8 * s + 2], x[8 * s + 3]), pk(x[8 * s + 4], x[8 * s + 5]), pk(x[8 * s + 6], x[8 * s + 7])})); }
__device__ __forceinline__ void p4_scan(Frame& F) {
    constexpr int NSCAN = NBATCH * NH * 2;
    if (F.bid >= NSCAN) {
        const int nconv = (F.G - NSCAN) < NCONV_SCAN ? (F.G - NSCAN) : NCONV_SCAN;
        if (F.bid - NSCAN < nconv) convert_experts(F, (F.bid - NSCAN) * 8 + F.wave, nconv * 8, ti_early(F.G), TI_EXP);
        return;
    }
    const int b = F.bid >> 4, h = (F.bid >> 1) & 7, dir = F.bid & 1, lane = F.lane;
    const unsigned char* prep = F.ws + WS_PREP;
#define STEP_CIDX(n) (dir ? ((n) < CTXL / 64 ? CTXL / 64 - 1 - (n) : NCHUNK + CTXL / 64 - 1 - (n)) : (n))
#define STEP_UNIT(n) (prep + (size_t)((((b * NCHUNK + STEP_CIDX(n)) * NH + h) * 2) + dir) * UNIT_BYTES)
    if (F.wave >= 4) {
        const int lw = F.wave - 4;
#define ISSUE(n) do { const unsigned char* _ub = STEP_UNIT(n); LAS unsigned char* _lb = F.lds + ((n) & 1) * UNIT_DMA; _Pragma("unroll") for (int _p = 0; _p < 19; ++_p) \
            if (_p * 4 + lw < UNIT_DMA / 1024) __builtin_amdgcn_global_load_lds((const unsigned*)(_ub + (_p * 4 + lw) * 1024 + lane * 16), (LAS unsigned*)(_lb + (_p * 4 + lw) * 1024), 16, 0, 0); } while (0)
        ISSUE(0);
        for (int n = 0; n < NCHUNK; ++n) { VM_WAIT(); __builtin_amdgcn_s_barrier(); asm volatile("" ::: "memory"); if (n + 1 < NCHUNK) ISSUE(n + 1); }
        VM_WAIT();
#undef ISSUE
        return;
    }
    const int nt = F.wave, c = lane & 31, hh = lane >> 5;
    bf16_t* OGb = WSP(bf16_t, WS_OGB) + (size_t)dir * ML * 1024;
    f32x16 S[4];
#pragma unroll
    for (int kt = 0; kt < 4; ++kt)
#pragma unroll
        for (int i = 0; i < 16; ++i) S[kt][i] = 0.f;
#pragma unroll 1
    for (int n = 0; n < NCHUNK; ++n) {
        asm volatile("" ::: "memory"); __builtin_amdgcn_s_barrier(); asm volatile("" ::: "memory");
        const LAS unsigned char* lb = F.lds + (n & 1) * UNIT_DMA;
        const float dlc = *(const LAS float*)(lb + UO_DL);
        u32x4 ucur[2][2];
#pragma unroll
        for (int mt = 0; mt < 2; ++mt) { ucur[mt][0] = *(const LAS u32x4*)(lb + UO_U + (mt * 4 + nt) * 2048 + lane * 32); ucur[mt][1] = *(const LAS u32x4*)(lb + UO_U + (mt * 4 + nt) * 2048 + lane * 32 + 16); }
#define FRAG(off, idx) (*(const LAS bf16x8*)(lb + (off) + (idx) * 1024 + lane * 16))
        f32x16 VN[2], O[2];
#pragma unroll
        for (int mt = 0; mt < 2; ++mt) {
#pragma unroll
            for (int p = 0; p < 4; ++p) { VN[mt][2 * p] = bf_lo(ucur[mt][0][p]); VN[mt][2 * p + 1] = bf_hi(ucur[mt][0][p]); VN[mt][8 + 2 * p] = bf_lo(ucur[mt][1][p]); VN[mt][8 + 2 * p + 1] = bf_hi(ucur[mt][1][p]); }
#pragma unroll
            for (int i = 0; i < 16; ++i) O[mt][i] = 0.f; }
#pragma unroll
        for (int kt = 0; kt < 4; ++kt) { const bf16x8 sb0 = pack_step(S[kt], 0), sb1 = pack_step(S[kt], 1);
#pragma unroll
            for (int mt = 0; mt < 2; ++mt) { const int fi = (mt * 4 + kt) * 2;
                VN[mt] = MFMA32(FRAG(UO_NW, fi), sb0, VN[mt]); VN[mt] = MFMA32(FRAG(UO_NW, fi + 1), sb1, VN[mt]);
                O[mt] = MFMA32(FRAG(UO_QD, fi), sb0, O[mt]); O[mt] = MFMA32(FRAG(UO_QD, fi + 1), sb1, O[mt]); } }
        bf16x8 vb[2][2];
#pragma unroll
        for (int ct = 0; ct < 2; ++ct) { vb[ct][0] = pack_step(VN[ct], 0); vb[ct][1] = pack_step(VN[ct], 1); }
#pragma unroll
        for (int mt = 0; mt < 2; ++mt)
#pragma unroll
            for (int ct = 0; ct < 2; ++ct) { const int fi = (mt * 2 + ct) * 2; O[mt] = MFMA32(FRAG(UO_QK, fi), vb[ct][0], O[mt]); O[mt] = MFMA32(FRAG(UO_QK, fi + 1), vb[ct][1], O[mt]); }
#pragma unroll
        for (int kt = 0; kt < 4; ++kt) {
#pragma unroll
            for (int i = 0; i < 16; ++i) S[kt][i] *= dlc;
#pragma unroll
            for (int ct = 0; ct < 2; ++ct) { const int fi = (kt * 2 + ct) * 2; S[kt] = MFMA32(FRAG(UO_KDT, fi), vb[ct][0], S[kt]); S[kt] = MFMA32(FRAG(UO_KDT, fi + 1), vb[ct][1], S[kt]); } }
#undef FRAG
        const int cidx = STEP_CIDX(n);
        if (cidx >= CTXL / 64) { const int rowbase = b * SEQ + (cidx - CTXL / 64) * 64;
#pragma unroll
            for (int mt = 0; mt < 2; ++mt)
#pragma unroll
                for (int reg = 0; reg < 16; ++reg) { const int row = 32 * mt + (reg & 3) + 8 * (reg >> 2) + 4 * hh, prow = rowbase + (dir ? 63 - row : row);
                    OGb[(size_t)prow * 1024 + h * 128 + 32 * nt + c] = f2bf(O[mt][reg]); } }
    }
#undef STEP_CIDX
#undef STEP_UNIT
}

struct MixRow { u32x4 oa[2], ob[2], zz[2], sb[2], cv[3][2], xv[3][2]; };
__device__ __forceinline__ MixRow mix_load(const bf16_t* P, const bf16_t* OGb, int row, int f0, int c0, bool horiz) {
    MixRow m; const int t = row % SEQ, gr = t / 64, gc = t % 64, dlt = horiz ? 1 : 64;
    const bool hasp = horiz ? (gc > 0) : (gr > 0), hasn = horiz ? (gc < 63) : (gr < SEQ / 64 - 1);
#pragma unroll
    for (int q = 0; q < 2; ++q) { m.oa[q] = *(const u32x4*)(OGb + (size_t)row * 1024 + f0 + 8 * q); m.ob[q] = *(const u32x4*)(OGb + (size_t)ML * 1024 + (size_t)row * 1024 + f0 + 8 * q);
        m.zz[q] = *(const u32x4*)(P + (size_t)row * NINP + COL_Z + f0 + 8 * q); m.sb[q] = *(const u32x4*)(P + (size_t)row * NINP + COL_SB + c0 + 8 * q); }
#pragma unroll
    for (int i = 0; i < 3; ++i) { const bool ok = i == 1 || (i == 0 ? hasp : hasn); const size_t rr = (size_t)(row + (ok ? (i - 1) * dlt : 0));
#pragma unroll
        for (int q = 0; q < 2; ++q) { m.cv[i][q] = *(const u32x4*)(P + rr * NINP + COL_SC + c0 + 8 * q); m.xv[i][q] = *(const u32x4*)(P + rr * NINP + COL_SX + c0 + 8 * q);
            if (!ok) m.cv[i][q] = (u32x4){0u, 0u, 0u, 0u}; } }
    return m;
}
__device__ __forceinline__ void p5_mix_out(Frame& F) {
    const bf16_t* P = WSP(const bf16_t, WS_P); const bf16_t* OGb = WSP(const bf16_t, WS_OGB); bf16_t* Y = WSP(bf16_t, WS_Y);
    const float* nw = F.in[I_GNW]; const float* cs = F.in[I_CONVSC];
    const int gw = F.bid * 8 + F.wave, NGW = F.G * 8;
    const int f0 = F.lane * 16, c0 = F.lane * 16; const bool horiz = c0 < 512;
    LAS float* nwL = (LAS float*)F.lds; LAS float* csL = nwL + 128;
    if (F.tid < 128) nwL[F.tid] = nw[F.tid];
    for (int i = F.tid; i < 3 * 1024; i += 512) csL[i] = cs[i];
    __syncthreads();
    if (gw >= ML) return;
    MixRow nx = mix_load(P, OGb, gw, f0, c0, horiz);
    for (int row = gw; row < ML; row += NGW) {
        const MixRow m = nx;
        if (row + NGW < ML) nx = mix_load(P, OGb, row + NGW, f0, c0, horiz);
        { float o[16]; float ss = 0.f;
#pragma unroll
          for (int q = 0; q < 2; ++q)
#pragma unroll
              for (int e = 0; e < 4; ++e) { const float s0 = bf_lo(m.oa[q][e]) + bf_lo(m.ob[q][e]), s1 = bf_hi(m.oa[q][e]) + bf_hi(m.ob[q][e]); o[8 * q + 2 * e] = s0; o[8 * q + 2 * e + 1] = s1; ss += s0 * s0 + s1 * s1; }
          ss += __shfl_xor(ss, 1); ss += __shfl_xor(ss, 2); ss += __shfl_xor(ss, 4);
          const float r = __builtin_amdgcn_rsqf(ss * (1.f / 128.f) + RMS_EPS);
          unsigned ow[8];
#pragma unroll
          for (int q = 0; q < 8; ++q) { const int f = (f0 + 2 * q) & 127; const unsigned zw = m.zz[q >> 2][q & 3];
              const float y0 = o[2 * q] * r * nwL[f] * silu_f(bf_lo(zw)), y1 = o[2 * q + 1] * r * nwL[f + 1] * silu_f(bf_hi(zw)); ow[q] = cvt_pk_bf16(y0, y1); }
          *(u32x4*)(Y + (size_t)row * D + f0) = (u32x4){ow[0], ow[1], ow[2], ow[3]}; *(u32x4*)(Y + (size_t)row * D + f0 + 8) = (u32x4){ow[4], ow[5], ow[6], ow[7]}; }
        { float acc[16];
#pragma unroll
          for (int q = 0; q < 16; ++q) acc[q] = 0.f;
#pragma unroll
          for (int i = 0; i < 3; ++i)
#pragma unroll
              for (int hh = 0; hh < 2; ++hh)
#pragma unroll
                  for (int q = 0; q < 4; ++q) { const int ch = c0 + 8 * hh + 2 * q; const unsigned cw = m.cv[i][hh][q], xw = m.xv[i][hh][q];
                      acc[8 * hh + 2 * q] += bf_lo(cw) * bf_lo(xw) * csL[i * 1024 + ch]; acc[8 * hh + 2 * q + 1] += bf_hi(cw) * bf_hi(xw) * csL[i * 1024 + ch + 1]; }
          unsigned ow[8];
#pragma unroll
          for (int q = 0; q < 8; ++q) { const unsigned bw = m.sb[q >> 2][q & 3]; ow[q] = cvt_pk_bf16(bf_lo(bw) * acc[2 * q], bf_hi(bw) * acc[2 * q + 1]); }
          *(u32x4*)(Y + (size_t)row * D + 1024 + c0) = (u32x4){ow[0], ow[1], ow[2], ow[3]}; *(u32x4*)(Y + (size_t)row * D + 1024 + c0 + 8) = (u32x4){ow[4], ow[5], ow[6], ow[7]}; }
    }
}

struct OutProj {
    static constexpr bool PERM = true, GATHER = false, FP8 = false, BBLK = false; typedef NoPre Pre;
    __device__ __forceinline__ Pre prefetch(const Unit&, int, int, int, int) const { return Pre{}; }
    int K; const char* A; const char* Bt; bf16_t* V; const float* x; const f32x2* st0; const float* g0; const float* b0; const float* modf; int G, c;
    __device__ __forceinline__ bool next(int i, Unit& u) const { const int L = i * G + c; if (L >= (ML / 256) * (D / 256)) return false; pg8::tile_order(L, ML / 256, D / 256, u.pm, u.pn); u.e = 0; return true; }
    __device__ __forceinline__ const char* bptr(const Unit& u, int half) const { return Bt + (size_t)(u.pn * 256 + half * 128) * K * 2; }
    __device__ __forceinline__ unsigned arow_i(int, const Unit& u, int r) const { return (unsigned)(u.pm * 256 + r); }
    __device__ __forceinline__ void epi(const f32x4 (&acc)[2][2][4][2], const Unit& u, int wr, int wc, int fr, int fq, const Pre&) const {
        const int row0 = u.pm * 256 + wr * 64 + fr, col0 = u.pn * 256 + wc * 32 + 8 * fq;
        const float* gt1 = modf + (size_t)(u.pm * 256 / SEQ) * (6 * D) + 2 * D;
        constexpr int XW = 4;
        f32x4 XA[16], XB[16]; f32x2 SS[16]; f32x4 PG[2][2], PB[2][2], PT[2][2];
#define OP_ROW(it_) (row0 + (((it_) >> 2) & 1) * 128 + ((it_) & 3) * 16)
#define OP_COL(it_) (col0 + ((it_) >> 3) * 128)
#define OP_LOAD(it_) do { SS[it_] = st0[OP_ROW(it_)]; XA[it_] = *(const f32x4*)(x + (size_t)OP_ROW(it_) * D + OP_COL(it_)); XB[it_] = *(const f32x4*)(x + (size_t)OP_ROW(it_) * D + OP_COL(it_) + 4); } while (0)
#define OP_PARAMS(bj_) do { const int _c = col0 + (bj_) * 128; PG[bj_][0] = *(const f32x4*)(g0 + _c); PG[bj_][1] = *(const f32x4*)(g0 + _c + 4); PB[bj_][0] = *(const f32x4*)(b0 + _c); PB[bj_][1] = *(const f32x4*)(b0 + _c + 4); \
            PT[bj_][0] = *(const f32x4*)(gt1 + _c); PT[bj_][1] = *(const f32x4*)(gt1 + _c + 4); } while (0)
        OP_PARAMS(0);
#pragma unroll
        for (int it = 0; it < XW; ++it) OP_LOAD(it);
#pragma unroll
        for (int it = 0; it < 16; ++it) { const int bj = it >> 3, ai = (it >> 2) & 1, m = it & 3; const f32x2 sv = SS[it];
            const f32x4 va = ((XA[it] - sv.x) * sv.y * PG[bj][0] + PB[bj][0]) * DN_ALPHA + PT[bj][0] * acc[ai][bj][m][0], vb = ((XB[it] - sv.x) * sv.y * PG[bj][1] + PB[bj][1]) * DN_ALPHA + PT[bj][1] * acc[ai][bj][m][1];
            *(u32x4*)(V + (size_t)OP_ROW(it) * D + OP_COL(it)) = (u32x4){cvt_pk_bf16(va[0], va[1]), cvt_pk_bf16(va[2], va[3]), cvt_pk_bf16(vb[0], vb[1]), cvt_pk_bf16(vb[2], vb[3])};
            if (it == 3) OP_PARAMS(1);
            if (it + XW < 16) OP_LOAD(it + XW); }
#undef OP_ROW
#undef OP_COL
#undef OP_LOAD
#undef OP_PARAMS
    }
};

constexpr int UT_PITCH = D + 4;
__device__ __forceinline__ void p7_ln1_router(Frame& F) {
    int tz_ = threadIdx.x; asm volatile("" : "+v"(tz_));
    const int tid_ = tz_, lane_ = tz_ & 63, wave_ = __builtin_amdgcn_readfirstlane(tz_ >> 6);
    LAS float* uT = (LAS float*)F.lds;
    LAS float* part = uT + 16 * UT_PITCH;
    LAS float* logit = part + 8 * 16 * 32;
    const bf16_t* V = WSP(const bf16_t, WS_V); f32x2* st1 = WSP(f32x2, WS_STAT1); const float* modf = WSP(const float, WS_MODF); unsigned char* U8 = WSP(unsigned char, WS_U);
    const float* g1 = F.in[I_LN1G]; const float* b1 = F.in[I_LN1B]; const float* wrt = F.in[I_WR]; const float* brt = F.in[I_BR];
    int* toke = WSP(int, WS_TOKE); int* tokp = WSP(int, WS_TOKP); float* tokg = WSP(float, WS_TOKG); int* list = WSP(int, WS_LIST);
    const int r16 = lane_ & 15, kk = lane_ >> 4;
    u32x2 vw[2][8];
#define LN1_LOAD(tile_) do { _Pragma("unroll") for (int _rr = 0; _rr < 2; ++_rr) { const u32x2* _xr = (const u32x2*)(V + (size_t)((tile_) * 16 + wave_ * 2 + _rr) * D) + lane_; \
            _Pragma("unroll") for (int _j = 0; _j < 8; ++_j) vw[_rr][_j] = _xr[64 * _j]; } } while (0)
    if (F.bid < ML / 16) LN1_LOAD(F.bid);
    for (int tile = F.bid; tile < ML / 16; tile += F.G) {
        const int rbase = tile * 16; const int bidx = rbase / SEQ; const float* sh2 = modf + (size_t)bidx * (6 * D) + 3 * D; const float* sc2 = sh2 + D;
        f32x4 pa[8], pc[8];
        unsigned dofs = 4u * (unsigned)lane_; asm volatile("" : "+v"(dofs));
#pragma unroll
        for (int j = 0; j < 8; ++j) { const f32x4 sc = *(const f32x4*)((sc2 + 256 * j) + dofs) + 1.f;
            pa[j] = *(const f32x4*)((g1 + 256 * j) + dofs) * sc; pc[j] = *(const f32x4*)((b1 + 256 * j) + dofs) * sc + *(const f32x4*)((sh2 + 256 * j) + dofs);
            if (j == 3) asm volatile("" ::: "memory"); }
#pragma unroll
        for (int rr = 0; rr < 2; ++rr) {
            const int lr = wave_ * 2 + rr, row = rbase + lr;
            f32x4 x[8]; float s = 0.f;
#pragma unroll
            for (int j = 0; j < 8; ++j) { const u32x2 w = vw[rr][j]; x[j] = (f32x4){bf_lo(w.x), bf_hi(w.x), bf_lo(w.y), bf_hi(w.y)}; s += (x[j].x + x[j].y) + (x[j].z + x[j].w); }
            const float mean = wave_sum(s) * (1.f / D); float s2 = 0.f;
#pragma unroll
            for (int j = 0; j < 8; ++j) { x[j] = x[j] - mean; s2 += (x[j].x * x[j].x + x[j].y * x[j].y) + (x[j].z * x[j].z + x[j].w * x[j].w); }
            const float rstd = 1.f / sqrtf(wave_sum(s2) * (1.f / D) + LN_EPS);
            if (lane_ == 0) st1[row] = (f32x2){mean, rstd}; unsigned* uo = (unsigned*)(U8 + (size_t)row * D) + lane_;
#pragma unroll
            for (int j = 0; j < 8; ++j) { const int d = 4 * lane_ + 256 * j;
                const f32x4 u = (x[j] * rstd) * pa[j] + pc[j];
                uo[64 * j] = pk_fp8x4(u.x, u.y, u.z, u.w);
                *(LAS f32x4*)(uT + lr * UT_PITCH + d) = u; }
        }
        unsigned wlo = (unsigned)(4 * kk * NE + r16); asm volatile("" : "+v"(wlo));
        float wl[16][4][2]; asm volatile("" ::: "memory");
#define RW_LOAD(m_) do { _Pragma("unroll") for (int _j = 0; _j < 4; ++_j) _Pragma("unroll") for (int _nt = 0; _nt < 2; ++_nt) \
            wl[m_][_j][_nt] = (wrt + (256 * wave_ + 16 * (m_)) * NE)[wlo + (unsigned)(_j * NE + 16 * _nt)]; } while (0)
#pragma unroll
        for (int m = 0; m < 12; ++m) RW_LOAD(m);
        __syncthreads();
        f32x4 lacc[2] = {{0.f, 0.f, 0.f, 0.f}, {0.f, 0.f, 0.f, 0.f}};
#pragma unroll
        for (int m = 0; m < 16; ++m) { const f32x4 a = *(const LAS f32x4*)(uT + r16 * UT_PITCH + 256 * wave_ + 16 * m + 4 * kk);
#pragma unroll
            for (int j = 0; j < 4; ++j) { lacc[0] = __builtin_amdgcn_mfma_f32_16x16x4f32(a[j], wl[m][j][0], lacc[0], 0, 0, 0); lacc[1] = __builtin_amdgcn_mfma_f32_16x16x4f32(a[j], wl[m][j][1], lacc[1], 0, 0, 0); }
            if (m == 3) { __builtin_amdgcn_sched_barrier(0); RW_LOAD(12); RW_LOAD(13); RW_LOAD(14); RW_LOAD(15); __builtin_amdgcn_sched_barrier(0); } }
#undef RW_LOAD
#pragma unroll
        for (int nt = 0; nt < 2; ++nt)
#pragma unroll
            for (int q = 0; q < 4; ++q) part[(wave_ * 16 + 4 * kk + q) * 32 + 16 * nt + r16] = lacc[nt][q];
        __syncthreads();
        if (tile + F.G < ML / 16) LN1_LOAD(tile + F.G);
        { const int lr = tid_ >> 5, e = tid_ & 31; float s = brt[e];
#pragma unroll
          for (int w = 0; w < 8; ++w) s += part[(w * 16 + lr) * 32 + e];
          logit[lr * 32 + e] = s; }
        __syncthreads();
        if (tid_ < 16) { const int row = rbase + tid_; float lv[32];
#pragma unroll
            for (int e = 0; e < 32; ++e) lv[e] = logit[tid_ * 32 + e];
            float tv[4]; int ti[4];
#pragma unroll
            for (int s4 = 0; s4 < 4; ++s4) { float best = -3.0e38f; int bi = 0;
#pragma unroll
                for (int e = 0; e < 32; ++e) { const bool take = lv[e] > best; best = take ? lv[e] : best; bi = take ? e : bi; }
                tv[s4] = best; ti[s4] = bi;
#pragma unroll
                for (int e = 0; e < 32; ++e) lv[e] = (e == bi) ? -3.0e38f : lv[e]; }
            const float e0 = 1.f, e1 = __expf(tv[1] - tv[0]), e2 = __expf(tv[2] - tv[0]), e3 = __expf(tv[3] - tv[0]); const float inv = 1.f / (e0 + e1 + e2 + e3);
            const float gg[4] = {e0 * inv, e1 * inv, e2 * inv, e3 * inv};
            int pos[4];
#pragma unroll
            for (int s4 = 0; s4 < 4; ++s4) pos[s4] = (int)__hip_atomic_fetch_add(F.ctl + CW_CNT + 64 * ti[s4], 1u, __ATOMIC_RELAXED, __HIP_MEMORY_SCOPE_AGENT);
            *(i32x4*)(toke + row * 4) = (i32x4){ti[0], ti[1], ti[2], ti[3]}; *(f32x4*)(tokg + row * 4) = (f32x4){gg[0], gg[1], gg[2], gg[3]};
            *(i32x4*)(tokp + row * 4) = (i32x4){pos[0], pos[1], pos[2], pos[3]};
#pragma unroll
            for (int s4 = 0; s4 < 4; ++s4) list[(size_t)ti[s4] * ML + pos[s4]] = row; }
        __syncthreads();
    }
#undef LN1_LOAD
}

struct MoeTab { const LAS int* cnt; const LAS int* pstart; };
__device__ __forceinline__ void moe_tables(Frame& F) {
    LAS int* cnt = (LAS int*)(F.lds + TAB_OFF); LAS int* ps = cnt + 32;
    if (F.tid < 32) cnt[F.tid] = (int)__hip_atomic_load(F.ctl + CW_CNT + 64 * F.tid, __ATOMIC_RELAXED, __HIP_MEMORY_SCOPE_AGENT);
    __syncthreads();
    if (F.tid < 64) { const int e = F.tid & 31; const int pad = (cnt[e] + 255) / 256 * 256; int inc = pad;
#pragma unroll
        for (int off = 1; off < 32; off <<= 1) { const int t = __shfl_up(inc, off); if (e >= off) inc += t; }
        if (F.tid < 32) { ps[e] = inc - pad; if (e == 31) ps[32] = inc; } }
    __syncthreads();
    if (F.tid < MAXTILES) { int e = 0; const int r = F.tid * 256;
#pragma unroll
        for (int q = 1; q < 32; ++q) e = (ps[q] <= r) ? q : e;
        ps[48 + F.tid] = e; }
    __syncthreads();
}
__device__ __forceinline__ int moe_tile_expert(const LAS int* ps, int tile) { return ps[48 + tile]; }

struct MoeUp {
    static constexpr bool PERM = true, GATHER = true, FP8 = true, BBLK = true;
    int K, NB; const char* A; const char* Wg; const char* Wu; unsigned char* H; const float* bg; const float* bu; const int* list; const LAS int* cnt; const LAS int* ps; const LAS int* gtab; int G, c;
    __device__ __forceinline__ bool next(int i, Unit& u) const {
        const int NT = ps[32] / 256, NU = NT * 16, L = i * G + c; if (L >= NU) return false;
        pg8::tile_order(L, NT, 16, u.pm, u.pn); u.e = moe_tile_expert(ps, u.pm); return true;
    }
    __device__ __forceinline__ const char* bptr(const Unit& u, int half) const { return (half ? Wu : Wg) + (size_t)u.e * D * D + (size_t)(u.pn * 128) * 16; }
    __device__ __forceinline__ unsigned arow(const Unit& u, int r) const { const int loc = u.pm * 256 + r - ps[u.e]; return loc < cnt[u.e] ? (unsigned)list[(size_t)u.e * ML + loc] : 0u; }
    __device__ __forceinline__ unsigned arow_i(int ord, const Unit&, int r) const { return (unsigned)gtab[ord * 256 + r]; }
    struct Pre { f32x4 g0, g1, u0, u1; };
    __device__ __forceinline__ Pre prefetch(const Unit& u, int wr, int wc, int fr, int fq) const { const int col0 = u.pn * 128 + wc * 32 + 8 * fq; Pre p;
        p.g0 = *(const f32x4*)(bg + (size_t)u.e * D + col0); p.g1 = *(const f32x4*)(bg + (size_t)u.e * D + col0 + 4); p.u0 = *(const f32x4*)(bu + (size_t)u.e * D + col0); p.u1 = *(const f32x4*)(bu + (size_t)u.e * D + col0 + 4); return p; }
    __device__ __forceinline__ void epi(const f32x4 (&acc)[2][2][4][2], const Unit& u, int wr, int wc, int fr, int fq, const Pre& pre) const {
        const int row0 = u.pm * 256 + wr * 64 + fr, col0 = u.pn * 128 + wc * 32 + 8 * fq;
        const f32x4 g0 = pre.g0, g1 = pre.g1, u0 = pre.u0, u1 = pre.u1;
#pragma unroll
        for (int ai = 0; ai < 2; ++ai)
#pragma unroll
            for (int m = 0; m < 4; ++m) { float hv[8];
#pragma unroll
                for (int n = 0; n < 2; ++n)
#pragma unroll
                    for (int jp = 0; jp < 2; ++jp) { const int j = 2 * jp;
                        const f32x2 bgv = n ? (f32x2){g1[j], g1[j + 1]} : (f32x2){g0[j], g0[j + 1]}, buv = n ? (f32x2){u1[j], u1[j + 1]} : (f32x2){u0[j], u0[j + 1]};
                        f32x2 glu = (f32x2){acc[ai][0][m][n][j], acc[ai][0][m][n][j + 1]} * (1.f / W8_SCALE) + bgv, lin = (f32x2){acc[ai][1][m][n][j], acc[ai][1][m][n][j + 1]} * (1.f / W8_SCALE) + buv;
                        glu.x = fminf(glu.x, 7.0f); glu.y = fminf(glu.y, 7.0f); lin.x = __builtin_amdgcn_fmed3f(lin.x, -7.0f, 7.0f); lin.y = __builtin_amdgcn_fmed3f(lin.y, -7.0f, 7.0f);
                        const f32x2 ea = glu * (-1.702f * 1.4426950408889634f); f32x2 dn; dn.x = __builtin_amdgcn_exp2f(ea.x); dn.y = __builtin_amdgcn_exp2f(ea.y); dn = dn + 1.0f;
                        f32x2 sg; sg.x = __builtin_amdgcn_rcpf(dn.x); sg.y = __builtin_amdgcn_rcpf(dn.y);
                        const f32x2 hh2 = (glu * sg) * (lin * H8_SCALE + H8_SCALE); hv[4 * n + j] = hh2.x; hv[4 * n + j + 1] = hh2.y; }
                *(u32x2*)(H + (size_t)(row0 + ai * 128 + m * 16) * D + col0) = (u32x2){pk_fp8x4(hv[0], hv[1], hv[2], hv[3]), pk_fp8x4(hv[4], hv[5], hv[6], hv[7])}; }
    }
};
struct MoeDown {
    static constexpr bool PERM = true, GATHER = false, FP8 = true, BBLK = true;
    int K, NB; const char* A; const char* Wd; unsigned char* O; const float* bd; const LAS int* ps; int G, c;
    __device__ __forceinline__ bool next(int i, Unit& u) const {
        const int NT = ps[32] / 256, NU = NT * 8, L = i * G + c; if (L >= NU) return false;
        pg8::tile_order(L, NT, 8, u.pm, u.pn); u.e = moe_tile_expert(ps, u.pm); return true;
    }
    __device__ __forceinline__ const char* bptr(const Unit& u, int half) const { return Wd + (size_t)u.e * D * D + (size_t)(u.pn * 256 + half * 128) * 16; }
    __device__ __forceinline__ unsigned arow_i(int, const Unit& u, int r) const { return (unsigned)(u.pm * 256 + r); }
    struct Pre { f32x4 c[2][2]; };
    __device__ __forceinline__ Pre prefetch(const Unit& u, int wr, int wc, int fr, int fq) const { const int col0 = u.pn * 256 + wc * 32 + 8 * fq; Pre p;
#pragma unroll
        for (int bj = 0; bj < 2; ++bj) { p.c[bj][0] = *(const f32x4*)(bd + (size_t)u.e * D + col0 + bj * 128); p.c[bj][1] = *(const f32x4*)(bd + (size_t)u.e * D + col0 + bj * 128 + 4); }
        return p; }
    __device__ __forceinline__ void epi(const f32x4 (&acc)[2][2][4][2], const Unit& u, int wr, int wc, int fr, int fq, const Pre& pre) const {
        const int row0 = u.pm * 256 + wr * 64 + fr, col0 = u.pn * 256 + wc * 32 + 8 * fq;
#pragma unroll
        for (int bj = 0; bj < 2; ++bj) { const f32x4 c0 = pre.c[bj][0], c1 = pre.c[bj][1];
#pragma unroll
            for (int ai = 0; ai < 2; ++ai)
#pragma unroll
                for (int m = 0; m < 4; ++m) { const f32x4 v0 = acc[ai][bj][m][0] * (O8_SCALE / (W8_SCALE * H8_SCALE)) + c0 * O8_SCALE, v1 = acc[ai][bj][m][1] * (O8_SCALE / (W8_SCALE * H8_SCALE)) + c1 * O8_SCALE;
#define SAT8(x) __builtin_amdgcn_fmed3f((x), -448.f, 448.f)
                    *(u32x2*)(O + (size_t)(row0 + ai * 128 + m * 16) * D + col0 + bj * 128) = (u32x2){pk_fp8x4(SAT8(v0[0]), SAT8(v0[1]), SAT8(v0[2]), SAT8(v0[3])), pk_fp8x4(SAT8(v1[0]), SAT8(v1[1]), SAT8(v1[2]), SAT8(v1[3]))}; } }
#undef SAT8
    }
};

__device__ __forceinline__ void p10_final(Frame& F) {
    int tz_ = threadIdx.x; asm volatile("" : "+v"(tz_));
    const int tid_ = tz_, lane_ = tz_ & 63, wave_ = __builtin_amdgcn_readfirstlane(tz_ >> 6);
    const LAS int* ps = (const LAS int*)(F.lds + TAB_OFF) + 32;
    const unsigned char* O = WSP(const unsigned char, WS_O); const float* modf = WSP(const float, WS_MODF); const bf16_t* V = WSP(const bf16_t, WS_V); const f32x2* st1 = WSP(const f32x2, WS_STAT1);
    const float* g1 = F.in[I_LN1G]; const float* b1 = F.in[I_LN1B];
    const i32x4* toke = WSP(const i32x4, WS_TOKE); const i32x4* tokp = WSP(const i32x4, WS_TOKP); const f32x4* tokg = WSP(const f32x4, WS_TOKG);
    const float* g2 = F.in[I_LN2G]; const float* b2 = F.in[I_LN2B];
    const int gw = F.bid * 8 + wave_, NGW = F.G * 8;
    LAS float* PL = (LAS float*)F.lds;
    for (int i = tid_; i < D; i += 512) { PL[i] = g1[i]; PL[D + i] = b1[i]; PL[2 * D + i] = g2[i]; PL[3 * D + i] = b2[i]; PL[4 * D + i] = modf[5 * D + i]; PL[5 * D + i] = modf[(size_t)(6 * D) + 5 * D + i]; }
    __syncthreads();
    if (gw >= ML) return;
    i32x4 ne = toke[gw], np = tokp[gw]; f32x4 ng = tokg[gw];
    unsigned own[4][8]; u32x2 hwn[8]; f32x2 srn; f32x4 cgn;
#define FIN_GATHER(row_) do { _Pragma("unroll") for (int _s = 0; _s < 4; ++_s) { const unsigned* _or = (const unsigned*)(O + (size_t)(ps[ne[_s]] + np[_s]) * D) + lane_; \
            _Pragma("unroll") for (int _j = 0; _j < 8; ++_j) own[_s][_j] = _or[64 * _j]; } \
        { const u32x2* _hr = (const u32x2*)(V + (size_t)(row_) * D) + lane_; _Pragma("unroll") for (int _j = 0; _j < 8; ++_j) hwn[_j] = _hr[64 * _j]; } \
        srn = st1[row_]; cgn = ng; } while (0)
    FIN_GATHER(gw);
    if (gw + NGW < ML) { ne = toke[gw + NGW]; np = tokp[gw + NGW]; ng = tokg[gw + NGW]; }
    for (int row = gw; row < ML; row += NGW) {
        unsigned ow[4][8]; u32x2 hw[8];
#pragma unroll
        for (int s4 = 0; s4 < 4; ++s4)
#pragma unroll
            for (int j = 0; j < 8; ++j) ow[s4][j] = own[s4][j];
#pragma unroll
        for (int j = 0; j < 8; ++j) hw[j] = hwn[j];
        const f32x2 sr = srn; const f32x4 cg = cgn;
        if (row + NGW < ML) { FIN_GATHER(row + NGW);
            if (row + 2 * NGW < ML) { ne = toke[row + 2 * NGW]; np = tokp[row + 2 * NGW]; ng = tokg[row + 2 * NGW]; } }
        const LAS float* gt2 = PL + 4 * D + (row / SEQ) * D;
        f32x4 f[8]; float s = 0.f;
#pragma unroll
        for (int j = 0; j < 8; ++j) { f32x4 a = {0.f, 0.f, 0.f, 0.f};
#pragma unroll
            for (int s4 = 0; s4 < 4; ++s4) { const unsigned w = ow[s4][j]; const f32x2 lo = __builtin_amdgcn_cvt_pk_f32_fp8((int)w, false), hi = __builtin_amdgcn_cvt_pk_f32_fp8((int)w, true); a += (f32x4){lo.x, lo.y, hi.x, hi.y} * (cg[s4] * (1.f / O8_SCALE)); }
            const int d = 4 * lane_ + 256 * j; const u32x2 h = hw[j];
            const f32x4 h1 = ((f32x4){bf_lo(h.x), bf_hi(h.x), bf_lo(h.y), bf_hi(h.y)} - sr.x) * sr.y * *(const LAS f32x4*)(PL + d) + *(const LAS f32x4*)(PL + D + d);
            f[j] = h1 * DN_ALPHA + *(const LAS f32x4*)(gt2 + d) * a; s += (f[j].x + f[j].y) + (f[j].z + f[j].w);
            if (j & 1) __builtin_amdgcn_sched_barrier(0); }
        const float mean = wave_sum(s) * (1.f / D); float s2 = 0.f;
#pragma unroll
        for (int j = 0; j < 8; ++j) { f[j] = f[j] - mean; s2 += (f[j].x * f[j].x + f[j].y * f[j].y) + (f[j].z * f[j].z + f[j].w * f[j].w); }
        const float rstd = __builtin_amdgcn_rsqf(wave_sum(s2) * (1.f / D) + LN_EPS);
        f32x4* orw = (f32x4*)(F.out + (size_t)row * D) + lane_;
#pragma unroll
        for (int j = 0; j < 8; ++j) { const int d = 4 * lane_ + 256 * j; orw[64 * j] = f[j] * rstd * *(const LAS f32x4*)(PL + 2 * D + d) + *(const LAS f32x4*)(PL + 3 * D + d); }
    }
#undef FIN_GATHER
}

constexpr int NPHASE = 12;
__global__ void __launch_bounds__(512, 2) fwd_kernel(Args args) {
    extern __shared__ __attribute__((aligned(16))) unsigned char lds_raw[];
    Frame F;
    F.lds = (LAS unsigned char*)lds_raw; F.MISC = (volatile LAS unsigned*)(F.lds + MISC_OFF);
    F.tid = threadIdx.x; F.lane = F.tid & 63; F.wave = __builtin_amdgcn_readfirstlane(F.tid >> 6); F.G = gridDim.x; F.bid = blockIdx.x;
    F.ws = args.ws; F.ctl = (unsigned*)(args.ws + WS_CTL); F.in = args.in; F.out = args.out;
    if (F.tid < 128) ((LAS unsigned*)(F.lds + MISC_OFF))[F.tid] = 0u;
    __syncthreads();
    const int lo = args.ph_lo, hi = args.ph_hi;
    XcdBarrier bar; bar.bar = F.ctl + CW_BAR + args.li * XCD_BAR_WORDS; bar.x = 0; bar.st = nullptr;
    if (hi - lo > 1) bar = xcd_barrier_post(F.ctl + CW_BAR + args.li * XCD_BAR_WORDS, F.MISC);
#ifndef PH_MASK
#define PH_MASK 0xfff
#endif
#define IN(k) (((PH_MASK >> (k)) & 1) && lo <= (k) && (k) < hi)
#define SEAM(k) do { if (IN(k) && IN((k) + 1)) xcd_barrier(bar); } while (0)
#ifndef PROBE_DBL
#define PROBE_DBL -1
#endif
#define REP(k) for (int _rep = 0; _rep < ((PROBE_DBL == (k)) ? 2 : 1); ++_rep)
    if (IN(0)) REP(0) { p0_prologue(F); if (PROBE_DBL == 0) { VM_WAIT(); __syncthreads(); } } SEAM(0);
    if (IN(1)) REP(1) { p1_ln0(F); if (PROBE_DBL == 1) { VM_WAIT(); __syncthreads(); } } SEAM(1);
    if (IN(2)) REP(2) { const int gconv = (F.G > 2 * NCONV_WG) ? NCONV_WG : 0, ggemm = F.G - gconv;
                 if (F.bid < ggemm) { InProj S{D, (const char*)WSP(bf16_t, WS_HM), (const char*)WSP(bf16_t, WS_WIN), WSP(bf16_t, WS_P), ggemm, F.bid}; pg8::gemm_phase(F.lds, S); }
                 else if (PROBE_DBL != 2 || _rep == 0) convert_experts(F, (F.bid - ggemm) * 8 + F.wave, gconv * 8, 0, ti_early(F.G)); } SEAM(2);
    if (IN(3)) REP(3) { p3a_tokens(F); if (PROBE_DBL == 3) { VM_WAIT(); __syncthreads(); } } SEAM(3);
    if (IN(4)) REP(4) { p3_prep(F); if (PROBE_DBL == 4) { VM_WAIT(); __syncthreads(); } } SEAM(4);
    if (IN(5)) { p4_scan(F); if (PROBE_DBL == 5) { VM_WAIT(); __syncthreads(); p4_scan(F); } } SEAM(5);
    if (IN(6)) REP(6) { p5_mix_out(F); if (PROBE_DBL == 6) { VM_WAIT(); __syncthreads(); } } SEAM(6);
    if (IN(7)) REP(7) { OutProj S{D, (const char*)WSP(bf16_t, WS_Y), (const char*)WSP(bf16_t, WS_WOUT), WSP(bf16_t, WS_V), F.in[I_X], WSP(const f32x2, WS_STAT0), F.in[I_LN0G], F.in[I_LN0B], WSP(const float, WS_MODF), F.G, F.bid};
                 pg8::gemm_phase(F.lds, S); } SEAM(7);
    if (IN(8)) { p7_ln1_router(F); } SEAM(8);
    if (IN(9) || IN(10) || IN(11)) moe_tables(F);
    if (IN(9)) REP(9) { const LAS int* cnt = (const LAS int*)(F.lds + TAB_OFF);
                 LAS int* gtab = (LAS int*)(F.lds + GTAB_OFF);
                 MoeUp S{D / 2, D, (const char*)WSP(unsigned char, WS_U), (const char*)WSP(unsigned char, WS_WG), (const char*)WSP(unsigned char, WS_WU), WSP(unsigned char, WS_H), F.in[I_BGATE], F.in[I_BUP], WSP(const int, WS_LIST), cnt, cnt + 32, gtab, F.G, F.bid};
                 { int gi[GTAB_UNITS / 2];
#pragma unroll
                   for (int k = 0; k < GTAB_UNITS / 2; ++k) { const int i = 2 * k + (F.tid >> 8); Unit u; gi[k] = -1; if (S.next(i, u)) gi[k] = (int)S.arow(u, F.tid & 255); }
#pragma unroll
                   for (int k = 0; k < GTAB_UNITS / 2; ++k) { const int i = 2 * k + (F.tid >> 8); if (gi[k] >= 0) gtab[i * 256 + (F.tid & 255)] = gi[k]; } }
                 __syncthreads();
                 pg8::gemm_phase(F.lds, S); } SEAM(9);
    if (IN(10)) REP(10) { const LAS int* cnt = (const LAS int*)(F.lds + TAB_OFF);
                 MoeDown S{D / 2, D, (const char*)WSP(unsigned char, WS_H), (const char*)WSP(unsigned char, WS_WD), WSP(unsigned char, WS_O), F.in[I_BDOWN], cnt + 32, F.G, F.bid};
                 pg8::gemm_phase(F.lds, S); } SEAM(10);
    if (IN(11)) { p10_final(F); }
#undef IN
#undef SEAM
}

extern "C" void kernel_launch(void* const* d_in, const int* in_sizes, int n_in, void* d_out, int out_size, void* d_ws, size_t ws_size, hipStream_t stream) {
    static int grid = 0;
    if (grid == 0) {
        if (n_in != 27 || out_size != ML * D || ws_size < WS_END) { fprintf(stderr, "kernel_launch: unexpected problem (n_in %d, out %d, ws %zu < %zu)\n", n_in, out_size, ws_size, (size_t)WS_END); grid = -1; return; }
        int dev = 0, cus = 0, per_cu = 0;
        if (hipGetDevice(&dev) != hipSuccess || hipDeviceGetAttribute(&cus, hipDeviceAttributeMultiprocessorCount, dev) != hipSuccess) { grid = -1; return; }
        if (hipFuncSetAttribute((const void*)fwd_kernel, hipFuncAttributeMaxDynamicSharedMemorySize, LDS_BYTES) != hipSuccess) { fprintf(stderr, "kernel_launch: hipFuncSetAttribute failed\n"); grid = -1; return; }
        if (hipOccupancyMaxActiveBlocksPerMultiprocessor(&per_cu, (const void*)fwd_kernel, 512, LDS_BYTES) != hipSuccess || per_cu < 1) { fprintf(stderr, "kernel_launch: occupancy query says %d\n", per_cu); }
        (void)hipGetLastError();
        grid = cus;
    }
    if (grid < 0) return;
    if (hipMemsetAsync((char*)d_ws + WS_CTL, 0, CTL_BYTES, stream) != hipSuccess) return;
    Args a{};
    for (int i = 0; i < 27; ++i) a.in[i] = (const float*)d_in[i];
    a.out = (float*)d_out; a.ws = (unsigned char*)d_ws; a.pad = 0;
#if MK_N_LAUNCHES == 1
    a.ph_lo = 0; a.ph_hi = NPHASE; a.li = 0;
    hipLaunchKernelGGL(fwd_kernel, dim3(grid), dim3(512), LDS_BYTES, stream, a);
#else
    for (int p = 0; p < NPHASE; ++p) { a.ph_lo = p; a.ph_hi = p + 1; a.li = 0; hipLaunchKernelGGL(fwd_kernel, dim3(grid), dim3(512), LDS_BYTES, stream, a); }
#endif
}
```

```cpp
#include <hip/hip_runtime.h>
#include <cstdio>
#include <cstdint>

#ifndef MK_N_LAUNCHES
#define MK_N_LAUNCHES 1
#endif

#define LAS __attribute__((address_space(3)))
#define GAS __attribute__((address_space(1)))
typedef unsigned short bf16_t;
typedef short bf16x8 __attribute__((ext_vector_type(8)));
typedef float f32x4 __attribute__((ext_vector_type(4)));
typedef float f32x2 __attribute__((ext_vector_type(2)));
typedef unsigned u32x4 __attribute__((ext_vector_type(4)));
typedef unsigned u32x2 __attribute__((ext_vector_type(2)));

constexpr int D = 2048, NBATCH = 2, SEQ = 8192, ML = NBATCH * SEQ, CTXL = 256, MC = NBATCH * CTXL, MTOT = ML + MC;
constexpr int NH = 8, DK = 128, GQK = 1024, GQKV = 3072, GIN = 3104, NIN = 7200, NINP = 7424;
constexpr int COL_A = 3072, COL_B = 3088, COL_Z = 3104, COL_SB = 4128, COL_SC = 5152, COL_SX = 6176;
constexpr int NE = 32, TOPK = 4, MAXROWS = ML * TOPK + NE * 256, MAXTILES = MAXROWS / 256;
constexpr float LN_EPS = 1e-5f, RMS_EPS = 1e-6f;
constexpr float DN_ALPHA = 1.189207115002721f;
constexpr int NPART = 8;

constexpr size_t MiB = 1ull << 20;
constexpr size_t WS_CTL = 0, CTL_BYTES = 64 * 1024;
constexpr size_t WS_MODP = 1 * MiB;
constexpr size_t WS_MODF = 3 * MiB;
constexpr size_t WS_STAT0 = 4 * MiB;
constexpr size_t WS_STAT1 = 4 * MiB + 512 * 1024;
constexpr size_t WS_TOKE = 5 * MiB;
constexpr size_t WS_TOKP = WS_TOKE + 256 * 1024;
constexpr size_t WS_TOKG = WS_TOKP + 256 * 1024;
constexpr size_t WS_LIST = 6 * MiB;
constexpr size_t WS_WIN = 8 * MiB;
constexpr size_t WS_WOUT = 38 * MiB;
constexpr size_t WS_WG = 48 * MiB, WS_WU = 304 * MiB, WS_WD = 560 * MiB;
constexpr size_t WS_HM = 816 * MiB;
constexpr size_t WS_P = 882 * MiB;
constexpr size_t WS_PREP = 1122 * MiB;
constexpr size_t WS_OGB = 1424 * MiB;
constexpr size_t WS_Y = 1488 * MiB;
constexpr size_t WS_V = 1552 * MiB;
constexpr size_t WS_H1B = 1616 * MiB;
constexpr size_t WS_U = 1680 * MiB;
constexpr size_t WS_H = 882 * MiB;
constexpr size_t WS_O = 1170 * MiB;
constexpr size_t WS_END = 1744 * MiB;
constexpr size_t WS_QKVB = WS_V;
constexpr size_t WS_GBF = WS_U;
#ifdef GDN_NAIVE
constexpr size_t WS_QKV = 1744 * MiB;
constexpr size_t WS_GB = 1942 * MiB;
constexpr size_t WS_OG = 1946 * MiB;
#endif
constexpr int NCHUNK = (CTXL + SEQ) / 64, NUNITS = NBATCH * NCHUNK * NH * 2;
constexpr int UNIT_BYTES = 74752, UO_NW = 0, UO_QD = 16384, UO_KDT = 32768, UO_QK = 49152, UO_U = 57344, UO_DL = 73728, UNIT_DMA = 74752;
static_assert(WS_WIN + (size_t)NINP * D * 2 <= WS_WOUT && WS_P + (size_t)MTOT * NINP * 2 <= WS_PREP && WS_PREP + (size_t)NUNITS * UNIT_BYTES <= WS_OGB, "ws map");
static_assert(WS_H + (size_t)MAXROWS * D * 2 <= WS_O && WS_O + (size_t)MAXROWS * D * 2 <= WS_Y && WS_OGB + (size_t)2 * ML * 1024 * 2 <= WS_Y, "ws map 2");
constexpr int CW_CNT = 1024;
constexpr int CW_BAR = 8192;

constexpr int LDS_BYTES = 155648;
constexpr int MISC_OFF = 155136;
constexpr int GTAB_OFF = 131072, GTAB_UNITS = 18;
constexpr int TAB_OFF = 151552;

__device__ __forceinline__ unsigned cvt_pk_bf16(float lo, float hi) { unsigned r; asm volatile("v_cvt_pk_bf16_f32 %0, %1, %2" : "=v"(r) : "v"(lo), "v"(hi)); return r; }
__device__ __forceinline__ float bf_lo(unsigned w) { return __uint_as_float(w << 16); }
__device__ __forceinline__ float bf_hi(unsigned w) { return __uint_as_float(w & 0xffff0000u); }
__device__ __forceinline__ float bf2f(bf16_t b) { return __uint_as_float(((unsigned)b) << 16); }
__device__ __forceinline__ float silu_f(float x) { return x * __builtin_amdgcn_rcpf(1.0f + __expf(-x)); }
__device__ __forceinline__ float sigmoid_f(float x) { return __builtin_amdgcn_rcpf(1.0f + __expf(-x)); }
__device__ __forceinline__ float softplus_f(float x) { return x > 20.f ? x : log1pf(__expf(x)); }
__device__ __forceinline__ float wave_sum(float v) {
#pragma unroll
    for (int o = 1; o < 64; o <<= 1) v += __shfl_xor(v, o);
    return v;
}
typedef int i32x8 __attribute__((ext_vector_type(8)));
typedef int i32x4 __attribute__((ext_vector_type(4)));
__device__ __forceinline__ unsigned pk_fp8x4(float a, float b, float c, float d) { int w = __builtin_amdgcn_cvt_pk_fp8_f32(a, b, 0, false); w = __builtin_amdgcn_cvt_pk_fp8_f32(c, d, w, true); return (unsigned)w; }
constexpr float W8_SCALE = 64.f, H8_SCALE = 8.f, O8_SCALE = 16.f;
#define LDS_WAIT() asm volatile("s_waitcnt lgkmcnt(0)" ::: "memory")
#define VM_WAIT() asm volatile("s_waitcnt vmcnt(0)" ::: "memory")

#define XB_TMO      128
#define XB_XCNT(j)  (256  + 64 * (j))
#define XB_XSUB(j)  (1280 + 64 * (j))
#define XB_XGEN(j)  (2304 + 64 * (j))
#define XB_TOP      3328
#define XB_TOPGEN   3392
#define XCD_BAR_WORDS 3456
#define XB_SPIN_CAP (1u << 22)

__device__ __forceinline__ unsigned xb_ld(unsigned* p)              { return __hip_atomic_load(p, __ATOMIC_RELAXED, __HIP_MEMORY_SCOPE_AGENT); }
__device__ __forceinline__ unsigned xb_add(unsigned* p, unsigned v) { return __hip_atomic_fetch_add(p, v, __ATOMIC_RELAXED, __HIP_MEMORY_SCOPE_AGENT); }
__device__ __forceinline__ unsigned xb_xcc_id() { return (unsigned)__builtin_amdgcn_s_getreg((3 << 11) | 20) & 0xFu; }
#define XB_SPIN(cond, bar) do { unsigned _sp = 0; while (cond) { __builtin_amdgcn_s_sleep(1); \
    if ((++_sp & 255u) == 0u) { if (xb_ld(&(bar)[XB_TMO])) break; if (_sp > XB_SPIN_CAP) { atomicAdd(&(bar)[XB_TMO], 1u); break; } } } } while (0)

struct XcdBarrier { unsigned* bar; unsigned x; volatile LAS unsigned* st; };

__device__ __forceinline__ XcdBarrier xcd_barrier_post(unsigned* bar, volatile LAS unsigned* st) {
    XcdBarrier b; b.bar = bar; b.x = xb_xcc_id(); b.st = st;
    if (threadIdx.x == 0) (void)xb_add(&bar[XB_XCNT(b.x)], 1u);
    return b;
}
__device__ __forceinline__ void xcd_barrier_complete(unsigned* bar, unsigned x, unsigned& nloc, unsigned& nx) {
    const unsigned G = gridDim.x * gridDim.y * gridDim.z;
    unsigned sum, cnt, mine, sp = 0u;
    for (;;) {
        sum = 0u; cnt = 0u; mine = 0u;
#pragma unroll
        for (unsigned j = 0; j < 16; ++j) { const unsigned c = xb_ld(&bar[XB_XCNT(j)]); sum += c; cnt += (c > 0u) ? 1u : 0u; mine = (j == x) ? c : mine; }
        if (sum == G) break;
        __builtin_amdgcn_s_sleep(1);
        if ((++sp & 255u) == 0u) { if (xb_ld(&bar[XB_TMO])) break; if (sp > XB_SPIN_CAP) { atomicAdd(&bar[XB_TMO], 1u); break; } }
    }
    nloc = mine > 0u ? mine : 1u; nx = cnt > 0u ? cnt : 1u;
}
__device__ __forceinline__ void xcd_barrier(const XcdBarrier& b) {
    asm volatile("s_waitcnt vmcnt(0)" ::: "memory");
    __syncthreads();
    if (threadIdx.x == 0) {
        unsigned* bar = b.bar;
        __builtin_amdgcn_s_waitcnt(0);
        unsigned nloc = b.st[0], nx = b.st[1];
        if (nloc == 0u) { xcd_barrier_complete(bar, b.x, nloc, nx); b.st[0] = nloc; b.st[1] = nx; }
        const unsigned old = xb_add(&bar[XB_XSUB(b.x)], 1u);
        const unsigned gen = old / nloc;
        if (old + 1u == (gen + 1u) * nloc) {
            __builtin_amdgcn_fence(__ATOMIC_RELEASE, "agent");
            asm volatile("s_waitcnt vmcnt(0)" ::: "memory");
            const unsigned og = xb_add(&bar[XB_TOP], 1u);
            const unsigned tg = og / nx;
            if (og + 1u == (tg + 1u) * nx) xb_add(&bar[XB_TOPGEN], 1u);
            else XB_SPIN(xb_ld(&bar[XB_TOPGEN]) == tg, bar);
            __builtin_amdgcn_fence(__ATOMIC_ACQUIRE, "agent");
            xb_add(&bar[XB_XGEN(b.x)], 1u);
            asm volatile("s_waitcnt vmcnt(0)" ::: "memory");
        } else {
            XB_SPIN(xb_ld(&bar[XB_XGEN(b.x)]) == gen, bar);
            __builtin_amdgcn_fence(__ATOMIC_ACQUIRE, "agent");
            asm volatile("s_waitcnt vmcnt(0)" ::: "memory");
        }
    }
    __syncthreads();
}

struct Args { const float* in[27]; float* out; unsigned char* ws; int ph_lo, ph_hi, li, pad; };
enum { I_X = 0, I_C, I_CTX, I_CCTX, I_LN0G, I_LN0B, I_WADA, I_BADA, I_WIN, I_CONVQKV, I_ALOG, I_DTB, I_GNW, I_CONVSC, I_WOUT, I_LN1G, I_LN1B, I_WR, I_BR,
       I_WGATE, I_BGATE, I_WUP, I_BUP, I_WDOWN, I_BDOWN, I_LN2G, I_LN2B };

namespace pg8 {
constexpr int BM = 256, BK = 64, HALF = 128, HTB = HALF * BK * 2, STAGE_BYTES = 8 * HTB, NXCD = 8, WGM = 8;
__host__ __device__ __forceinline__ int lds_byte(int r, int c) { const int st = (r >> 4) * 2 + (c >> 5), rr = r & 15, cc = c & 31, ob = rr * 64 + cc * 2; return st * 1024 + (ob ^ (((ob >> 9) & 1) << 5)); }
__host__ __device__ __forceinline__ void stage_rc(int b, int& R, int& C) { const int st = b / 1024, sb = b % 1024, swz = sb ^ (((sb >> 9) & 1) << 5); R = (st >> 1) * 16 + swz / 64; C = (st & 1) * 32 + (swz % 64) / 2; }
__host__ __device__ __forceinline__ int perm32(int rho) { const int n = rho >> 4, i = rho & 15; return 8 * (i >> 2) + 4 * n + (i & 3); }

struct Unit { int pm, pn, e; };
__device__ __forceinline__ void tile_order(int L, int nM, int nN, int& pm, int& pn) {
    const int nwg = nM * nN; int wgid = L;
    { const int q = nwg / NXCD, r = nwg % NXCD, xcd = wgid % NXCD, off = wgid / NXCD; wgid = (xcd < r ? xcd * (q + 1) : r * (q + 1) + (xcd - r) * q) + off; }
    const int nig = WGM * nN, gid = wgid / nig, fm = gid * WGM, gsz = (nM - fm) < WGM ? (nM - fm) : WGM;
    pm = fm + ((wgid % nig) % gsz); pn = (wgid % nig) / gsz;
}

template <class P>
__device__ __forceinline__ void gemm_phase(LAS unsigned char* lds, const P& S) {
    int tid = threadIdx.x; asm volatile("" : "+v"(tid));
    const int wid = __builtin_amdgcn_readfirstlane(tid >> 6), lane = tid & 63, wr = wid >> 2, wc = wid & 3, fr = lane & 15, fq = lane >> 4;
    const int K = S.K, nt = K / BK;
    unsigned voffB[2]; int RA[2], CA[2];
#pragma unroll
    for (int i = 0; i < 2; ++i) { int R, C; stage_rc(tid * 16 + i * 8192, R, C); const int Rb = P::PERM ? ((R & ~31) + perm32(R & 31)) : R;
        RA[i] = R; CA[i] = C; if constexpr (P::BBLK) voffB[i] = (unsigned)((C >> 3) * S.NB + Rb) * 16u; else voffB[i] = (unsigned)(Rb * K + C) * 2u; }
    const size_t kstep = (size_t)(BK * 2);
    size_t kstepB = kstep; if constexpr (P::BBLK) kstepB = (size_t)128 * (size_t)S.NB;
    const unsigned ldsw = (unsigned)wid * 1024u;
    const int aoff = lds_byte(wr * 64 + fr, fq * 8), boff = lds_byte(wc * 32 + fr, fq * 8);
#define PG8_SA(b, h) (((b) * 2 + (h)) * HTB)
#define PG8_SB(b, h) ((4 + (b) * 2 + (h)) * HTB)
#define PG8_STAGE_B(bufoff, gbase) do { _Pragma("unroll") for (int _i = 0; _i < 2; ++_i) \
        __builtin_amdgcn_global_load_lds((const unsigned*)((const char*)(gbase) + voffB[_i]), (LAS unsigned*)(lds + (bufoff) + ldsw + _i * 8192), 16, 0, 0); } while (0)
#define PG8_STAGE_A(bufoff, AO, h, kb) do { _Pragma("unroll") for (int _i = 0; _i < 2; ++_i) \
        __builtin_amdgcn_global_load_lds((const unsigned*)(S.A + (size_t)(AO)[h][_i] + (size_t)(kb)), (LAS unsigned*)(lds + (bufoff) + ldsw + _i * 8192), 16, 0, 0); } while (0)
#define PG8_LDA(dst, b, h) do { _Pragma("unroll") for (int m = 0; m < 4; ++m) { dst[m].lo = *(const LAS i32x4*)(lds + PG8_SA(b, h) + aoff + m * 2048); dst[m].hi = *(const LAS i32x4*)(lds + PG8_SA(b, h) + aoff + m * 2048 + 1024); } } while (0)
#define PG8_LDB(dst, b, h) do { _Pragma("unroll") for (int n = 0; n < 2; ++n) { dst[n].lo = *(const LAS i32x4*)(lds + PG8_SB(b, h) + boff + n * 2048); dst[n].hi = *(const LAS i32x4*)(lds + PG8_SB(b, h) + boff + n * 2048 + 1024); } } while (0)
#define PG8_MMA(ai, bj, At, Bt) do { __builtin_amdgcn_s_setprio(1); \
        if constexpr (P::FP8) { _Pragma("unroll") for (int m = 0; m < 4; ++m) _Pragma("unroll") for (int n = 0; n < 2; ++n) \
            { FP8_MMA_ONE(acc[ai][bj][m][n], Bt[n], At[m]); } } \
        else { _Pragma("unroll") for (int m = 0; m < 4; ++m) _Pragma("unroll") for (int n = 0; n < 2; ++n) { \
            const i32x4 _bl = __builtin_shufflevector(Bt[n], Bt[n], 0, 1, 2, 3), _bh = __builtin_shufflevector(Bt[n], Bt[n], 4, 5, 6, 7), _al = __builtin_shufflevector(At[m], At[m], 0, 1, 2, 3), _ah = __builtin_shufflevector(At[m], At[m], 4, 5, 6, 7); \
            acc[ai][bj][m][n] = __builtin_amdgcn_mfma_f32_16x16x32_bf16(__builtin_bit_cast(bf16x8, _bl), __builtin_bit_cast(bf16x8, _al), acc[ai][bj][m][n], 0, 0, 0); \
            acc[ai][bj][m][n] = __builtin_amdgcn_mfma_f32_16x16x32_bf16(__builtin_bit_cast(bf16x8, _bh), __builtin_bit_cast(bf16x8, _ah), acc[ai][bj][m][n], 0, 0, 0); } } \
        __builtin_amdgcn_s_setprio(0); } while (0)
typedef int i32x2 __attribute__((ext_vector_type(2)));
#ifdef FP8_LEGACY_MFMA
#define FP8_MMA_ONE(c, b8, a8) do { \
        const i32x2 _b0 = __builtin_shufflevector(b8, b8, 0, 1), _b1 = __builtin_shufflevector(b8, b8, 2, 3), _b2 = __builtin_shufflevector(b8, b8, 4, 5), _b3 = __builtin_shufflevector(b8, b8, 6, 7); \
        const i32x2 _a0 = __builtin_shufflevector(a8, a8, 0, 1), _a1 = __builtin_shufflevector(a8, a8, 2, 3), _a2 = __builtin_shufflevector(a8, a8, 4, 5), _a3 = __builtin_shufflevector(a8, a8, 6, 7); \
        asm volatile("s_nop 1\n\tv_mfma_f32_16x16x32_fp8_fp8 %0, %1, %2, %0\n\ts_nop 7\n\tv_mfma_f32_16x16x32_fp8_fp8 %0, %3, %4, %0\n\ts_nop 7\n\tv_mfma_f32_16x16x32_fp8_fp8 %0, %5, %6, %0\n\ts_nop 7\n\tv_mfma_f32_16x16x32_fp8_fp8 %0, %7, %8, %0" \
                     : "+v"(c) : "v"(_b0), "v"(_a0), "v"(_b1), "v"(_a1), "v"(_b2), "v"(_a2), "v"(_b3), "v"(_a3)); } while (0)
#else
#define FP8_MMA_ONE(c, b8, a8) asm volatile("v_mfma_f32_16x16x128_f8f6f4 %0, %1, %2, %0" : "+v"(c) : "v"(b8), "v"(a8))
#endif
#define PG8_WAIT_V(n) asm volatile("s_waitcnt vmcnt(" #n ")" ::: "memory")
#define PG8_WAIT_L(n) asm volatile("s_waitcnt lgkmcnt(" #n ")" ::: "memory")
#define PG8_BAR __builtin_amdgcn_s_barrier()
#define PG8_SCHED __builtin_amdgcn_sched_barrier(0)
#define PG8_AOFF(AO, u, ord) do { _Pragma("unroll") for (int _h = 0; _h < 2; ++_h) _Pragma("unroll") for (int _i = 0; _i < 2; ++_i) \
        (AO)[_h][_i] = (unsigned)((size_t)S.arow_i((ord), (u), _h * HALF + RA[_i]) * (size_t)K + (size_t)CA[_i]) * 2u; } while (0)
    Unit cur, nxt; int ui = 0;
    if (!S.next(0, cur)) return;
    f32x4 acc[2][2][4][2];
#pragma unroll
    for (int a = 0; a < 2; ++a)
#pragma unroll
        for (int b = 0; b < 2; ++b)
#pragma unroll
            for (int m = 0; m < 4; ++m)
#pragma unroll
                for (int n = 0; n < 2; ++n) acc[a][b][m][n] = (f32x4){0.f, 0.f, 0.f, 0.f};
    i32x8 At[4], B0[2], B1[2];
    unsigned ac[2][2], a2[2][2];
    PG8_AOFF(ac, cur, 0);
    const char* cB0 = S.bptr(cur, 0); const char* cB1 = S.bptr(cur, 1);
    PG8_STAGE_B(PG8_SB(0, 0), cB0); PG8_STAGE_A(PG8_SA(0, 0), ac, 0, 0); PG8_STAGE_B(PG8_SB(0, 1), cB1); PG8_STAGE_A(PG8_SA(0, 1), ac, 1, 0);
    if (wr == 1) PG8_BAR;
    PG8_WAIT_V(4); PG8_BAR;
    PG8_STAGE_B(PG8_SB(1, 0), cB0 + kstepB); PG8_STAGE_A(PG8_SA(1, 0), ac, 0, kstep); PG8_STAGE_B(PG8_SB(1, 1), cB1 + kstepB);
    PG8_WAIT_V(6); PG8_BAR;
    for (;;) {
        const bool has_next = S.next(ui + 1, nxt);
        const char* nB0 = has_next ? S.bptr(nxt, 0) : cB0; const char* nB1 = has_next ? S.bptr(nxt, 1) : cB1;
        typename P::Pre pre{};
        for (int t = 0; t < nt; t += 2) {
            const bool last = (t == nt - 2);
            if (last) pre = S.prefetch(cur, wr, wc, fr, fq);
            if (last && has_next) { PG8_AOFF(a2, nxt, ui + 1); } else {
#pragma unroll
                for (int _h = 0; _h < 2; ++_h)
#pragma unroll
                    for (int _i = 0; _i < 2; ++_i) a2[_h][_i] = last ? ac[_h][_i] : ac[_h][_i] + (unsigned)((t + 2) * (BK * 2)); }
            const size_t k1 = (size_t)(t + 1) * kstep;
            const char* b20 = last ? nB0 : cB0 + (size_t)(t + 2) * kstepB; const char* b21 = last ? nB1 : cB1 + (size_t)(t + 2) * kstepB;
            PG8_LDB(B0, 0, 0); PG8_SCHED; PG8_LDA(At, 0, 0); PG8_STAGE_A(PG8_SA(1, 1), ac, 1, k1);
            PG8_WAIT_L(8); PG8_BAR; PG8_WAIT_L(0); PG8_MMA(0, 0, At, B0); PG8_BAR; PG8_SCHED;
            PG8_LDB(B1, 0, 1); PG8_STAGE_B(PG8_SB(0, 0), b20);
            PG8_BAR; PG8_WAIT_L(0); PG8_MMA(0, 1, At, B1); PG8_BAR;
            PG8_LDA(At, 0, 1); PG8_STAGE_A(PG8_SA(0, 0), a2, 0, 0);
            PG8_BAR; PG8_WAIT_L(0); PG8_MMA(1, 0, At, B0); PG8_BAR; PG8_SCHED;
            PG8_STAGE_B(PG8_SB(0, 1), b21);
            PG8_WAIT_V(6); PG8_BAR; PG8_MMA(1, 1, At, B1); PG8_BAR;
            PG8_LDB(B0, 1, 0); PG8_SCHED; PG8_LDA(At, 1, 0); PG8_STAGE_A(PG8_SA(0, 1), a2, 1, 0);
            PG8_WAIT_L(8); PG8_BAR; PG8_WAIT_L(0); PG8_MMA(0, 0, At, B0); PG8_BAR; PG8_SCHED;
            PG8_LDB(B1, 1, 1); PG8_STAGE_B(PG8_SB(1, 0), b20 + kstepB);
            PG8_BAR; PG8_WAIT_L(0); PG8_MMA(0, 1, At, B1); PG8_BAR;
            PG8_LDA(At, 1, 1); PG8_STAGE_A(PG8_SA(1, 0), a2, 0, kstep);
            PG8_BAR; PG8_WAIT_L(0); PG8_MMA(1, 0, At, B0); PG8_BAR; PG8_SCHED;
            PG8_STAGE_B(PG8_SB(1, 1), b21 + kstepB);
            PG8_WAIT_V(6); PG8_BAR; PG8_MMA(1, 1, At, B1); PG8_BAR;
        }
        if constexpr (P::FP8) asm volatile("s_nop 15\n\ts_nop 15" ::: "memory");
        S.epi(acc, cur, wr, wc, fr, fq, pre);
        if (!has_next) break;
#pragma unroll
        for (int a = 0; a < 2; ++a)
#pragma unroll
            for (int b = 0; b < 2; ++b)
#pragma unroll
                for (int m = 0; m < 4; ++m)
#pragma unroll
                    for (int n = 0; n < 2; ++n) acc[a][b][m][n] = (f32x4){0.f, 0.f, 0.f, 0.f};
        cur = nxt; cB0 = nB0; cB1 = nB1; ++ui;
#pragma unroll
        for (int _h = 0; _h < 2; ++_h)
#pragma unroll
            for (int _i = 0; _i < 2; ++_i) ac[_h][_i] = a2[_h][_i];
    }
    PG8_WAIT_V(0);
    if (wr == 0) PG8_BAR;
    PG8_BAR;
#undef PG8_SA
#undef PG8_SB
#undef PG8_STAGE_A
#undef PG8_STAGE_B
#undef PG8_LDA
#undef PG8_LDB
#undef PG8_MMA
#undef PG8_WAIT_V
#undef PG8_WAIT_L
#undef PG8_BAR
#undef PG8_SCHED
#undef PG8_AOFF
}
}
using pg8::Unit;

struct Frame {
    LAS unsigned char* lds;
    volatile LAS unsigned* MISC;
    unsigned* ctl;
    unsigned char* ws;
    int tid, lane, wave, G, bid;
    const float* const* in;
    float* out;
};
#define WSP(T, off) ((T*)(F.ws + (off)))

__device__ __forceinline__ void transpose_load(const float* __restrict__ W, int N, int item, int lane, f32x4 (&v)[16]) {
    const int nblk = (N + 63) / 64, kb = item / nblk, nb = item % nblk, k0 = 64 * kb, n0 = 64 * nb;
    const int lk = lane >> 4, ln = (lane & 15) * 4; const bool ok = n0 + ln < N;
#pragma unroll
    for (int i = 0; i < 16; ++i) v[i] = ok ? *(const f32x4*)(W + (size_t)(k0 + 4 * i + lk) * N + n0 + ln) : (f32x4){0.f, 0.f, 0.f, 0.f};
}
__device__ __forceinline__ void transpose_finish(int K, int N, bf16_t* __restrict__ WT, int row_off, LAS float* scr, int item, int lane, const f32x4 (&v)[16]) {
    const int nblk = (N + 63) / 64, kb = item / nblk, nb = item % nblk, k0 = 64 * kb, n0 = 64 * nb;
    const int lk = lane >> 4, ln = (lane & 15) * 4;
#pragma unroll
    for (int i = 0; i < 16; ++i) { LAS float* d = scr + (4 * i + lk) * 65 + ln; d[0] = v[i].x; d[1] = v[i].y; d[2] = v[i].z; d[3] = v[i].w; }
    LDS_WAIT(); asm volatile("" ::: "memory");
    const int c = lane & 7;
#pragma unroll
    for (int j = 0; j < 8; ++j) { const int n = (lane >> 3) + 8 * j; const LAS float* s = scr + (8 * c) * 65 + n;
        if (n0 + n < N) { u32x4 o; o.x = cvt_pk_bf16(s[0 * 65], s[1 * 65]); o.y = cvt_pk_bf16(s[2 * 65], s[3 * 65]); o.z = cvt_pk_bf16(s[4 * 65], s[5 * 65]); o.w = cvt_pk_bf16(s[6 * 65], s[7 * 65]);
            *(u32x4*)(WT + (size_t)(row_off + n0 + n) * K + k0 + 8 * c) = o; } }
    LDS_WAIT(); asm volatile("" ::: "memory");
}
constexpr int TI_PER_MAT = (D / 64) * (D / 64);
constexpr int TI_WIN = (D / 64) * ((NIN + 63) / 64);
constexpr int TI_SMALL = TI_WIN + TI_PER_MAT;
constexpr int TI_EXP = 3 * NE * TI_PER_MAT;
#ifndef NCONV_SCAN
#define NCONV_SCAN 168
#endif
#ifndef NCONV_WG
#define NCONV_WG 20
#endif
#ifndef TI_EARLY_PCT
#define TI_EARLY_PCT 12
#endif
__host__ __device__ constexpr int ti_early(int G) { return (G > 2 * NCONV_WG) ? (TI_EXP / 100) * TI_EARLY_PCT : 0; }
__device__ __forceinline__ void transpose_small_load(Frame& F, int it, f32x4 (&v)[16]) {
    if (it < TI_WIN) transpose_load(F.in[I_WIN], NIN, it, F.lane, v); else transpose_load(F.in[I_WOUT], D, it - TI_WIN, F.lane, v);
}
__device__ __forceinline__ void transpose_small_finish(Frame& F, int it, LAS float* scr, const f32x4 (&v)[16]) {
    if (it < TI_WIN) transpose_finish(D, NIN, WSP(bf16_t, WS_WIN), 0, scr, it, F.lane, v); else transpose_finish(D, D, WSP(bf16_t, WS_WOUT), 0, scr, it - TI_WIN, F.lane, v);
}
__device__ __forceinline__ void convert_load(Frame& F, int it, f32x4 (&v)[16]) {
    const int mat = it / TI_PER_MAT, r = it % TI_PER_MAT, type = mat / NE, e = mat % NE, kb = r >> 3, n4 = (r & 7) * 256 + F.lane * 4;
    const float* src = F.in[type == 0 ? I_WGATE : (type == 1 ? I_WUP : I_WDOWN)] + (size_t)e * D * D + (size_t)(kb * 16) * D + n4;
#pragma unroll
    for (int i = 0; i < 16; ++i) v[i] = __builtin_nontemporal_load((const f32x4*)(src + (size_t)i * D));
}
__device__ __forceinline__ void convert_store(Frame& F, int it, const f32x4 (&v)[16]) {
    const int mat = it / TI_PER_MAT, r = it % TI_PER_MAT, type = mat / NE, e = mat % NE, kb = r >> 3, n4 = (r & 7) * 256 + F.lane * 4;
    unsigned char* dst = F.ws + (type == 0 ? WS_WG : (type == 1 ? WS_WU : WS_WD)) + (size_t)e * D * D + ((size_t)kb * D + n4) * 16;
#pragma unroll
    for (int nn = 0; nn < 4; ++nn)
        *(u32x4*)(dst + nn * 16) = (u32x4){pk_fp8x4(v[0][nn] * W8_SCALE, v[1][nn] * W8_SCALE, v[2][nn] * W8_SCALE, v[3][nn] * W8_SCALE), pk_fp8x4(v[4][nn] * W8_SCALE, v[5][nn] * W8_SCALE, v[6][nn] * W8_SCALE, v[7][nn] * W8_SCALE),
                                          pk_fp8x4(v[8][nn] * W8_SCALE, v[9][nn] * W8_SCALE, v[10][nn] * W8_SCALE, v[11][nn] * W8_SCALE), pk_fp8x4(v[12][nn] * W8_SCALE, v[13][nn] * W8_SCALE, v[14][nn] * W8_SCALE, v[15][nn] * W8_SCALE)};
}
__device__ __forceinline__ void convert_experts(Frame& F, int gw, int NGW, int it0, int it1) {
    f32x4 A[16], B[16];
    for (int it = it0 + gw; it < it1; it += 2 * NGW) {
        const int i2 = it + NGW; const bool h2 = i2 < it1;
        convert_load(F, it, A); convert_load(F, h2 ? i2 : it, B); __builtin_amdgcn_sched_barrier(0);
        convert_store(F, it, A);
        if (h2) convert_store(F, i2, B);
    }
}
__device__ __forceinline__ void p0_prologue(Frame& F) {
    LAS float* red = (LAS float*)F.lds;
    const float* c = F.in[I_C]; const float* cctx = F.in[I_CCTX]; const float* wada = F.in[I_WADA];
    float* modp = WSP(float, WS_MODP);
    const int gw = F.bid * 8 + F.wave, NGW = F.G * 8;
    f32x4 tc[16], tn[16];
    if (gw < TI_SMALL) transpose_small_load(F, gw, tc);
    for (int it = F.bid; it < NPART * 32; it += F.G) {
        const int kq = it / 32, cg = it % 32, kb = kq * 256 + F.wave * 32, col = cg * 384 + F.lane * 4, col2 = cg * 384 + 256 + (F.lane & 31) * 4; const bool ex = F.lane < 32;
        f32x4 a0 = {0.f, 0.f, 0.f, 0.f}, a1 = a0, a2 = a0, b0 = a0, b1 = a0, b2 = a0;
#pragma unroll 8
        for (int i = 0; i < 32; ++i) { const int k = kb + i; const f32x4 wv = *(const f32x4*)(wada + (size_t)k * (6 * D) + col); f32x4 wx = {0.f, 0.f, 0.f, 0.f}; if (ex) wx = *(const f32x4*)(wada + (size_t)k * (6 * D) + col2);
            const float s0 = silu_f(c[k]), s1 = silu_f(c[D + k]), s2 = silu_f(cctx[k]); a0 += wv * s0; a1 += wv * s1; a2 += wv * s2; b0 += wx * s0; b1 += wx * s1; b2 += wx * s2; }
        *(LAS f32x4*)(red + (F.wave * 3 + 0) * 384 + F.lane * 4) = a0; *(LAS f32x4*)(red + (F.wave * 3 + 1) * 384 + F.lane * 4) = a1; *(LAS f32x4*)(red + (F.wave * 3 + 2) * 384 + F.lane * 4) = a2;
        if (ex) { *(LAS f32x4*)(red + (F.wave * 3 + 0) * 384 + 256 + F.lane * 4) = b0; *(LAS f32x4*)(red + (F.wave * 3 + 1) * 384 + 256 + F.lane * 4) = b1; *(LAS f32x4*)(red + (F.wave * 3 + 2) * 384 + 256 + F.lane * 4) = b2; }
        __syncthreads();
        for (int idx = F.tid; idx < 3 * 384; idx += 512) { const int v = idx / 384, cc = idx % 384; float s = 0.f;
#pragma unroll
            for (int w = 0; w < 8; ++w) s += red[(w * 3 + v) * 384 + cc];
            modp[(size_t)(kq * 3 + v) * (6 * D) + cg * 384 + cc] = s; }
        __syncthreads();
    }
    LAS float* scr = (LAS float*)(F.lds + F.wave * (64 * 65 * 4));
    for (int it = gw; it < TI_SMALL; it += NGW) {
        if (it + NGW < TI_SMALL) transpose_small_load(F, it + NGW, tn);
        transpose_small_finish(F, it, scr, tc);
#pragma unroll
        for (int i = 0; i < 16; ++i) tc[i] = tn[i];
    }
}

__device__ __forceinline__ const float* row_src(Frame& F, int row) { return row < ML ? F.in[I_X] + (size_t)row * D : F.in[I_CTX] + (size_t)(row - ML) * D; }
__device__ __forceinline__ int row_vec(int row) { return row < SEQ ? 0 : (row < ML ? 1 : 2); }
__device__ __forceinline__ void p1_ln0(Frame& F) {
    const int rpw = (MTOT + F.G - 1) / F.G, r0 = F.bid * rpw, r1 = (r0 + rpw < MTOT) ? r0 + rpw : MTOT;
    const float* modp = WSP(const float, WS_MODP); const float* bada = F.in[I_BADA];
    LAS float* SC = (LAS float*)F.lds;
    LAS float* SH = SC + 3 * D;
    if (r0 < r1) {
        const int vlo = row_vec(r0), vhi = row_vec(r1 - 1);
        for (int v = vlo; v <= vhi; ++v)
            for (int d = F.tid; d < D; d += 512) { float sh = bada[d], sc = bada[D + d];
#pragma unroll
                for (int p = 0; p < NPART; ++p) { sh += modp[(size_t)(p * 3 + v) * (6 * D) + d]; sc += modp[(size_t)(p * 3 + v) * (6 * D) + D + d]; }
                const float g0 = F.in[I_LN0G][d], b0 = F.in[I_LN0B][d];
                SC[v * D + d] = g0 * (1.f + sc); SH[v * D + d] = b0 * (1.f + sc) + sh; }
    }
    __syncthreads();
    bf16_t* HM = WSP(bf16_t, WS_HM); f32x2* st = WSP(f32x2, WS_STAT0);
    f32x4 xn[8];
    if (r0 + F.wave < r1) { const f32x4* xr = (const f32x4*)row_src(F, r0 + F.wave) + F.lane;
#pragma unroll
        for (int j = 0; j < 8; ++j) xn[j] = xr[64 * j]; }
    for (int row = r0 + F.wave; row < r1; row += 8) {
        const int v = row_vec(row);
        f32x4 x[8]; float s = 0.f;
#pragma unroll
        for (int j = 0; j < 8; ++j) { x[j] = xn[j]; s += (x[j].x + x[j].y) + (x[j].z + x[j].w); }
        if (row + 8 < r1) { const f32x4* xr = (const f32x4*)row_src(F, row + 8) + F.lane;
#pragma unroll
            for (int j = 0; j < 8; ++j) xn[j] = xr[64 * j]; }
        const float mean = wave_sum(s) * (1.f / D); float s2 = 0.f;
#pragma unroll
        for (int j = 0; j < 8; ++j) { x[j] = x[j] - mean; s2 += (x[j].x * x[j].x + x[j].y * x[j].y) + (x[j].z * x[j].z + x[j].w * x[j].w); }
        const float rstd = 1.f / sqrtf(wave_sum(s2) * (1.f / D) + LN_EPS);
        if (F.lane == 0) st[row] = (f32x2){mean, rstd};
        u32x2* o = (u32x2*)(HM + (size_t)row * D) + F.lane;
#pragma unroll
        for (int j = 0; j < 8; ++j) { const int d = 4 * F.lane + 256 * j; const f32x4 a = *(const LAS f32x4*)(SC + v * D + d), b = *(const LAS f32x4*)(SH + v * D + d);
            const f32x4 y = x[j] * rstd * a + b; u32x2 w; w.x = cvt_pk_bf16(y.x, y.y); w.y = cvt_pk_bf16(y.z, y.w); o[64 * j] = w; }
    }
    float* modf = WSP(float, WS_MODF);
    for (int idx = F.bid * 512 + F.tid; idx < 3 * 6 * D; idx += F.G * 512) { const int v = idx / (6 * D), n = idx % (6 * D); float s = bada[n];
#pragma unroll
        for (int p = 0; p < NPART; ++p) s += modp[(size_t)(p * 3 + v) * (6 * D) + n];
        modf[idx] = s; }
}

struct NoPre {};
struct InProj {
    static constexpr bool PERM = true, GATHER = false, FP8 = false, BBLK = false; typedef NoPre Pre;
    __device__ __forceinline__ Pre prefetch(const Unit&, int, int, int, int) const { return Pre{}; }
    int K; const char* A; const char* Bt; bf16_t* P; int G, c;
    __device__ __forceinline__ bool next(int i, Unit& u) const {
        const int L = i * G + c; constexpr int NMAIN = (ML / 256) * (NINP / 256), NCTXT = (GIN + 255) / 256;
        if (L < NMAIN) { pg8::tile_order(L, ML / 256, NINP / 256, u.pm, u.pn); u.e = 0; return true; }
        const int j = L - NMAIN; if (j >= (MC / 256) * NCTXT) return false;
        u.pm = ML / 256 + j / NCTXT; u.pn = j % NCTXT; u.e = 0; return true;
    }
    __device__ __forceinline__ const char* bptr(const Unit& u, int half) const { return Bt + (size_t)(u.pn * 256 + half * 128) * K * 2; }
    __device__ __forceinline__ unsigned arow_i(int, const Unit& u, int r) const { return (unsigned)(u.pm * 256 + r); }
    __device__ __forceinline__ void epi(const f32x4 (&acc)[2][2][4][2], const Unit& u, int wr, int wc, int fr, int fq, const Pre&) const {
        const int row0 = u.pm * 256 + wr * 64 + fr, col0 = u.pn * 256 + wc * 32 + 8 * fq;
#pragma unroll
        for (int ai = 0; ai < 2; ++ai)
#pragma unroll
            for (int m = 0; m < 4; ++m) { bf16_t* rowp = P + (size_t)(row0 + ai * 128 + m * 16) * NINP + col0;
#pragma unroll
                for (int bj = 0; bj < 2; ++bj) { const f32x4 v0 = acc[ai][bj][m][0], v1 = acc[ai][bj][m][1];
                    u32x4 w; w.x = cvt_pk_bf16(v0[0], v0[1]); w.y = cvt_pk_bf16(v0[2], v0[3]); w.z = cvt_pk_bf16(v1[0], v1[1]); w.w = cvt_pk_bf16(v1[2], v1[3]);
                    *(u32x4*)(rowp + bj * 128) = w; } }
    }
};

typedef float f32x16 __attribute__((ext_vector_type(16)));
typedef __bf16 bf2_t __attribute__((ext_vector_type(2)));
__device__ __forceinline__ unsigned pk(float a, float b) { f32x2 v = {a, b}; return __builtin_bit_cast(unsigned, __builtin_convertvector(v, bf2_t)); }
__device__ __forceinline__ bf16_t f2bf(float a) { return (bf16_t)(pk(a, 0.f) & 0xffffu); }
#define MFMA16(a, b, c) __builtin_amdgcn_mfma_f32_16x16x32_bf16((a), (b), (c), 0, 0, 0)
#define MFMA32(a, b, c) __builtin_amdgcn_mfma_f32_32x32x16_bf16((a), (b), (c), 0, 0, 0)
__device__ __forceinline__ void unit_rows(int b, int cidx, int& rowbase, int& segbase, int& len) {
    if (cidx < CTXL / 64) { segbase = ML + b * CTXL; len = CTXL; rowbase = segbase + cidx * 64; }
    else { segbase = b * SEQ; len = SEQ; rowbase = segbase + (cidx - CTXL / 64) * 64; }
}
constexpr int TOKB = 9;
__device__ __forceinline__ int tok_seg(int r) { return r < ML ? r / SEQ : NBATCH + (r - ML) / CTXL; }
template <bool MASKED>
__device__ __forceinline__ void tok_block(const bf16_t* P, bf16_t* QKVb, const float* cw, int b0, int nrow, int lane) {
#pragma unroll 1
    for (int jj = 0; jj < 6; ++jj) {
        const int col = jj * 512 + lane * 8;
        u32x4 R[TOKB + 4];
#pragma unroll
        for (int t = 0; t < TOKB + 4; ++t) { const int r = b0 - 2 + t; const bool ok = !MASKED || (r >= 0 && r < MTOT);
            R[t] = (u32x4){0u, 0u, 0u, 0u}; if (ok) R[t] = *(const u32x4*)(P + (size_t)r * NINP + col); }
        f32x4 cwr[5][2];
#pragma unroll
        for (int i = 0; i < 5; ++i) { cwr[i][0] = *(const f32x4*)(cw + i * GQKV + col); cwr[i][1] = *(const f32x4*)(cw + i * GQKV + col + 4); }
#pragma unroll
        for (int rr = 0; rr < TOKB; ++rr) {
            if (rr < nrow) { const int row = b0 + rr;
                float a[8];
#pragma unroll
                for (int q = 0; q < 8; ++q) a[q] = 0.f;
#pragma unroll
                for (int i = 0; i < 5; ++i) { const f32x4 w0 = cwr[i][0], w1 = cwr[i][1]; u32x4 p = R[rr + i];
                    if (MASKED) { const int tr = row + i - 2; const bool v = tr >= 0 && tr < MTOT && tok_seg(tr < 0 ? 0 : (tr < MTOT ? tr : MTOT - 1)) == tok_seg(row); if (!v) p = (u32x4){0u, 0u, 0u, 0u}; }
                    a[0] += bf_lo(p.x) * w0.x; a[1] += bf_hi(p.x) * w0.y; a[2] += bf_lo(p.y) * w0.z; a[3] += bf_hi(p.y) * w0.w;
                    a[4] += bf_lo(p.z) * w1.x; a[5] += bf_hi(p.z) * w1.y; a[6] += bf_lo(p.w) * w1.z; a[7] += bf_hi(p.w) * w1.w; }
                float ss = 0.f;
#pragma unroll
                for (int q = 0; q < 8; ++q) { a[q] = silu_f(a[q]); ss += a[q] * a[q]; }
                if (jj < 4) { ss += __shfl_xor(ss, 1); ss += __shfl_xor(ss, 2); ss += __shfl_xor(ss, 4); ss += __shfl_xor(ss, 8);
                    float sc = __builtin_amdgcn_rsqf(ss + 1e-6f); if (jj < 2) sc *= 0.08838834764831845f;
#pragma unroll
                    for (int q = 0; q < 8; ++q) a[q] *= sc; }
                *(u32x4*)(QKVb + (size_t)row * GQKV + col) = (u32x4){pk(a[0], a[1]), pk(a[2], a[3]), pk(a[4], a[5]), pk(a[6], a[7])}; }
        }
    }
}
__device__ __forceinline__ void p3a_tokens(Frame& F) {
    const bf16_t* P = WSP(const bf16_t, WS_P); bf16_t* QKVb = WSP(bf16_t, WS_QKVB); float* GBf = WSP(float, WS_GBF);
    const float* cw = F.in[I_CONVQKV];
    int tz_ = threadIdx.x; asm volatile("" : "+v"(tz_));
    const int lane_ = tz_ & 63, wave_ = __builtin_amdgcn_readfirstlane(tz_ >> 6);
    for (int blk = F.bid * 8 + wave_; blk * TOKB < MTOT; blk += F.G * 8) {
        const int b0 = blk * TOKB, nrow = (b0 + TOKB <= MTOT) ? TOKB : MTOT - b0;
        const bool clean = b0 >= 2 && b0 + TOKB + 1 < MTOT && tok_seg(b0 - 2) == tok_seg(b0 + TOKB + 1);
        if (clean) tok_block<false>(P, QKVb, cw, b0, nrow, lane_); else tok_block<true>(P, QKVb, cw, b0, nrow, lane_);
        if (lane_ < 32) { const int i = lane_ & 15; float gv[TOKB];
#pragma unroll
            for (int rr = 0; rr < TOKB; ++rr) gv[rr] = (rr < nrow) ? bf2f(P[(size_t)(b0 + rr) * NINP + (lane_ < 16 ? COL_A : COL_B) + i]) : 0.f;
            const float al = -__expf(F.in[I_ALOG][i]), dt = F.in[I_DTB][i];
#pragma unroll
            for (int rr = 0; rr < TOKB; ++rr) if (rr < nrow) { const float v = gv[rr]; GBf[(size_t)(b0 + rr) * 32 + lane_] = (lane_ < 16) ? al * softplus_f(v + dt) : sigmoid_f(v); } }
    }
}
constexpr int PL_QS = 0, PL_KS = 17408, PL_KBG = 34816, PL_VB = 53248, PL_AM = 71680, PL_QKM = 89088, PL_TB = 106496, PL_EGC = 115712, PL_EKD = 115968, PL_TF = 116224, PL_GC = 133632, PL_BETA = 133888;
constexpr int QP = 136, TP = 72, FP = 68;
#define MFMA4F(a, b, c) __builtin_amdgcn_mfma_f32_16x16x4f32((a), (b), (c), 0, 0, 0)
__device__ __forceinline__ void p3_prep(Frame& F) {
    const bf16_t* QKVb = WSP(const bf16_t, WS_QKVB); const float* GBf = WSP(const float, WS_GBF);
    LAS bf16_t* Qs = (LAS bf16_t*)(F.lds + PL_QS); LAS bf16_t* Ks = (LAS bf16_t*)(F.lds + PL_KS); LAS bf16_t* KbgT = (LAS bf16_t*)(F.lds + PL_KBG); LAS bf16_t* VbT = (LAS bf16_t*)(F.lds + PL_VB);
    LAS float* Am = (LAS float*)(F.lds + PL_AM); LAS float* QKm = (LAS float*)(F.lds + PL_QKM); LAS bf16_t* Tb = (LAS bf16_t*)(F.lds + PL_TB); LAS float* Tf = (LAS float*)(F.lds + PL_TF);
    LAS float* egc_s = (LAS float*)(F.lds + PL_EGC); LAS float* ekd_s = (LAS float*)(F.lds + PL_EKD); LAS float* gc_s = (LAS float*)(F.lds + PL_GC); LAS float* beta_s = (LAS float*)(F.lds + PL_BETA);
    LAS bf16_t* Ws = Qs; LAS bf16_t* Us = Ks;
    int tz = threadIdx.x; asm volatile("" : "+v"(tz));
    const int tid = tz, lane = tz & 63, w = __builtin_amdgcn_readfirstlane(tz >> 6), l15 = lane & 15, l4 = lane >> 4, r31 = lane & 31, hh = lane >> 5;
    u32x4 pre[3][2]; float pg = 0.f, pb = 0.f;
#define PREP_LOAD(uid_) do { const int _dir = (uid_) & 1, _h = ((uid_) >> 1) & 7, _cb = (uid_) >> 4, _cidx = _cb % NCHUNK, _b = _cb / NCHUNK; int _rb, _sb, _ln; unit_rows(_b, _cidx, _rb, _sb, _ln); \
        _Pragma("unroll") for (int _p = 0; _p < 3; ++_p) _Pragma("unroll") for (int _hf = 0; _hf < 2; ++_hf) { const int _r = 2 * (tid >> 4) + _hf; \
            pre[_p][_hf] = *(const u32x4*)(QKVb + (size_t)(_rb + (_dir ? 63 - _r : _r)) * GQKV + _p * GQK + _h * 128 + (tid & 15) * 8); } \
        { const size_t _pr = (size_t)(_rb + (_dir ? 63 - lane : lane)); pg = GBf[_pr * 32 + _dir * 8 + _h]; pb = GBf[_pr * 32 + 16 + _dir * 8 + _h]; } } while (0)
    if (F.bid < NUNITS) PREP_LOAD(F.bid);
    for (int uid = F.bid; uid < NUNITS; uid += F.G) {
        unsigned char* ub = F.ws + WS_PREP + (size_t)uid * UNIT_BYTES;
        float gc = pg; const float beta = pb;
#pragma unroll
        for (int off = 1; off < 64; off <<= 1) { const float t = __shfl_up(gc, off); if (lane >= off) gc += t; }
        const float glast = __shfl(gc, 63), egcv = __expf(gc);
        if (w == 0) { egc_s[lane] = egcv; ekd_s[lane] = __expf(glast - gc); gc_s[lane] = gc; beta_s[lane] = beta; }
        { const int r0 = 2 * (tid >> 4), c16 = tid & 15;
          const float br0 = __shfl(beta, r0), br1 = __shfl(beta, r0 + 1), sk0 = br0 * __shfl(egcv, r0), sk1 = br1 * __shfl(egcv, r0 + 1);
          const int rs = (((r0 >> 3) ^ (c16 >> 1)) << 3) + (r0 & 7);
          *(LAS u32x4*)(Qs + r0 * QP + c16 * 8) = pre[0][0]; *(LAS u32x4*)(Qs + (r0 + 1) * QP + c16 * 8) = pre[0][1];
          *(LAS u32x4*)(Ks + r0 * QP + c16 * 8) = pre[1][0]; *(LAS u32x4*)(Ks + (r0 + 1) * QP + c16 * 8) = pre[1][1];
#pragma unroll
          for (int e = 0; e < 4; ++e) { const unsigned k0 = pre[1][0][e], k1 = pre[1][1][e], v0 = pre[2][0][e], v1 = pre[2][1][e];
              *(LAS unsigned*)(KbgT + (c16 * 8 + 2 * e) * TP + rs) = pk(bf_lo(k0) * sk0, bf_lo(k1) * sk1); *(LAS unsigned*)(KbgT + (c16 * 8 + 2 * e + 1) * TP + rs) = pk(bf_hi(k0) * sk0, bf_hi(k1) * sk1);
              *(LAS unsigned*)(VbT + (c16 * 8 + 2 * e) * TP + rs) = pk(bf_lo(v0) * br0, bf_lo(v1) * br1); *(LAS unsigned*)(VbT + (c16 * 8 + 2 * e + 1) * TP + rs) = pk(bf_hi(v0) * br0, bf_hi(v1) * br1); } }
        if (uid + F.G < NUNITS) PREP_LOAD(uid + F.G);
        __syncthreads();
        { const bool isq = w >= 4; const int rt = w & 3; const LAS bf16_t* X = isq ? Qs : Ks; LAS float* OUT = isq ? QKm : Am;
          bf16x8 af[4], bfr[4][4];
#pragma unroll
          for (int ks = 0; ks < 4; ++ks) af[ks] = *(const LAS bf16x8*)(X + (rt * 16 + l15) * QP + 32 * ks + 8 * l4);
#pragma unroll
          for (int st = 0; st < 4; ++st)
#pragma unroll
              for (int ks = 0; ks < 4; ++ks) bfr[st][ks] = *(const LAS bf16x8*)(Ks + (st * 16 + l15) * QP + 32 * ks + 8 * l4);
          const f32x4 gcr4 = *(const LAS f32x4*)(gc_s + rt * 16 + 4 * l4), br4 = *(const LAS f32x4*)(beta_s + rt * 16 + 4 * l4);
          float gcs4[4];
#pragma unroll
          for (int st = 0; st < 4; ++st) gcs4[st] = gc_s[st * 16 + l15];
#pragma unroll
          for (int st = 0; st < 4; ++st) { f32x4 acc = {0.f, 0.f, 0.f, 0.f};
#pragma unroll
              for (int ks = 0; ks < 4; ++ks) acc = MFMA16(af[ks], bfr[st][ks], acc);
              const int sidx = st * 16 + l15; const float gcs = gcs4[st];
#pragma unroll
              for (int reg = 0; reg < 4; ++reg) { const int ridx = rt * 16 + 4 * l4 + reg; const float gcr = gcr4[reg], br = br4[reg];
                  const float e = __expf(fminf(gcr - gcs, 0.f));
                  const float val = isq ? (ridx >= sidx ? acc[reg] * e : 0.f) : (ridx > sidx ? br * acc[reg] * e : 0.f);
                  OUT[ridx * FP + sidx] = val; } } }
#pragma unroll
        for (int q2 = 0; q2 < 2; ++q2) { const int frag = w + 8 * q2;
            { const int mt = frag >> 3, kt = (frag >> 1) & 3, s2 = frag & 1, row = 32 * mt + r31, col0 = 32 * kt + 16 * s2 + 4 * hh; const float e = egc_s[row];
              const u32x2 lo = *(const LAS u32x2*)(Qs + row * QP + col0), hi = *(const LAS u32x2*)(Qs + row * QP + col0 + 8);
              *(u32x4*)(ub + UO_QD + frag * 1024 + lane * 16) = (u32x4){pk(bf_lo(lo.x) * e, bf_hi(lo.x) * e), pk(bf_lo(lo.y) * e, bf_hi(lo.y) * e), pk(bf_lo(hi.x) * e, bf_hi(hi.x) * e), pk(bf_lo(hi.y) * e, bf_hi(hi.y) * e)}; }
            { const int kt = frag >> 2, ct = (frag >> 1) & 1, s2 = frag & 1; float v[8];
#pragma unroll
              for (int j = 0; j < 8; ++j) { const int tok = 32 * ct + 16 * s2 + 8 * (j >> 2) + 4 * hh + (j & 3); v[j] = bf2f(Ks[tok * QP + 32 * kt + r31]); }
              { const int t0 = 32 * ct + 16 * s2 + 4 * hh; const f32x4 e0 = *(const LAS f32x4*)(ekd_s + t0), e1 = *(const LAS f32x4*)(ekd_s + t0 + 8);
                v[0] *= e0.x; v[1] *= e0.y; v[2] *= e0.z; v[3] *= e0.w; v[4] *= e1.x; v[5] *= e1.y; v[6] *= e1.z; v[7] *= e1.w; }
              *(u32x4*)(ub + UO_KDT + frag * 1024 + lane * 16) = (u32x4){pk(v[0], v[1]), pk(v[2], v[3]), pk(v[4], v[5]), pk(v[6], v[7])}; } }
        __syncthreads();
        if (w < 4) { float t[16];
            f32x4 ar[4];
#pragma unroll
            for (int c4 = 0; c4 < 4; ++c4) ar[c4] = *(const LAS f32x4*)(Am + (16 * w + l15) * FP + 16 * w + 4 * c4);
#pragma unroll
            for (int i = 0; i < 16; ++i) { float a0 = (i == lane) ? 1.f : 0.f;
#pragma unroll
                for (int m = 0; m < i; ++m) { const float av = ar[m >> 2][m & 3];
                    a0 -= __builtin_bit_cast(float, __builtin_amdgcn_readlane(__builtin_bit_cast(int, av), i)) * t[m]; }
                t[i] = a0; }
            if (lane < 16) {
#pragma unroll
                for (int i = 0; i < 16; ++i) Tf[(16 * w + i) * FP + 16 * w + lane] = t[i]; } }
        __syncthreads();
#pragma unroll
        for (int lv = 1; lv < 4; ++lv) {
            if (w < 4 - lv) { const int bj = w, bi = w + lv;
                f32x4 aop[3]; float bop[3][4];
#pragma unroll
                for (int t = 0; t < lv; ++t) { const int bk = bj + t; aop[t] = *(const LAS f32x4*)(Am + (16 * bi + l15) * FP + 16 * bk + 4 * l4);
#pragma unroll
                    for (int ks = 0; ks < 4; ++ks) bop[t][ks] = Tf[(16 * bk + 4 * l4 + ks) * FP + 16 * bj + l15]; }
                const f32x4 tdg = *(const LAS f32x4*)(Tf + (16 * bi + l15) * FP + 16 * bi + 4 * l4);
                f32x4 x = {0.f, 0.f, 0.f, 0.f};
#pragma unroll
                for (int t = 0; t < lv; ++t)
#pragma unroll
                    for (int ks = 0; ks < 4; ++ks) x = MFMA4F(aop[t][ks], bop[t][ks], x);
                f32x4 y = {0.f, 0.f, 0.f, 0.f};
#pragma unroll
                for (int ks = 0; ks < 4; ++ks) y = MFMA4F(tdg[ks], x[ks], y);
#pragma unroll
                for (int reg = 0; reg < 4; ++reg) Tf[(16 * bi + 4 * l4 + reg) * FP + 16 * bj + l15] = -y[reg]; }
            __syncthreads();
        }
#pragma unroll
        for (int q = 0; q < 4; ++q) { const int idx = tid + 512 * q, i = idx >> 5, j = (idx & 31) * 2; const f32x2 tv = *(const LAS f32x2*)(Tf + i * FP + j);
            *(LAS unsigned*)(Tb + i * TP + j) = pk(j <= i ? tv.x : 0.f, j + 1 <= i ? tv.y : 0.f); }
        __syncthreads();
        { bf16x8 bu[2], bw[2];
#pragma unroll
          for (int ks = 0; ks < 2; ++ks) { const int ch = 8 * ((4 * ks + l4) ^ w);
              bu[ks] = *(const LAS bf16x8*)(VbT + (w * 16 + l15) * TP + ch); bw[ks] = *(const LAS bf16x8*)(KbgT + (w * 16 + l15) * TP + ch); }
#pragma unroll
          for (int rt = 0; rt < 4; ++rt) { const bf16x8 a0 = *(const LAS bf16x8*)(Tb + (rt * 16 + l15) * TP + 8 * l4), a1 = *(const LAS bf16x8*)(Tb + (rt * 16 + l15) * TP + 32 + 8 * l4);
              f32x4 au = {0.f, 0.f, 0.f, 0.f}, aw = {0.f, 0.f, 0.f, 0.f};
              au = MFMA16(bu[0], a0, au); au = MFMA16(bu[1], a1, au); aw = MFMA16(bw[0], a0, aw); aw = MFMA16(bw[1], a1, aw);
              { const int r = rt * 16 + l15, f0 = w * 16 + 4 * l4;
                *(LAS u32x2*)(Us + r * QP + f0) = (u32x2){pk(au[0], au[1]), pk(au[2], au[3])}; *(LAS u32x2*)(Ws + r * QP + f0) = (u32x2){pk(-aw[0], -aw[1]), pk(-aw[2], -aw[3])}; } } }
        __syncthreads();
#pragma unroll
        for (int q2 = 0; q2 < 2; ++q2) { const int frag = w + 8 * q2, mt = frag >> 3, kt = (frag >> 1) & 3, s2 = frag & 1, row = 32 * mt + r31, col0 = 32 * kt + 16 * s2 + 4 * hh;
            const u32x2 lo = *(const LAS u32x2*)(Ws + row * QP + col0), hi = *(const LAS u32x2*)(Ws + row * QP + col0 + 8);
            *(u32x4*)(ub + UO_NW + frag * 1024 + lane * 16) = (u32x4){lo.x, lo.y, hi.x, hi.y}; }
        { const int mt = w >> 2, nt = w & 3; unsigned o[8];
#pragma unroll
          for (int p = 0; p < 8; ++p) { const int reg0 = 2 * p, row0 = 32 * mt + (reg0 & 3) + 8 * (reg0 >> 2) + 4 * hh;
              o[p] = (unsigned)Us[row0 * QP + 32 * nt + r31] | ((unsigned)Us[(row0 + 1) * QP + 32 * nt + r31] << 16); }
          *(u32x4*)(ub + UO_U + w * 2048 + lane * 32) = (u32x4){o[0], o[1], o[2], o[3]}; *(u32x4*)(ub + UO_U + w * 2048 + lane * 32 + 16) = (u32x4){o[4], o[5], o[6], o[7]}; }
        { const int mt = w >> 2, ct = (w >> 1) & 1, s2 = w & 1, row = 32 * mt + r31, col0 = 32 * ct + 16 * s2 + 4 * hh;
          const f32x4 x0 = *(const LAS f32x4*)(QKm + row * FP + col0), x1 = *(const LAS f32x4*)(QKm + row * FP + col0 + 8);
          *(u32x4*)(ub + UO_QK + w * 1024 + lane * 16) = (u32x4){pk(x0.x, x0.y), pk(x0.z, x0.w), pk(x1.x, x1.y), pk(x1.z, x1.w)}; }
        if (tid == 0) *(float*)(ub + UO_DL) = __expf(glast);
        __syncthreads();
    }
#undef PREP_LOAD
}

__device__ __forceinline__ bf16x8 pack_step(const f32x16& x, int s) { return __builtin_bit_cast(bf16x8, ((u32x4){pk(x[8 * s], x[8 * s + 1]), pk(x[8 * s + 2], x[8 * s + 3]), pk(x[8 * s + 4], x[8 * s + 5]), pk(x[8 * s + 6], x[8 * s + 7])})); }
__device__ __forceinline__ void p4_scan(Frame& F) {
    constexpr int NSCAN = NBATCH * NH * 2;
    if (F.bid >= NSCAN) {
        const int nconv = (F.G - NSCAN) < NCONV_SCAN ? (F.G - NSCAN) : NCONV_SCAN;
        if (F.bid - NSCAN < nconv) convert_experts(F, (F.bid - NSCAN) * 8 + F.wave, nconv * 8, ti_early(F.G), TI_EXP);
        return;
    }
    const int b = F.bid >> 4, h = (F.bid >> 1) & 7, dir = F.bid & 1, lane = F.lane;
    const unsigned char* prep = F.ws + WS_PREP;
#define STEP_CIDX(n) (dir ? ((n) < CTXL / 64 ? CTXL / 64 - 1 - (n) : NCHUNK + CTXL / 64 - 1 - (n)) : (n))
#define STEP_UNIT(n) (prep + (size_t)((((b * NCHUNK + STEP_CIDX(n)) * NH + h) * 2) + dir) * UNIT_BYTES)
    const int wv = F.wave;
#define ISSUE(n) do { const unsigned char* _ub = STEP_UNIT(n); LAS unsigned char* _lb = F.lds + ((n) & 1) * UNIT_DMA; _Pragma("unroll") for (int _p = 0; _p < 10; ++_p) \
            if (_p * 8 + wv < UNIT_DMA / 1024) __builtin_amdgcn_global_load_lds((const unsigned*)(_ub + (_p * 8 + wv) * 1024 + lane * 16), (LAS unsigned*)(_lb + (_p * 8 + wv) * 1024), 16, 0, 0); } while (0)
    ISSUE(0);
    if (F.wave >= 4) {
        for (int n = 0; n < NCHUNK; ++n) { VM_WAIT(); __builtin_amdgcn_s_barrier(); asm volatile("" ::: "memory"); if (n + 1 < NCHUNK) ISSUE(n + 1); }
        VM_WAIT();
        return;
    }
    const int nt = F.wave, c = lane & 31, hh = lane >> 5;
    bf16_t* OGb = WSP(bf16_t, WS_OGB) + (size_t)dir * ML * 1024;
    f32x16 S[4];
#pragma unroll
    for (int kt = 0; kt < 4; ++kt)
#pragma unroll
        for (int i = 0; i < 16; ++i) S[kt][i] = 0.f;
#pragma unroll 1
    for (int n = 0; n < NCHUNK; ++n) {
        VM_WAIT(); __builtin_amdgcn_s_barrier(); asm volatile("" ::: "memory");
        if (n + 1 < NCHUNK) ISSUE(n + 1);
        const LAS unsigned char* lb = F.lds + (n & 1) * UNIT_DMA;
        const float dlc = *(const LAS float*)(lb + UO_DL);
        u32x4 ucur[2][2];
#pragma unroll
        for (int mt = 0; mt < 2; ++mt) { ucur[mt][0] = *(const LAS u32x4*)(lb + UO_U + (mt * 4 + nt) * 2048 + lane * 32); ucur[mt][1] = *(const LAS u32x4*)(lb + UO_U + (mt * 4 + nt) * 2048 + lane * 32 + 16); }
#define FRAG(off, idx) (*(const LAS bf16x8*)(lb + (off) + (idx) * 1024 + lane * 16))
        f32x16 VN[2], O[2];
#pragma unroll
        for (int mt = 0; mt < 2; ++mt) {
#pragma unroll
            for (int p = 0; p < 4; ++p) { VN[mt][2 * p] = bf_lo(ucur[mt][0][p]); VN[mt][2 * p + 1] = bf_hi(ucur[mt][0][p]); VN[mt][8 + 2 * p] = bf_lo(ucur[mt][1][p]); VN[mt][8 + 2 * p + 1] = bf_hi(ucur[mt][1][p]); }
#pragma unroll
            for (int i = 0; i < 16; ++i) O[mt][i] = 0.f; }
#pragma unroll
        for (int kt = 0; kt < 4; ++kt) { const bf16x8 sb0 = pack_step(S[kt], 0), sb1 = pack_step(S[kt], 1);
#pragma unroll
            for (int mt = 0; mt < 2; ++mt) { const int fi = (mt * 4 + kt) * 2;
                VN[mt] = MFMA32(FRAG(UO_NW, fi), sb0, VN[mt]); VN[mt] = MFMA32(FRAG(UO_NW, fi + 1), sb1, VN[mt]);
                O[mt] = MFMA32(FRAG(UO_QD, fi), sb0, O[mt]); O[mt] = MFMA32(FRAG(UO_QD, fi + 1), sb1, O[mt]); } }
        bf16x8 vb[2][2];
#pragma unroll
        for (int ct = 0; ct < 2; ++ct) { vb[ct][0] = pack_step(VN[ct], 0); vb[ct][1] = pack_step(VN[ct], 1); }
#pragma unroll
        for (int mt = 0; mt < 2; ++mt)
#pragma unroll
            for (int ct = 0; ct < 2; ++ct) { const int fi = (mt * 2 + ct) * 2; O[mt] = MFMA32(FRAG(UO_QK, fi), vb[ct][0], O[mt]); O[mt] = MFMA32(FRAG(UO_QK, fi + 1), vb[ct][1], O[mt]); }
#pragma unroll
        for (int kt = 0; kt < 4; ++kt) {
#pragma unroll
            for (int i = 0; i < 16; ++i) S[kt][i] *= dlc;
#pragma unroll
            for (int ct = 0; ct < 2; ++ct) { const int fi = (kt * 2 + ct) * 2; S[kt] = MFMA32(FRAG(UO_KDT, fi), vb[ct][0], S[kt]); S[kt] = MFMA32(FRAG(UO_KDT, fi + 1), vb[ct][1], S[kt]); } }
#undef FRAG
        const int cidx = STEP_CIDX(n);
        if (cidx >= CTXL / 64) { const int rowbase = b * SEQ + (cidx - CTXL / 64) * 64;
#pragma unroll
            for (int mt = 0; mt < 2; ++mt)
#pragma unroll
                for (int reg = 0; reg < 16; ++reg) { const int row = 32 * mt + (reg & 3) + 8 * (reg >> 2) + 4 * hh, prow = rowbase + (dir ? 63 - row : row);
                    OGb[(size_t)prow * 1024 + h * 128 + 32 * nt + c] = f2bf(O[mt][reg]); } }
    }
    VM_WAIT();
#undef ISSUE
#undef STEP_CIDX
#undef STEP_UNIT
}

struct MixRow { u32x4 oa[2], ob[2], zz[2], sb[2], cv[3][2], xv[3][2]; };
__device__ __forceinline__ MixRow mix_load(const bf16_t* P, const bf16_t* OGb, int row, int f0, int c0, bool horiz) {
    MixRow m; const int t = row % SEQ, gr = t / 64, gc = t % 64, dlt = horiz ? 1 : 64;
    const bool hasp = horiz ? (gc > 0) : (gr > 0), hasn = horiz ? (gc < 63) : (gr < SEQ / 64 - 1);
#pragma unroll
    for (int q = 0; q < 2; ++q) { m.oa[q] = *(const u32x4*)(OGb + (size_t)row * 1024 + f0 + 8 * q); m.ob[q] = *(const u32x4*)(OGb + (size_t)ML * 1024 + (size_t)row * 1024 + f0 + 8 * q);
        m.zz[q] = *(const u32x4*)(P + (size_t)row * NINP + COL_Z + f0 + 8 * q); m.sb[q] = *(const u32x4*)(P + (size_t)row * NINP + COL_SB + c0 + 8 * q); }
#pragma unroll
    for (int i = 0; i < 3; ++i) { const bool ok = i == 1 || (i == 0 ? hasp : hasn); const size_t rr = (size_t)(row + (ok ? (i - 1) * dlt : 0));
#pragma unroll
        for (int q = 0; q < 2; ++q) { m.cv[i][q] = *(const u32x4*)(P + rr * NINP + COL_SC + c0 + 8 * q); m.xv[i][q] = *(const u32x4*)(P + rr * NINP + COL_SX + c0 + 8 * q);
            if (!ok) m.cv[i][q] = (u32x4){0u, 0u, 0u, 0u}; } }
    return m;
}
__device__ __forceinline__ void p5_mix_out(Frame& F) {
    const bf16_t* P = WSP(const bf16_t, WS_P); const bf16_t* OGb = WSP(const bf16_t, WS_OGB); bf16_t* Y = WSP(bf16_t, WS_Y);
    const float* nw = F.in[I_GNW]; const float* cs = F.in[I_CONVSC];
    const int gw = F.bid * 8 + F.wave, NGW = F.G * 8;
    const int f0 = F.lane * 16, c0 = F.lane * 16; const bool horiz = c0 < 512;
    LAS float* nwL = (LAS float*)F.lds; LAS float* csL = nwL + 128;
    if (F.tid < 128) nwL[F.tid] = nw[F.tid];
    for (int i = F.tid; i < 3 * 1024; i += 512) csL[i] = cs[i];
    __syncthreads();
    if (gw >= ML) return;
    MixRow nx = mix_load(P, OGb, gw, f0, c0, horiz);
    for (int row = gw; row < ML; row += NGW) {
        const MixRow m = nx;
        if (row + NGW < ML) nx = mix_load(P, OGb, row + NGW, f0, c0, horiz);
        { float o[16]; float ss = 0.f;
#pragma unroll
          for (int q = 0; q < 2; ++q)
#pragma unroll
              for (int e = 0; e < 4; ++e) { const float s0 = bf_lo(m.oa[q][e]) + bf_lo(m.ob[q][e]), s1 = bf_hi(m.oa[q][e]) + bf_hi(m.ob[q][e]); o[8 * q + 2 * e] = s0; o[8 * q + 2 * e + 1] = s1; ss += s0 * s0 + s1 * s1; }
          ss += __shfl_xor(ss, 1); ss += __shfl_xor(ss, 2); ss += __shfl_xor(ss, 4);
          const float r = __builtin_amdgcn_rsqf(ss * (1.f / 128.f) + RMS_EPS);
          unsigned ow[8];
#pragma unroll
          for (int q = 0; q < 8; ++q) { const int f = (f0 + 2 * q) & 127; const unsigned zw = m.zz[q >> 2][q & 3];
              const float y0 = o[2 * q] * r * nwL[f] * silu_f(bf_lo(zw)), y1 = o[2 * q + 1] * r * nwL[f + 1] * silu_f(bf_hi(zw)); ow[q] = cvt_pk_bf16(y0, y1); }
          *(u32x4*)(Y + (size_t)row * D + f0) = (u32x4){ow[0], ow[1], ow[2], ow[3]}; *(u32x4*)(Y + (size_t)row * D + f0 + 8) = (u32x4){ow[4], ow[5], ow[6], ow[7]}; }
        { float acc[16];
#pragma unroll
          for (int q = 0; q < 16; ++q) acc[q] = 0.f;
#pragma unroll
          for (int i = 0; i < 3; ++i)
#pragma unroll
              for (int hh = 0; hh < 2; ++hh)
#pragma unroll
                  for (int q = 0; q < 4; ++q) { const int ch = c0 + 8 * hh + 2 * q; const unsigned cw = m.cv[i][hh][q], xw = m.xv[i][hh][q];
                      acc[8 * hh + 2 * q] += bf_lo(cw) * bf_lo(xw) * csL[i * 1024 + ch]; acc[8 * hh + 2 * q + 1] += bf_hi(cw) * bf_hi(xw) * csL[i * 1024 + ch + 1]; }
          unsigned ow[8];
#pragma unroll
          for (int q = 0; q < 8; ++q) { const unsigned bw = m.sb[q >> 2][q & 3]; ow[q] = cvt_pk_bf16(bf_lo(bw) * acc[2 * q], bf_hi(bw) * acc[2 * q + 1]); }
          *(u32x4*)(Y + (size_t)row * D + 1024 + c0) = (u32x4){ow[0], ow[1], ow[2], ow[3]}; *(u32x4*)(Y + (size_t)row * D + 1024 + c0 + 8) = (u32x4){ow[4], ow[5], ow[6], ow[7]}; }
    }
}

struct OutProj {
    static constexpr bool PERM = true, GATHER = false, FP8 = false, BBLK = false; typedef NoPre Pre;
    __device__ __forceinline__ Pre prefetch(const Unit&, int, int, int, int) const { return Pre{}; }
    int K; const char* A; const char* Bt; bf16_t* V; const float* x; const f32x2* st0; const float* g0; const float* b0; const float* modf; int G, c;
    __device__ __forceinline__ bool next(int i, Unit& u) const { const int L = i * G + c; if (L >= (ML / 256) * (D / 256)) return false; pg8::tile_order(L, ML / 256, D / 256, u.pm, u.pn); u.e = 0; return true; }
    __device__ __forceinline__ const char* bptr(const Unit& u, int half) const { return Bt + (size_t)(u.pn * 256 + half * 128) * K * 2; }
    __device__ __forceinline__ unsigned arow_i(int, const Unit& u, int r) const { return (unsigned)(u.pm * 256 + r); }
    __device__ __forceinline__ void epi(const f32x4 (&acc)[2][2][4][2], const Unit& u, int wr, int wc, int fr, int fq, const Pre&) const {
        const int row0 = u.pm * 256 + wr * 64 + fr, col0 = u.pn * 256 + wc * 32 + 8 * fq;
        const float* gt1 = modf + (size_t)(u.pm * 256 / SEQ) * (6 * D) + 2 * D;
        constexpr int XW = 4;
        f32x4 XA[16], XB[16]; f32x2 SS[16]; f32x4 PG[2][2], PB[2][2], PT[2][2];
#define OP_ROW(it_) (row0 + (((it_) >> 2) & 1) * 128 + ((it_) & 3) * 16)
#define OP_COL(it_) (col0 + ((it_) >> 3) * 128)
#define OP_LOAD(it_) do { SS[it_] = st0[OP_ROW(it_)]; XA[it_] = *(const f32x4*)(x + (size_t)OP_ROW(it_) * D + OP_COL(it_)); XB[it_] = *(const f32x4*)(x + (size_t)OP_ROW(it_) * D + OP_COL(it_) + 4); } while (0)
#define OP_PARAMS(bj_) do { const int _c = col0 + (bj_) * 128; PG[bj_][0] = *(const f32x4*)(g0 + _c); PG[bj_][1] = *(const f32x4*)(g0 + _c + 4); PB[bj_][0] = *(const f32x4*)(b0 + _c); PB[bj_][1] = *(const f32x4*)(b0 + _c + 4); \
            PT[bj_][0] = *(const f32x4*)(gt1 + _c); PT[bj_][1] = *(const f32x4*)(gt1 + _c + 4); } while (0)
        OP_PARAMS(0);
#pragma unroll
        for (int it = 0; it < XW; ++it) OP_LOAD(it);
#pragma unroll
        for (int it = 0; it < 16; ++it) { const int bj = it >> 3, ai = (it >> 2) & 1, m = it & 3; const f32x2 sv = SS[it];
            const f32x4 va = ((XA[it] - sv.x) * sv.y * PG[bj][0] + PB[bj][0]) * DN_ALPHA + PT[bj][0] * acc[ai][bj][m][0], vb = ((XB[it] - sv.x) * sv.y * PG[bj][1] + PB[bj][1]) * DN_ALPHA + PT[bj][1] * acc[ai][bj][m][1];
            *(u32x4*)(V + (size_t)OP_ROW(it) * D + OP_COL(it)) = (u32x4){cvt_pk_bf16(va[0], va[1]), cvt_pk_bf16(va[2], va[3]), cvt_pk_bf16(vb[0], vb[1]), cvt_pk_bf16(vb[2], vb[3])};
            if (it == 3) OP_PARAMS(1);
            if (it + XW < 16) OP_LOAD(it + XW); }
#undef OP_ROW
#undef OP_COL
#undef OP_LOAD
#undef OP_PARAMS
    }
};

constexpr int UT_PITCH = D + 4;
__device__ __forceinline__ void p7_ln1_router(Frame& F) {
    int tz_ = threadIdx.x; asm volatile("" : "+v"(tz_));
    const int tid_ = tz_, lane_ = tz_ & 63, wave_ = __builtin_amdgcn_readfirstlane(tz_ >> 6);
    LAS float* uT = (LAS float*)F.lds;
    LAS float* part = uT + 16 * UT_PITCH;
    LAS float* logit = part + 8 * 16 * 32;
    const bf16_t* V = WSP(const bf16_t, WS_V); f32x2* st1 = WSP(f32x2, WS_STAT1); const float* modf = WSP(const float, WS_MODF); unsigned char* U8 = WSP(unsigned char, WS_U);
    const float* g1 = F.in[I_LN1G]; const float* b1 = F.in[I_LN1B]; const float* wrt = F.in[I_WR]; const float* brt = F.in[I_BR];
    int* toke = WSP(int, WS_TOKE); int* tokp = WSP(int, WS_TOKP); float* tokg = WSP(float, WS_TOKG); int* list = WSP(int, WS_LIST);
    const int r16 = lane_ & 15, kk = lane_ >> 4;
    u32x2 vw[2][8];
#define LN1_LOAD(tile_) do { _Pragma("unroll") for (int _rr = 0; _rr < 2; ++_rr) { const u32x2* _xr = (const u32x2*)(V + (size_t)((tile_) * 16 + wave_ * 2 + _rr) * D) + lane_; \
            _Pragma("unroll") for (int _j = 0; _j < 8; ++_j) vw[_rr][_j] = _xr[64 * _j]; } } while (0)
    if (F.bid < ML / 16) LN1_LOAD(F.bid);
    for (int tile = F.bid; tile < ML / 16; tile += F.G) {
        const int rbase = tile * 16; const int bidx = rbase / SEQ; const float* sh2 = modf + (size_t)bidx * (6 * D) + 3 * D; const float* sc2 = sh2 + D;
        f32x4 pa[8], pc[8];
        unsigned dofs = 4u * (unsigned)lane_; asm volatile("" : "+v"(dofs));
#pragma unroll
        for (int j = 0; j < 8; ++j) { const f32x4 sc = *(const f32x4*)((sc2 + 256 * j) + dofs) + 1.f;
            pa[j] = *(const f32x4*)((g1 + 256 * j) + dofs) * sc; pc[j] = *(const f32x4*)((b1 + 256 * j) + dofs) * sc + *(const f32x4*)((sh2 + 256 * j) + dofs);
            if (j == 3) asm volatile("" ::: "memory"); }
#pragma unroll
        for (int rr = 0; rr < 2; ++rr) {
            const int lr = wave_ * 2 + rr, row = rbase + lr;
            f32x4 x[8]; float s = 0.f;
#pragma unroll
            for (int j = 0; j < 8; ++j) { const u32x2 w = vw[rr][j]; x[j] = (f32x4){bf_lo(w.x), bf_hi(w.x), bf_lo(w.y), bf_hi(w.y)}; s += (x[j].x + x[j].y) + (x[j].z + x[j].w); }
            const float mean = wave_sum(s) * (1.f / D); float s2 = 0.f;
#pragma unroll
            for (int j = 0; j < 8; ++j) { x[j] = x[j] - mean; s2 += (x[j].x * x[j].x + x[j].y * x[j].y) + (x[j].z * x[j].z + x[j].w * x[j].w); }
            const float rstd = 1.f / sqrtf(wave_sum(s2) * (1.f / D) + LN_EPS);
            if (lane_ == 0) st1[row] = (f32x2){mean, rstd}; unsigned* uo = (unsigned*)(U8 + (size_t)row * D) + lane_;
#pragma unroll
            for (int j = 0; j < 8; ++j) { const int d = 4 * lane_ + 256 * j;
                const f32x4 u = (x[j] * rstd) * pa[j] + pc[j];
                uo[64 * j] = pk_fp8x4(u.x, u.y, u.z, u.w);
                *(LAS f32x4*)(uT + lr * UT_PITCH + d) = u; }
        }
        unsigned wlo = (unsigned)(4 * kk * NE + r16); asm volatile("" : "+v"(wlo));
        float wl[16][4][2]; asm volatile("" ::: "memory");
#define RW_LOAD(m_) do { _Pragma("unroll") for (int _j = 0; _j < 4; ++_j) _Pragma("unroll") for (int _nt = 0; _nt < 2; ++_nt) \
            wl[m_][_j][_nt] = (wrt + (256 * wave_ + 16 * (m_)) * NE)[wlo + (unsigned)(_j * NE + 16 * _nt)]; } while (0)
#pragma unroll
        for (int m = 0; m < 12; ++m) RW_LOAD(m);
        __syncthreads();
        f32x4 lacc[2] = {{0.f, 0.f, 0.f, 0.f}, {0.f, 0.f, 0.f, 0.f}};
#pragma unroll
        for (int m = 0; m < 16; ++m) { const f32x4 a = *(const LAS f32x4*)(uT + r16 * UT_PITCH + 256 * wave_ + 16 * m + 4 * kk);
#pragma unroll
            for (int j = 0; j < 4; ++j) { lacc[0] = __builtin_amdgcn_mfma_f32_16x16x4f32(a[j], wl[m][j][0], lacc[0], 0, 0, 0); lacc[1] = __builtin_amdgcn_mfma_f32_16x16x4f32(a[j], wl[m][j][1], lacc[1], 0, 0, 0); }
            if (m == 3) { __builtin_amdgcn_sched_barrier(0); RW_LOAD(12); RW_LOAD(13); RW_LOAD(14); RW_LOAD(15); __builtin_amdgcn_sched_barrier(0); } }
#undef RW_LOAD
#pragma unroll
        for (int nt = 0; nt < 2; ++nt)
#pragma unroll
            for (int q = 0; q < 4; ++q) part[(wave_ * 16 + 4 * kk + q) * 32 + 16 * nt + r16] = lacc[nt][q];
        __syncthreads();
        if (tile + F.G < ML / 16) LN1_LOAD(tile + F.G);
        { const int lr = tid_ >> 5, e = tid_ & 31; float s = brt[e];
#pragma unroll
          for (int w = 0; w < 8; ++w) s += part[(w * 16 + lr) * 32 + e];
          logit[lr * 32 + e] = s; }
        __syncthreads();
        if (tid_ < 16) { const int row = rbase + tid_; float lv[32];
#pragma unroll
            for (int e = 0; e < 32; ++e) lv[e] = logit[tid_ * 32 + e];
            float tv[4]; int ti[4];
#pragma unroll
            for (int s4 = 0; s4 < 4; ++s4) { float best = -3.0e38f; int bi = 0;
#pragma unroll
                for (int e = 0; e < 32; ++e) { const bool take = lv[e] > best; best = take ? lv[e] : best; bi = take ? e : bi; }
                tv[s4] = best; ti[s4] = bi;
#pragma unroll
                for (int e = 0; e < 32; ++e) lv[e] = (e == bi) ? -3.0e38f : lv[e]; }
            const float e0 = 1.f, e1 = __expf(tv[1] - tv[0]), e2 = __expf(tv[2] - tv[0]), e3 = __expf(tv[3] - tv[0]); const float inv = 1.f / (e0 + e1 + e2 + e3);
            const float gg[4] = {e0 * inv, e1 * inv, e2 * inv, e3 * inv};
            int pos[4];
#pragma unroll
            for (int s4 = 0; s4 < 4; ++s4) pos[s4] = (int)__hip_atomic_fetch_add(F.ctl + CW_CNT + 64 * ti[s4], 1u, __ATOMIC_RELAXED, __HIP_MEMORY_SCOPE_AGENT);
            *(i32x4*)(toke + row * 4) = (i32x4){ti[0], ti[1], ti[2], ti[3]}; *(f32x4*)(tokg + row * 4) = (f32x4){gg[0], gg[1], gg[2], gg[3]};
            *(i32x4*)(tokp + row * 4) = (i32x4){pos[0], pos[1], pos[2], pos[3]};
#pragma unroll
            for (int s4 = 0; s4 < 4; ++s4) list[(size_t)ti[s4] * ML + pos[s4]] = row; }
        __syncthreads();
    }
#undef LN1_LOAD
}

struct MoeTab { const LAS int* cnt; const LAS int* pstart; };
__device__ __forceinline__ void moe_tables(Frame& F) {
    LAS int* cnt = (LAS int*)(F.lds + TAB_OFF); LAS int* ps = cnt + 32;
    if (F.tid < 32) cnt[F.tid] = (int)__hip_atomic_load(F.ctl + CW_CNT + 64 * F.tid, __ATOMIC_RELAXED, __HIP_MEMORY_SCOPE_AGENT);
    __syncthreads();
    if (F.tid == 0) { int a = 0; for (int e = 0; e < 32; ++e) { ps[e] = a; a += (cnt[e] + 255) / 256 * 256; } ps[32] = a; }
    __syncthreads();
    if (F.tid < MAXTILES) { int e = 0; const int r = F.tid * 256;
#pragma unroll
        for (int q = 1; q < 32; ++q) e = (ps[q] <= r) ? q : e;
        ps[48 + F.tid] = e; }
    __syncthreads();
}
__device__ __forceinline__ int moe_tile_expert(const LAS int* ps, int tile) { return ps[48 + tile]; }

struct MoeUp {
    static constexpr bool PERM = true, GATHER = true, FP8 = true, BBLK = true;
    int K, NB; const char* A; const char* Wg; const char* Wu; unsigned char* H; const float* bg; const float* bu; const int* list; const LAS int* cnt; const LAS int* ps; const LAS int* gtab; int G, c;
    __device__ __forceinline__ bool next(int i, Unit& u) const {
        const int NT = ps[32] / 256, NU = NT * 16, L = i * G + c; if (L >= NU) return false;
        pg8::tile_order(L, NT, 16, u.pm, u.pn); u.e = moe_tile_expert(ps, u.pm); return true;
    }
    __device__ __forceinline__ const char* bptr(const Unit& u, int half) const { return (half ? Wu : Wg) + (size_t)u.e * D * D + (size_t)(u.pn * 128) * 16; }
    __device__ __forceinline__ unsigned arow(const Unit& u, int r) const { const int loc = u.pm * 256 + r - ps[u.e]; return loc < cnt[u.e] ? (unsigned)list[(size_t)u.e * ML + loc] : 0u; }
    __device__ __forceinline__ unsigned arow_i(int ord, const Unit&, int r) const { return (unsigned)gtab[ord * 256 + r]; }
    struct Pre { f32x4 g0, g1, u0, u1; };
    __device__ __forceinline__ Pre prefetch(const Unit& u, int wr, int wc, int fr, int fq) const { const int col0 = u.pn * 128 + wc * 32 + 8 * fq; Pre p;
        p.g0 = *(const f32x4*)(bg + (size_t)u.e * D + col0); p.g1 = *(const f32x4*)(bg + (size_t)u.e * D + col0 + 4); p.u0 = *(const f32x4*)(bu + (size_t)u.e * D + col0); p.u1 = *(const f32x4*)(bu + (size_t)u.e * D + col0 + 4); return p; }
    __device__ __forceinline__ void epi(const f32x4 (&acc)[2][2][4][2], const Unit& u, int wr, int wc, int fr, int fq, const Pre& pre) const {
        const int row0 = u.pm * 256 + wr * 64 + fr, col0 = u.pn * 128 + wc * 32 + 8 * fq;
        const f32x4 g0 = pre.g0, g1 = pre.g1, u0 = pre.u0, u1 = pre.u1;
#pragma unroll
        for (int ai = 0; ai < 2; ++ai)
#pragma unroll
            for (int m = 0; m < 4; ++m) { float hv[8];
#pragma unroll
                for (int n = 0; n < 2; ++n)
#pragma unroll
                    for (int jp = 0; jp < 2; ++jp) { const int j = 2 * jp;
                        const f32x2 bgv = n ? (f32x2){g1[j], g1[j + 1]} : (f32x2){g0[j], g0[j + 1]}, buv = n ? (f32x2){u1[j], u1[j + 1]} : (f32x2){u0[j], u0[j + 1]};
                        f32x2 glu = (f32x2){acc[ai][0][m][n][j], acc[ai][0][m][n][j + 1]} * (1.f / W8_SCALE) + bgv, lin = (f32x2){acc[ai][1][m][n][j], acc[ai][1][m][n][j + 1]} * (1.f / W8_SCALE) + buv;
                        glu.x = fminf(glu.x, 7.0f); glu.y = fminf(glu.y, 7.0f); lin.x = __builtin_amdgcn_fmed3f(lin.x, -7.0f, 7.0f); lin.y = __builtin_amdgcn_fmed3f(lin.y, -7.0f, 7.0f);
                        const f32x2 ea = glu * (-1.702f * 1.4426950408889634f); f32x2 dn; dn.x = __builtin_amdgcn_exp2f(ea.x); dn.y = __builtin_amdgcn_exp2f(ea.y); dn = dn + 1.0f;
                        f32x2 sg; sg.x = __builtin_amdgcn_rcpf(dn.x); sg.y = __builtin_amdgcn_rcpf(dn.y);
                        const f32x2 hh2 = (glu * sg) * (lin * H8_SCALE + H8_SCALE); hv[4 * n + j] = hh2.x; hv[4 * n + j + 1] = hh2.y; }
                *(u32x2*)(H + (size_t)(row0 + ai * 128 + m * 16) * D + col0) = (u32x2){pk_fp8x4(hv[0], hv[1], hv[2], hv[3]), pk_fp8x4(hv[4], hv[5], hv[6], hv[7])}; }
    }
};
struct MoeDown {
    static constexpr bool PERM = true, GATHER = false, FP8 = true, BBLK = true;
    int K, NB; const char* A; const char* Wd; unsigned char* O; const float* bd; const LAS int* ps; int G, c;
    __device__ __forceinline__ bool next(int i, Unit& u) const {
        const int NT = ps[32] / 256, NU = NT * 8, L = i * G + c; if (L >= NU) return false;
        pg8::tile_order(L, NT, 8, u.pm, u.pn); u.e = moe_tile_expert(ps, u.pm); return true;
    }
    __device__ __forceinline__ const char* bptr(const Unit& u, int half) const { return Wd + (size_t)u.e * D * D + (size_t)(u.pn * 256 + half * 128) * 16; }
    __device__ __forceinline__ unsigned arow_i(int, const Unit& u, int r) const { return (unsigned)(u.pm * 256 + r); }
    struct Pre { f32x4 c[2][2]; };
    __device__ __forceinline__ Pre prefetch(const Unit& u, int wr, int wc, int fr, int fq) const { const int col0 = u.pn * 256 + wc * 32 + 8 * fq; Pre p;
#pragma unroll
        for (int bj = 0; bj < 2; ++bj) { p.c[bj][0] = *(const f32x4*)(bd + (size_t)u.e * D + col0 + bj * 128); p.c[bj][1] = *(const f32x4*)(bd + (size_t)u.e * D + col0 + bj * 128 + 4); }
        return p; }
    __device__ __forceinline__ void epi(const f32x4 (&acc)[2][2][4][2], const Unit& u, int wr, int wc, int fr, int fq, const Pre& pre) const {
        const int row0 = u.pm * 256 + wr * 64 + fr, col0 = u.pn * 256 + wc * 32 + 8 * fq;
#pragma unroll
        for (int bj = 0; bj < 2; ++bj) { const f32x4 c0 = pre.c[bj][0], c1 = pre.c[bj][1];
#pragma unroll
            for (int ai = 0; ai < 2; ++ai)
#pragma unroll
                for (int m = 0; m < 4; ++m) { const f32x4 v0 = acc[ai][bj][m][0] * (O8_SCALE / (W8_SCALE * H8_SCALE)) + c0 * O8_SCALE, v1 = acc[ai][bj][m][1] * (O8_SCALE / (W8_SCALE * H8_SCALE)) + c1 * O8_SCALE;
#define SAT8(x) __builtin_amdgcn_fmed3f((x), -448.f, 448.f)
                    *(u32x2*)(O + (size_t)(row0 + ai * 128 + m * 16) * D + col0 + bj * 128) = (u32x2){pk_fp8x4(SAT8(v0[0]), SAT8(v0[1]), SAT8(v0[2]), SAT8(v0[3])), pk_fp8x4(SAT8(v1[0]), SAT8(v1[1]), SAT8(v1[2]), SAT8(v1[3]))}; } }
#undef SAT8
    }
};

__device__ __forceinline__ void p10_final(Frame& F) {
    int tz_ = threadIdx.x; asm volatile("" : "+v"(tz_));
    const int tid_ = tz_, lane_ = tz_ & 63, wave_ = __builtin_amdgcn_readfirstlane(tz_ >> 6);
    const LAS int* ps = (const LAS int*)(F.lds + TAB_OFF) + 32;
    const unsigned char* O = WSP(const unsigned char, WS_O); const float* modf = WSP(const float, WS_MODF); const bf16_t* V = WSP(const bf16_t, WS_V); const f32x2* st1 = WSP(const f32x2, WS_STAT1);
    const float* g1 = F.in[I_LN1G]; const float* b1 = F.in[I_LN1B];
    const i32x4* toke = WSP(const i32x4, WS_TOKE); const i32x4* tokp = WSP(const i32x4, WS_TOKP); const f32x4* tokg = WSP(const f32x4, WS_TOKG);
    const float* g2 = F.in[I_LN2G]; const float* b2 = F.in[I_LN2B];
    const int gw = F.bid * 8 + wave_, NGW = F.G * 8;
    LAS float* PL = (LAS float*)F.lds;
    for (int i = tid_; i < D; i += 512) { PL[i] = g1[i]; PL[D + i] = b1[i]; PL[2 * D + i] = g2[i]; PL[3 * D + i] = b2[i]; PL[4 * D + i] = modf[5 * D + i]; PL[5 * D + i] = modf[(size_t)(6 * D) + 5 * D + i]; }
    __syncthreads();
    if (gw >= ML) return;
    i32x4 ne = toke[gw], np = tokp[gw]; f32x4 ng = tokg[gw];
    unsigned own[4][8]; u32x2 hwn[8]; f32x2 srn; f32x4 cgn;
#define FIN_GATHER(row_) do { _Pragma("unroll") for (int _s = 0; _s < 4; ++_s) { const unsigned* _or = (const unsigned*)(O + (size_t)(ps[ne[_s]] + np[_s]) * D) + lane_; \
            _Pragma("unroll") for (int _j = 0; _j < 8; ++_j) own[_s][_j] = _or[64 * _j]; } \
        { const u32x2* _hr = (const u32x2*)(V + (size_t)(row_) * D) + lane_; _Pragma("unroll") for (int _j = 0; _j < 8; ++_j) hwn[_j] = _hr[64 * _j]; } \
        srn = st1[row_]; cgn = ng; } while (0)
    FIN_GATHER(gw);
    if (gw + NGW < ML) { ne = toke[gw + NGW]; np = tokp[gw + NGW]; ng = tokg[gw + NGW]; }
    for (int row = gw; row < ML; row += NGW) {
        unsigned ow[4][8]; u32x2 hw[8];
#pragma unroll
        for (int s4 = 0; s4 < 4; ++s4)
#pragma unroll
            for (int j = 0; j < 8; ++j) ow[s4][j] = own[s4][j];
#pragma unroll
        for (int j = 0; j < 8; ++j) hw[j] = hwn[j];
        const f32x2 sr = srn; const f32x4 cg = cgn;
        if (row + NGW < ML) { FIN_GATHER(row + NGW);
            if (row + 2 * NGW < ML) { ne = toke[row + 2 * NGW]; np = tokp[row + 2 * NGW]; ng = tokg[row + 2 * NGW]; } }
        const LAS float* gt2 = PL + 4 * D + (row / SEQ) * D;
        f32x4 f[8]; float s = 0.f;
#pragma unroll
        for (int j = 0; j < 8; ++j) { f32x4 a = {0.f, 0.f, 0.f, 0.f};
#pragma unroll
            for (int s4 = 0; s4 < 4; ++s4) { const unsigned w = ow[s4][j]; const f32x2 lo = __builtin_amdgcn_cvt_pk_f32_fp8((int)w, false), hi = __builtin_amdgcn_cvt_pk_f32_fp8((int)w, true); a += (f32x4){lo.x, lo.y, hi.x, hi.y} * (cg[s4] * (1.f / O8_SCALE)); }
            const int d = 4 * lane_ + 256 * j; const u32x2 h = hw[j];
            const f32x4 h1 = ((f32x4){bf_lo(h.x), bf_hi(h.x), bf_lo(h.y), bf_hi(h.y)} - sr.x) * sr.y * *(const LAS f32x4*)(PL + d) + *(const LAS f32x4*)(PL + D + d);
            f[j] = h1 * DN_ALPHA + *(const LAS f32x4*)(gt2 + d) * a; s += (f[j].x + f[j].y) + (f[j].z + f[j].w);
            if (j & 1) __builtin_amdgcn_sched_barrier(0); }
        const float mean = wave_sum(s) * (1.f / D); float s2 = 0.f;
#pragma unroll
        for (int j = 0; j < 8; ++j) { f[j] = f[j] - mean; s2 += (f[j].x * f[j].x + f[j].y * f[j].y) + (f[j].z * f[j].z + f[j].w * f[j].w); }
        const float rstd = __builtin_amdgcn_rsqf(wave_sum(s2) * (1.f / D) + LN_EPS);
        f32x4* orw = (f32x4*)(F.out + (size_t)row * D) + lane_;
#pragma unroll
        for (int j = 0; j < 8; ++j) { const int d = 4 * lane_ + 256 * j; orw[64 * j] = f[j] * rstd * *(const LAS f32x4*)(PL + 2 * D + d) + *(const LAS f32x4*)(PL + 3 * D + d); }
    }
#undef FIN_GATHER
}

constexpr int NPHASE = 12;
__global__ void __launch_bounds__(512, 2) fwd_kernel(Args args) {
    extern __shared__ __attribute__((aligned(16))) unsigned char lds_raw[];
    Frame F;
    F.lds = (LAS unsigned char*)lds_raw; F.MISC = (volatile LAS unsigned*)(F.lds + MISC_OFF);
    F.tid = threadIdx.x; F.lane = F.tid & 63; F.wave = __builtin_amdgcn_readfirstlane(F.tid >> 6); F.G = gridDim.x; F.bid = blockIdx.x;
    F.ws = args.ws; F.ctl = (unsigned*)(args.ws + WS_CTL); F.in = args.in; F.out = args.out;
    if (F.tid < 128) ((LAS unsigned*)(F.lds + MISC_OFF))[F.tid] = 0u;
    __syncthreads();
    const int lo = args.ph_lo, hi = args.ph_hi;
    XcdBarrier bar; bar.bar = F.ctl + CW_BAR + args.li * XCD_BAR_WORDS; bar.x = 0; bar.st = nullptr;
    if (hi - lo > 1) bar = xcd_barrier_post(F.ctl + CW_BAR + args.li * XCD_BAR_WORDS, F.MISC);
#ifndef PH_MASK
#define PH_MASK 0xfff
#endif
#define IN(k) (((PH_MASK >> (k)) & 1) && lo <= (k) && (k) < hi)
#define SEAM(k) do { if (IN(k) && IN((k) + 1)) xcd_barrier(bar); } while (0)
#ifndef PROBE_DBL
#define PROBE_DBL -1
#endif
#define REP(k) for (int _rep = 0; _rep < ((PROBE_DBL == (k)) ? 2 : 1); ++_rep)
    if (IN(0)) REP(0) { p0_prologue(F); if (PROBE_DBL == 0) { VM_WAIT(); __syncthreads(); } } SEAM(0);
    if (IN(1)) REP(1) { p1_ln0(F); if (PROBE_DBL == 1) { VM_WAIT(); __syncthreads(); } } SEAM(1);
    if (IN(2)) REP(2) { const int gconv = (F.G > 2 * NCONV_WG) ? NCONV_WG : 0, ggemm = F.G - gconv;
                 if (F.bid < ggemm) { InProj S{D, (const char*)WSP(bf16_t, WS_HM), (const char*)WSP(bf16_t, WS_WIN), WSP(bf16_t, WS_P), ggemm, F.bid}; pg8::gemm_phase(F.lds, S); }
                 else if (PROBE_DBL != 2 || _rep == 0) convert_experts(F, (F.bid - ggemm) * 8 + F.wave, gconv * 8, 0, ti_early(F.G)); } SEAM(2);
    if (IN(3)) REP(3) { p3a_tokens(F); if (PROBE_DBL == 3) { VM_WAIT(); __syncthreads(); } } SEAM(3);
    if (IN(4)) REP(4) { p3_prep(F); if (PROBE_DBL == 4) { VM_WAIT(); __syncthreads(); } } SEAM(4);
    if (IN(5)) { p4_scan(F); if (PROBE_DBL == 5) { VM_WAIT(); __syncthreads(); p4_scan(F); } } SEAM(5);
    if (IN(6)) REP(6) { p5_mix_out(F); if (PROBE_DBL == 6) { VM_WAIT(); __syncthreads(); } } SEAM(6);
    if (IN(7)) REP(7) { OutProj S{D, (const char*)WSP(bf16_t, WS_Y), (const char*)WSP(bf16_t, WS_WOUT), WSP(bf16_t, WS_V), F.in[I_X], WSP(const f32x2, WS_STAT0), F.in[I_LN0G], F.in[I_LN0B], WSP(const float, WS_MODF), F.G, F.bid};
                 pg8::gemm_phase(F.lds, S); } SEAM(7);
    if (IN(8)) { p7_ln1_router(F); } SEAM(8);
    if (IN(9) || IN(10) || IN(11)) moe_tables(F);
    if (IN(9)) REP(9) { const LAS int* cnt = (const LAS int*)(F.lds + TAB_OFF);
                 LAS int* gtab = (LAS int*)(F.lds + GTAB_OFF);
                 MoeUp S{D / 2, D, (const char*)WSP(unsigned char, WS_U), (const char*)WSP(unsigned char, WS_WG), (const char*)WSP(unsigned char, WS_WU), WSP(unsigned char, WS_H), F.in[I_BGATE], F.in[I_BUP], WSP(const int, WS_LIST), cnt, cnt + 32, gtab, F.G, F.bid};
                 { int gi[GTAB_UNITS / 2];
#pragma unroll
                   for (int k = 0; k < GTAB_UNITS / 2; ++k) { const int i = 2 * k + (F.tid >> 8); Unit u; gi[k] = -1; if (S.next(i, u)) gi[k] = (int)S.arow(u, F.tid & 255); }
#pragma unroll
                   for (int k = 0; k < GTAB_UNITS / 2; ++k) { const int i = 2 * k + (F.tid >> 8); if (gi[k] >= 0) gtab[i * 256 + (F.tid & 255)] = gi[k]; } }
                 __syncthreads();
                 pg8::gemm_phase(F.lds, S); } SEAM(9);
    if (IN(10)) REP(10) { const LAS int* cnt = (const LAS int*)(F.lds + TAB_OFF);
                 MoeDown S{D / 2, D, (const char*)WSP(unsigned char, WS_H), (const char*)WSP(unsigned char, WS_WD), WSP(unsigned char, WS_O), F.in[I_BDOWN], cnt + 32, F.G, F.bid};
                 pg8::gemm_phase(F.lds, S); } SEAM(10);
    if (IN(11)) { p10_final(F); }
#undef IN
#undef SEAM
}

extern "C" void kernel_launch(void* const* d_in, const int* in_sizes, int n_in, void* d_out, int out_size, void* d_ws, size_t ws_size, hipStream_t stream) {
    static int grid = 0;
    if (grid == 0) {
        if (n_in != 27 || out_size != ML * D || ws_size < WS_END) { fprintf(stderr, "kernel_launch: unexpected problem (n_in %d, out %d, ws %zu < %zu)\n", n_in, out_size, ws_size, (size_t)WS_END); grid = -1; return; }
        int dev = 0, cus = 0, per_cu = 0;
        if (hipGetDevice(&dev) != hipSuccess || hipDeviceGetAttribute(&cus, hipDeviceAttributeMultiprocessorCount, dev) != hipSuccess) { grid = -1; return; }
        if (hipFuncSetAttribute((const void*)fwd_kernel, hipFuncAttributeMaxDynamicSharedMemorySize, LDS_BYTES) != hipSuccess) { fprintf(stderr, "kernel_launch: hipFuncSetAttribute failed\n"); grid = -1; return; }
        if (hipOccupancyMaxActiveBlocksPerMultiprocessor(&per_cu, (const void*)fwd_kernel, 512, LDS_BYTES) != hipSuccess || per_cu < 1) { fprintf(stderr, "kernel_launch: occupancy query says %d\n", per_cu); }
        (void)hipGetLastError();
        grid = cus;
    }
    if (grid < 0) return;
    if (hipMemsetAsync((char*)d_ws + WS_CTL, 0, CTL_BYTES, stream) != hipSuccess) return;
    Args a{};
    for (int i = 0; i < 27; ++i) a.in[i] = (const float*)d_in[i];
    a.out = (float*)d_out; a.ws = (unsigned char*)d_ws; a.pad = 0;
#if MK_N_LAUNCHES == 1
    a.ph_lo = 0; a.ph_hi = NPHASE; a.li = 0;
    hipLaunchKernelGGL(fwd_kernel, dim3(grid), dim3(512), LDS_BYTES, stream, a);
#else
    for (int p = 0; p < NPHASE; ++p) { a.ph_lo = p; a.ph_hi = p + 1; a.li = 0; hipLaunchKernelGGL(fwd_kernel, dim3(grid), dim3(512), LDS_BYTES, stream, a); }
#endif
}
```

```cpp
#include <hip/hip_runtime.h>
#include <cstdio>
#include <cstdint>

#ifndef MK_N_LAUNCHES
#define MK_N_LAUNCHES 1
#endif

#define LAS __attribute__((address_space(3)))
#define GAS __attribute__((address_space(1)))
typedef unsigned short bf16_t;
typedef short bf16x8 __attribute__((ext_vector_type(8)));
typedef float f32x4 __attribute__((ext_vector_type(4)));
typedef float f32x2 __attribute__((ext_vector_type(2)));
typedef unsigned u32x4 __attribute__((ext_vector_type(4)));
typedef unsigned u32x2 __attribute__((ext_vector_type(2)));

constexpr int D = 2048, NBATCH = 2, SEQ = 8192, ML = NBATCH * SEQ, CTXL = 256, MC = NBATCH * CTXL, MTOT = ML + MC;
constexpr int NH = 8, DK = 128, GQK = 1024, GQKV = 3072, GIN = 3104, NIN = 7200, NINP = 7424;
constexpr int COL_A = 3072, COL_B = 3088, COL_Z = 3104, COL_SB = 4128, COL_SC = 5152, COL_SX = 6176;
constexpr int NE = 32, TOPK = 4, MAXROWS = ML * TOPK + NE * 256, MAXTILES = MAXROWS / 256;
constexpr float LN_EPS = 1e-5f, RMS_EPS = 1e-6f;
constexpr float DN_ALPHA = 1.189207115002721f;
constexpr int NPART = 8;

constexpr size_t MiB = 1ull << 20;
constexpr size_t WS_CTL = 0, CTL_BYTES = 64 * 1024;
constexpr size_t WS_MODP = 1 * MiB;
constexpr size_t WS_MODF = 3 * MiB;
constexpr size_t WS_STAT0 = 4 * MiB;
constexpr size_t WS_STAT1 = 4 * MiB + 512 * 1024;
constexpr size_t WS_TOKE = 5 * MiB;
constexpr size_t WS_TOKP = WS_TOKE + 256 * 1024;
constexpr size_t WS_TOKG = WS_TOKP + 256 * 1024;
constexpr size_t WS_LIST = 6 * MiB;
constexpr size_t WS_WIN = 8 * MiB;
constexpr size_t WS_WOUT = 38 * MiB;
constexpr size_t WS_WG = 48 * MiB, WS_WU = 304 * MiB, WS_WD = 560 * MiB;
constexpr size_t WS_HM = 816 * MiB;
constexpr size_t WS_P = 882 * MiB;
constexpr size_t WS_PREP = 1122 * MiB;
constexpr size_t WS_OGB = 1424 * MiB;
constexpr size_t WS_Y = 1488 * MiB;
constexpr size_t WS_V = 1552 * MiB;
constexpr size_t WS_H1B = 1616 * MiB;
constexpr size_t WS_U = 1680 * MiB;
constexpr size_t WS_H = 882 * MiB;
constexpr size_t WS_O = 1170 * MiB;
constexpr size_t WS_END = 1744 * MiB;
constexpr size_t WS_QKVB = WS_V;
constexpr size_t WS_GBF = WS_U;
#ifdef GDN_NAIVE
constexpr size_t WS_QKV = 1744 * MiB;
constexpr size_t WS_GB = 1942 * MiB;
constexpr size_t WS_OG = 1946 * MiB;
#endif
constexpr int NCHUNK = (CTXL + SEQ) / 64, NUNITS = NBATCH * NCHUNK * NH * 2;
constexpr int UNIT_BYTES = 74752, UO_NW = 0, UO_QD = 16384, UO_KDT = 32768, UO_QK = 49152, UO_U = 57344, UO_DL = 73728, UNIT_DMA = 74752;
static_assert(WS_WIN + (size_t)NINP * D * 2 <= WS_WOUT && WS_P + (size_t)MTOT * NINP * 2 <= WS_PREP && WS_PREP + (size_t)NUNITS * UNIT_BYTES <= WS_OGB, "ws map");
static_assert(WS_H + (size_t)MAXROWS * D * 2 <= WS_O && WS_O + (size_t)MAXROWS * D * 2 <= WS_Y && WS_OGB + (size_t)2 * ML * 1024 * 2 <= WS_Y, "ws map 2");
constexpr int CW_CNT = 1024;
constexpr int CW_BAR = 8192;

constexpr int LDS_BYTES = 155648;
constexpr int MISC_OFF = 155136;
constexpr int GTAB_OFF = 131072, GTAB_UNITS = 18;
constexpr int TAB_OFF = 151552;

__device__ __forceinline__ unsigned cvt_pk_bf16(float lo, float hi) { unsigned r; asm volatile("v_cvt_pk_bf16_f32 %0, %1, %2" : "=v"(r) : "v"(lo), "v"(hi)); return r; }
__device__ __forceinline__ float bf_lo(unsigned w) { return __uint_as_float(w << 16); }
__device__ __forceinline__ float bf_hi(unsigned w) { return __uint_as_float(w & 0xffff0000u); }
__device__ __forceinline__ float bf2f(bf16_t b) { return __uint_as_float(((unsigned)b) << 16); }
__device__ __forceinline__ float silu_f(float x) { return x * __builtin_amdgcn_rcpf(1.0f + __expf(-x)); }
__device__ __forceinline__ float sigmoid_f(float x) { return __builtin_amdgcn_rcpf(1.0f + __expf(-x)); }
__device__ __forceinline__ float softplus_f(float x) { return x > 20.f ? x : log1pf(__expf(x)); }
__device__ __forceinline__ float wave_sum(float v) {
#pragma unroll
    for (int o = 1; o < 64; o <<= 1) v += __shfl_xor(v, o);
    return v;
}
typedef int i32x8 __attribute__((ext_vector_type(8)));
typedef int i32x4 __attribute__((ext_vector_type(4)));
__device__ __forceinline__ unsigned pk_fp8x4(float a, float b, float c, float d) { int w = __builtin_amdgcn_cvt_pk_fp8_f32(a, b, 0, false); w = __builtin_amdgcn_cvt_pk_fp8_f32(c, d, w, true); return (unsigned)w; }
constexpr float W8_SCALE = 64.f, H8_SCALE = 8.f, O8_SCALE = 16.f;
#define LDS_WAIT() asm volatile("s_waitcnt lgkmcnt(0)" ::: "memory")
#define VM_WAIT() asm volatile("s_waitcnt vmcnt(0)" ::: "memory")

#define XB_TMO      128
#define XB_XCNT(j)  (256  + 64 * (j))
#define XB_XSUB(j)  (1280 + 64 * (j))
#define XB_XGEN(j)  (2304 + 64 * (j))
#define XB_TOP      3328
#define XB_TOPGEN   3392
#define XCD_BAR_WORDS 3456
#define XB_SPIN_CAP (1u << 22)

__device__ __forceinline__ unsigned xb_ld(unsigned* p)              { return __hip_atomic_load(p, __ATOMIC_RELAXED, __HIP_MEMORY_SCOPE_AGENT); }
__device__ __forceinline__ unsigned xb_add(unsigned* p, unsigned v) { return __hip_atomic_fetch_add(p, v, __ATOMIC_RELAXED, __HIP_MEMORY_SCOPE_AGENT); }
__device__ __forceinline__ unsigned xb_xcc_id() { return (unsigned)__builtin_amdgcn_s_getreg((3 << 11) | 20) & 0xFu; }
#define XB_SPIN(cond, bar) do { unsigned _sp = 0; while (cond) { __builtin_amdgcn_s_sleep(1); \
    if ((++_sp & 255u) == 0u) { if (xb_ld(&(bar)[XB_TMO])) break; if (_sp > XB_SPIN_CAP) { atomicAdd(&(bar)[XB_TMO], 1u); break; } } } } while (0)

struct XcdBarrier { unsigned* bar; unsigned x; volatile LAS unsigned* st; };

__device__ __forceinline__ XcdBarrier xcd_barrier_post(unsigned* bar, volatile LAS unsigned* st) {
    XcdBarrier b; b.bar = bar; b.x = xb_xcc_id(); b.st = st;
    if (threadIdx.x == 0) (void)xb_add(&bar[XB_XCNT(b.x)], 1u);
    return b;
}
__device__ __forceinline__ void xcd_barrier_complete(unsigned* bar, unsigned x, unsigned& nloc, unsigned& nx) {
    const unsigned G = gridDim.x * gridDim.y * gridDim.z;
    unsigned sum, cnt, mine, sp = 0u;
    for (;;) {
        sum = 0u; cnt = 0u; mine = 0u;
#pragma unroll
        for (unsigned j = 0; j < 16; ++j) { const unsigned c = xb_ld(&bar[XB_XCNT(j)]); sum += c; cnt += (c > 0u) ? 1u : 0u; mine = (j == x) ? c : mine; }
        if (sum == G) break;
        __builtin_amdgcn_s_sleep(1);
        if ((++sp & 255u) == 0u) { if (xb_ld(&bar[XB_TMO])) break; if (sp > XB_SPIN_CAP) { atomicAdd(&bar[XB_TMO], 1u); break; } }
    }
    nloc = mine > 0u ? mine : 1u; nx = cnt > 0u ? cnt : 1u;
}
__device__ __forceinline__ void xcd_barrier(const XcdBarrier& b) {
    asm volatile("s_waitcnt vmcnt(0)" ::: "memory");
    __syncthreads();
    if (threadIdx.x == 0) {
        unsigned* bar = b.bar;
        __builtin_amdgcn_s_waitcnt(0);
        unsigned nloc = b.st[0], nx = b.st[1];
        if (nloc == 0u) { xcd_barrier_complete(bar, b.x, nloc, nx); b.st[0] = nloc; b.st[1] = nx; }
        const unsigned old = xb_add(&bar[XB_XSUB(b.x)], 1u);
        const unsigned gen = old / nloc;
        if (old + 1u == (gen + 1u) * nloc) {
            __builtin_amdgcn_fence(__ATOMIC_RELEASE, "agent");
            asm volatile("s_waitcnt vmcnt(0)" ::: "memory");
            const unsigned og = xb_add(&bar[XB_TOP], 1u);
            const unsigned tg = og / nx;
            if (og + 1u == (tg + 1u) * nx) xb_add(&bar[XB_TOPGEN], 1u);
            else XB_SPIN(xb_ld(&bar[XB_TOPGEN]) == tg, bar);
            __builtin_amdgcn_fence(__ATOMIC_ACQUIRE, "agent");
            xb_add(&bar[XB_XGEN(b.x)], 1u);
            asm volatile("s_waitcnt vmcnt(0)" ::: "memory");
        } else {
            XB_SPIN(xb_ld(&bar[XB_XGEN(b.x)]) == gen, bar);
            __builtin_amdgcn_fence(__ATOMIC_ACQUIRE, "agent");
            asm volatile("s_waitcnt vmcnt(0)" ::: "memory");
        }
    }
    __syncthreads();
}

struct Args { const float* in[27]; float* out; unsigned char* ws; int ph_lo, ph_hi, li, pad; };
enum { I_X = 0, I_C, I_CTX, I_CCTX, I_LN0G, I_LN0B, I_WADA, I_BADA, I_WIN, I_CONVQKV, I_ALOG, I_DTB, I_GNW, I_CONVSC, I_WOUT, I_LN1G, I_LN1B, I_WR, I_BR,
       I_WGATE, I_BGATE, I_WUP, I_BUP, I_WDOWN, I_BDOWN, I_LN2G, I_LN2B };

namespace pg8 {
constexpr int BM = 256, BK = 64, HALF = 128, HTB = HALF * BK * 2, STAGE_BYTES = 8 * HTB, NXCD = 8, WGM = 8;
__host__ __device__ __forceinline__ int lds_byte(int r, int c) { const int st = (r >> 4) * 2 + (c >> 5), rr = r & 15, cc = c & 31, ob = rr * 64 + cc * 2; return st * 1024 + (ob ^ (((ob >> 9) & 1) << 5)); }
__host__ __device__ __forceinline__ void stage_rc(int b, int& R, int& C) { const int st = b / 1024, sb = b % 1024, swz = sb ^ (((sb >> 9) & 1) << 5); R = (st >> 1) * 16 + swz / 64; C = (st & 1) * 32 + (swz % 64) / 2; }
__host__ __device__ __forceinline__ int perm32(int rho) { const int n = rho >> 4, i = rho & 15; return 8 * (i >> 2) + 4 * n + (i & 3); }

struct Unit { int pm, pn, e; };
__device__ __forceinline__ void tile_order(int L, int nM, int nN, int& pm, int& pn) {
    const int nwg = nM * nN; int wgid = L;
    { const int q = nwg / NXCD, r = nwg % NXCD, xcd = wgid % NXCD, off = wgid / NXCD; wgid = (xcd < r ? xcd * (q + 1) : r * (q + 1) + (xcd - r) * q) + off; }
    const int nig = WGM * nN, gid = wgid / nig, fm = gid * WGM, gsz = (nM - fm) < WGM ? (nM - fm) : WGM;
    pm = fm + ((wgid % nig) % gsz); pn = (wgid % nig) / gsz;
}

template <class P>
__device__ __forceinline__ void gemm_phase(LAS unsigned char* lds, const P& S) {
    int tid = threadIdx.x; asm volatile("" : "+v"(tid));
    const int wid = __builtin_amdgcn_readfirstlane(tid >> 6), lane = tid & 63, wr = wid >> 2, wc = wid & 3, fr = lane & 15, fq = lane >> 4;
    const int K = S.K, nt = K / BK;
    unsigned voffB[2]; int RA[2], CA[2];
#pragma unroll
    for (int i = 0; i < 2; ++i) { int R, C; stage_rc(tid * 16 + i * 8192, R, C); const int Rb = P::PERM ? ((R & ~31) + perm32(R & 31)) : R;
        RA[i] = R; CA[i] = C; if constexpr (P::BBLK) voffB[i] = (unsigned)((C >> 3) * S.NB + Rb) * 16u; else voffB[i] = (unsigned)(Rb * K + C) * 2u; }
    const size_t kstep = (size_t)(BK * 2);
    size_t kstepB = kstep; if constexpr (P::BBLK) kstepB = (size_t)128 * (size_t)S.NB;
    const unsigned ldsw = (unsigned)wid * 1024u;
    const int aoff = lds_byte(wr * 64 + fr, fq * 8), boff = lds_byte(wc * 32 + fr, fq * 8);
#define PG8_SA(b, h) (((b) * 2 + (h)) * HTB)
#define PG8_SB(b, h) ((4 + (b) * 2 + (h)) * HTB)
#define PG8_STAGE_B(bufoff, gbase) do { _Pragma("unroll") for (int _i = 0; _i < 2; ++_i) \
        __builtin_amdgcn_global_load_lds((const unsigned*)((const char*)(gbase) + voffB[_i]), (LAS unsigned*)(lds + (bufoff) + ldsw + _i * 8192), 16, 0, 0); } while (0)
#define PG8_STAGE_A(bufoff, AO, h, kb) do { _Pragma("unroll") for (int _i = 0; _i < 2; ++_i) \
        __builtin_amdgcn_global_load_lds((const unsigned*)(S.A + (size_t)(AO)[h][_i] + (size_t)(kb)), (LAS unsigned*)(lds + (bufoff) + ldsw + _i * 8192), 16, 0, 0); } while (0)
#define PG8_LDA(dst, b, h) do { _Pragma("unroll") for (int m = 0; m < 4; ++m) { dst[m].lo = *(const LAS i32x4*)(lds + PG8_SA(b, h) + aoff + m * 2048); dst[m].hi = *(const LAS i32x4*)(lds + PG8_SA(b, h) + aoff + m * 2048 + 1024); } } while (0)
#define PG8_LDB(dst, b, h) do { _Pragma("unroll") for (int n = 0; n < 2; ++n) { dst[n].lo = *(const LAS i32x4*)(lds + PG8_SB(b, h) + boff + n * 2048); dst[n].hi = *(const LAS i32x4*)(lds + PG8_SB(b, h) + boff + n * 2048 + 1024); } } while (0)
#define PG8_MMA(ai, bj, At, Bt) do { __builtin_amdgcn_s_setprio(1); \
        if constexpr (P::FP8) { _Pragma("unroll") for (int m = 0; m < 4; ++m) _Pragma("unroll") for (int n = 0; n < 2; ++n) \
            { FP8_MMA_ONE(acc[ai][bj][m][n], Bt[n], At[m]); } } \
        else { _Pragma("unroll") for (int m = 0; m < 4; ++m) _Pragma("unroll") for (int n = 0; n < 2; ++n) { \
            const i32x4 _bl = __builtin_shufflevector(Bt[n], Bt[n], 0, 1, 2, 3), _bh = __builtin_shufflevector(Bt[n], Bt[n], 4, 5, 6, 7), _al = __builtin_shufflevector(At[m], At[m], 0, 1, 2, 3), _ah = __builtin_shufflevector(At[m], At[m], 4, 5, 6, 7); \
            acc[ai][bj][m][n] = __builtin_amdgcn_mfma_f32_16x16x32_bf16(__builtin_bit_cast(bf16x8, _bl), __builtin_bit_cast(bf16x8, _al), acc[ai][bj][m][n], 0, 0, 0); \
            acc[ai][bj][m][n] = __builtin_amdgcn_mfma_f32_16x16x32_bf16(__builtin_bit_cast(bf16x8, _bh), __builtin_bit_cast(bf16x8, _ah), acc[ai][bj][m][n], 0, 0, 0); } } \
        __builtin_amdgcn_s_setprio(0); } while (0)
typedef int i32x2 __attribute__((ext_vector_type(2)));
#ifdef FP8_LEGACY_MFMA
#define FP8_MMA_ONE(c, b8, a8) do { \
        const i32x2 _b0 = __builtin_shufflevector(b8, b8, 0, 1), _b1 = __builtin_shufflevector(b8, b8, 2, 3), _b2 = __builtin_shufflevector(b8, b8, 4, 5), _b3 = __builtin_shufflevector(b8, b8, 6, 7); \
        const i32x2 _a0 = __builtin_shufflevector(a8, a8, 0, 1), _a1 = __builtin_shufflevector(a8, a8, 2, 3), _a2 = __builtin_shufflevector(a8, a8, 4, 5), _a3 = __builtin_shufflevector(a8, a8, 6, 7); \
        asm volatile("s_nop 1\n\tv_mfma_f32_16x16x32_fp8_fp8 %0, %1, %2, %0\n\ts_nop 7\n\tv_mfma_f32_16x16x32_fp8_fp8 %0, %3, %4, %0\n\ts_nop 7\n\tv_mfma_f32_16x16x32_fp8_fp8 %0, %5, %6, %0\n\ts_nop 7\n\tv_mfma_f32_16x16x32_fp8_fp8 %0, %7, %8, %0" \
                     : "+v"(c) : "v"(_b0), "v"(_a0), "v"(_b1), "v"(_a1), "v"(_b2), "v"(_a2), "v"(_b3), "v"(_a3)); } while (0)
#else
#define FP8_MMA_ONE(c, b8, a8) asm volatile("v_mfma_f32_16x16x128_f8f6f4 %0, %1, %2, %0" : "+v"(c) : "v"(b8), "v"(a8))
#endif
#define PG8_WAIT_V(n) asm volatile("s_waitcnt vmcnt(" #n ")" ::: "memory")
#define PG8_WAIT_L(n) asm volatile("s_waitcnt lgkmcnt(" #n ")" ::: "memory")
#define PG8_BAR __builtin_amdgcn_s_barrier()
#define PG8_SCHED __builtin_amdgcn_sched_barrier(0)
#define PG8_AOFF(AO, u, ord) do { _Pragma("unroll") for (int _h = 0; _h < 2; ++_h) _Pragma("unroll") for (int _i = 0; _i < 2; ++_i) \
        (AO)[_h][_i] = (unsigned)((size_t)S.arow_i((ord), (u), _h * HALF + RA[_i]) * (size_t)K + (size_t)CA[_i]) * 2u; } while (0)
    Unit cur, nxt; int ui = 0;
    if (!S.next(0, cur)) return;
    f32x4 acc[2][2][4][2];
#pragma unroll
    for (int a = 0; a < 2; ++a)
#pragma unroll
        for (int b = 0; b < 2; ++b)
#pragma unroll
            for (int m = 0; m < 4; ++m)
#pragma unroll
                for (int n = 0; n < 2; ++n) acc[a][b][m][n] = (f32x4){0.f, 0.f, 0.f, 0.f};
    i32x8 At[4], B0[2], B1[2];
    unsigned ac[2][2], a2[2][2];
    PG8_AOFF(ac, cur, 0);
    const char* cB0 = S.bptr(cur, 0); const char* cB1 = S.bptr(cur, 1);
    PG8_STAGE_B(PG8_SB(0, 0), cB0); PG8_STAGE_A(PG8_SA(0, 0), ac, 0, 0); PG8_STAGE_B(PG8_SB(0, 1), cB1); PG8_STAGE_A(PG8_SA(0, 1), ac, 1, 0);
    if (wr == 1) PG8_BAR;
    PG8_WAIT_V(4); PG8_BAR;
    PG8_STAGE_B(PG8_SB(1, 0), cB0 + kstepB); PG8_STAGE_A(PG8_SA(1, 0), ac, 0, kstep); PG8_STAGE_B(PG8_SB(1, 1), cB1 + kstepB);
    PG8_WAIT_V(6); PG8_BAR;
    for (;;) {
        const bool has_next = S.next(ui + 1, nxt);
        const char* nB0 = has_next ? S.bptr(nxt, 0) : cB0; const char* nB1 = has_next ? S.bptr(nxt, 1) : cB1;
        typename P::Pre pre{};
        for (int t = 0; t < nt; t += 2) {
            const bool last = (t == nt - 2);
            if (last) pre = S.prefetch(cur, wr, wc, fr, fq);
            if (last && has_next) { PG8_AOFF(a2, nxt, ui + 1); } else {
#pragma unroll
                for (int _h = 0; _h < 2; ++_h)
#pragma unroll
                    for (int _i = 0; _i < 2; ++_i) a2[_h][_i] = last ? ac[_h][_i] : ac[_h][_i] + (unsigned)((t + 2) * (BK * 2)); }
            const size_t k1 = (size_t)(t + 1) * kstep;
            const char* b20 = last ? nB0 : cB0 + (size_t)(t + 2) * kstepB; const char* b21 = last ? nB1 : cB1 + (size_t)(t + 2) * kstepB;
            PG8_LDB(B0, 0, 0); PG8_SCHED; PG8_LDA(At, 0, 0); PG8_STAGE_A(PG8_SA(1, 1), ac, 1, k1);
            PG8_WAIT_L(8); PG8_BAR; PG8_WAIT_L(0); PG8_MMA(0, 0, At, B0); PG8_BAR; PG8_SCHED;
            PG8_LDB(B1, 0, 1); PG8_STAGE_B(PG8_SB(0, 0), b20);
            PG8_BAR; PG8_WAIT_L(0); PG8_MMA(0, 1, At, B1); PG8_BAR;
            PG8_LDA(At, 0, 1); PG8_STAGE_A(PG8_SA(0, 0), a2, 0, 0);
            PG8_BAR; PG8_WAIT_L(0); PG8_MMA(1, 0, At, B0); PG8_BAR; PG8_SCHED;
            PG8_STAGE_B(PG8_SB(0, 1), b21);
            PG8_WAIT_V(6); PG8_BAR; PG8_MMA(1, 1, At, B1); PG8_BAR;
            PG8_LDB(B0, 1, 0); PG8_SCHED; PG8_LDA(At, 1, 0); PG8_STAGE_A(PG8_SA(0, 1), a2, 1, 0);
            PG8_WAIT_L(8); PG8_BAR; PG8_WAIT_L(0); PG8_MMA(0, 0, At, B0); PG8_BAR; PG8_SCHED;
            PG8_LDB(B1, 1, 1); PG8_STAGE_B(PG8_SB(1, 0), b20 + kstepB);
            PG8_BAR; PG8_WAIT_L(0); PG8_MMA(0, 1, At, B1); PG8_BAR;
            PG8_LDA(At, 1, 1); PG8_STAGE_A(PG8_SA(1, 0), a2, 0, kstep);
            PG8_BAR; PG8_WAIT_L(0); PG8_MMA(1, 0, At, B0); PG8_BAR; PG8_SCHED;
            PG8_STAGE_B(PG8_SB(1, 1), b21 + kstepB);
            PG8_WAIT_V(6); PG8_BAR; PG8_MMA(1, 1, At, B1); PG8_BAR;
        }
        if constexpr (P::FP8) asm volatile("s_nop 15\n\ts_nop 15" ::: "memory");
        S.epi(acc, cur, wr, wc, fr, fq, pre);
        if (!has_next) break;
#pragma unroll
        for (int a = 0; a < 2; ++a)
#pragma unroll
            for (int b = 0; b < 2; ++b)
#pragma unroll
                for (int m = 0; m < 4; ++m)
#pragma unroll
                    for (int n = 0; n < 2; ++n) acc[a][b][m][n] = (f32x4){0.f, 0.f, 0.f, 0.f};
        cur = nxt; cB0 = nB0; cB1 = nB1; ++ui;
#pragma unroll
        for (int _h = 0; _h < 2; ++_h)
#pragma unroll
            for (int _i = 0; _i < 2; ++_i) ac[_h][_i] = a2[_h][_i];
    }
    PG8_WAIT_V(0);
    if (wr == 0) PG8_BAR;
    PG8_BAR;
#undef PG8_SA
#undef PG8_SB
#undef PG8_STAGE_A
#undef PG8_STAGE_B
#undef PG8_LDA
#undef PG8_LDB
#undef PG8_MMA
#undef PG8_WAIT_V
#undef PG8_WAIT_L
#undef PG8_BAR
#undef PG8_SCHED
#undef PG8_AOFF
}
}
using pg8::Unit;

struct Frame {
    LAS unsigned char* lds;
    volatile LAS unsigned* MISC;
    unsigned* ctl;
    unsigned char* ws;
    int tid, lane, wave, G, bid;
    const float* const* in;
    float* out;
};
#define WSP(T, off) ((T*)(F.ws + (off)))

__device__ __forceinline__ void transpose_load(const float* __restrict__ W, int N, int item, int lane, f32x4 (&v)[16]) {
    const int nblk = (N + 63) / 64, kb = item / nblk, nb = item % nblk, k0 = 64 * kb, n0 = 64 * nb;
    const int lk = lane >> 4, ln = (lane & 15) * 4; const bool ok = n0 + ln < N;
#pragma unroll
    for (int i = 0; i < 16; ++i) v[i] = ok ? *(const f32x4*)(W + (size_t)(k0 + 4 * i + lk) * N + n0 + ln) : (f32x4){0.f, 0.f, 0.f, 0.f};
}
__device__ __forceinline__ void transpose_finish(int K, int N, bf16_t* __restrict__ WT, int row_off, LAS float* scr, int item, int lane, const f32x4 (&v)[16]) {
    const int nblk = (N + 63) / 64, kb = item / nblk, nb = item % nblk, k0 = 64 * kb, n0 = 64 * nb;
    const int lk = lane >> 4, ln = (lane & 15) * 4;
#pragma unroll
    for (int i = 0; i < 16; ++i) { LAS float* d = scr + (4 * i + lk) * 65 + ln; d[0] = v[i].x; d[1] = v[i].y; d[2] = v[i].z; d[3] = v[i].w; }
    LDS_WAIT(); asm volatile("" ::: "memory");
    const int c = lane & 7;
#pragma unroll
    for (int j = 0; j < 8; ++j) { const int n = (lane >> 3) + 8 * j; const LAS float* s = scr + (8 * c) * 65 + n;
        if (n0 + n < N) { u32x4 o; o.x = cvt_pk_bf16(s[0 * 65], s[1 * 65]); o.y = cvt_pk_bf16(s[2 * 65], s[3 * 65]); o.z = cvt_pk_bf16(s[4 * 65], s[5 * 65]); o.w = cvt_pk_bf16(s[6 * 65], s[7 * 65]);
            *(u32x4*)(WT + (size_t)(row_off + n0 + n) * K + k0 + 8 * c) = o; } }
    LDS_WAIT(); asm volatile("" ::: "memory");
}
constexpr int TI_PER_MAT = (D / 64) * (D / 64);
constexpr int TI_WIN = (D / 64) * ((NIN + 63) / 64);
constexpr int TI_SMALL = TI_WIN + TI_PER_MAT;
constexpr int TI_EXP = 3 * NE * TI_PER_MAT;
#ifndef NCONV_SCAN
#define NCONV_SCAN 168
#endif
#ifndef NCONV_WG
#define NCONV_WG 20
#endif
#ifndef TI_EARLY_PCT
#define TI_EARLY_PCT 12
#endif
__host__ __device__ constexpr int ti_early(int G) { return (G > 2 * NCONV_WG) ? (TI_EXP / 100) * TI_EARLY_PCT : 0; }
__device__ __forceinline__ void transpose_small_load(Frame& F, int it, f32x4 (&v)[16]) {
    if (it < TI_WIN) transpose_load(F.in[I_WIN], NIN, it, F.lane, v); else transpose_load(F.in[I_WOUT], D, it - TI_WIN, F.lane, v);
}
__device__ __forceinline__ void transpose_small_finish(Frame& F, int it, LAS float* scr, const f32x4 (&v)[16]) {
    if (it < TI_WIN) transpose_finish(D, NIN, WSP(bf16_t, WS_WIN), 0, scr, it, F.lane, v); else transpose_finish(D, D, WSP(bf16_t, WS_WOUT), 0, scr, it - TI_WIN, F.lane, v);
}
__device__ __forceinline__ void convert_load(Frame& F, int it, f32x4 (&v)[16]) {
    const int mat = it / TI_PER_MAT, r = it % TI_PER_MAT, type = mat / NE, e = mat % NE, kb = r >> 3, n4 = (r & 7) * 256 + F.lane * 4;
    const float* src = F.in[type == 0 ? I_WGATE : (type == 1 ? I_WUP : I_WDOWN)] + (size_t)e * D * D + (size_t)(kb * 16) * D + n4;
#pragma unroll
    for (int i = 0; i < 16; ++i) v[i] = __builtin_nontemporal_load((const f32x4*)(src + (size_t)i * D));
}
__device__ __forceinline__ void convert_store(Frame& F, int it, const f32x4 (&v)[16]) {
    const int mat = it / TI_PER_MAT, r = it % TI_PER_MAT, type = mat / NE, e = mat % NE, kb = r >> 3, n4 = (r & 7) * 256 + F.lane * 4;
    unsigned char* dst = F.ws + (type == 0 ? WS_WG : (type == 1 ? WS_WU : WS_WD)) + (size_t)e * D * D + ((size_t)kb * D + n4) * 16;
#pragma unroll
    for (int nn = 0; nn < 4; ++nn)
        *(u32x4*)(dst + nn * 16) = (u32x4){pk_fp8x4(v[0][nn] * W8_SCALE, v[1][nn] * W8_SCALE, v[2][nn] * W8_SCALE, v[3][nn] * W8_SCALE), pk_fp8x4(v[4][nn] * W8_SCALE, v[5][nn] * W8_SCALE, v[6][nn] * W8_SCALE, v[7][nn] * W8_SCALE),
                                          pk_fp8x4(v[8][nn] * W8_SCALE, v[9][nn] * W8_SCALE, v[10][nn] * W8_SCALE, v[11][nn] * W8_SCALE), pk_fp8x4(v[12][nn] * W8_SCALE, v[13][nn] * W8_SCALE, v[14][nn] * W8_SCALE, v[15][nn] * W8_SCALE)};
}
__device__ __forceinline__ void convert_experts(Frame& F, int gw, int NGW, int it0, int it1) {
    f32x4 A[16], B[16];
    for (int it = it0 + gw; it < it1; it += 2 * NGW) {
        const int i2 = it + NGW; const bool h2 = i2 < it1;
        convert_load(F, it, A); convert_load(F, h2 ? i2 : it, B); __builtin_amdgcn_sched_barrier(0);
        convert_store(F, it, A);
        if (h2) convert_store(F, i2, B);
    }
}
__device__ __forceinline__ void p0_prologue(Frame& F) {
    LAS float* red = (LAS float*)F.lds;
    const float* c = F.in[I_C]; const float* cctx = F.in[I_CCTX]; const float* wada = F.in[I_WADA];
    float* modp = WSP(float, WS_MODP);
    const int gw = F.bid * 8 + F.wave, NGW = F.G * 8;
    f32x4 tc[16], tn[16];
    if (gw < TI_SMALL) transpose_small_load(F, gw, tc);
    for (int it = F.bid; it < NPART * 32; it += F.G) {
        const int kq = it / 32, cg = it % 32, kb = kq * 256 + F.wave * 32, col = cg * 384 + F.lane * 4, col2 = cg * 384 + 256 + (F.lane & 31) * 4; const bool ex = F.lane < 32;
        f32x4 a0 = {0.f, 0.f, 0.f, 0.f}, a1 = a0, a2 = a0, b0 = a0, b1 = a0, b2 = a0;
#pragma unroll 8
        for (int i = 0; i < 32; ++i) { const int k = kb + i; const f32x4 wv = *(const f32x4*)(wada + (size_t)k * (6 * D) + col); f32x4 wx = {0.f, 0.f, 0.f, 0.f}; if (ex) wx = *(const f32x4*)(wada + (size_t)k * (6 * D) + col2);
            const float s0 = silu_f(c[k]), s1 = silu_f(c[D + k]), s2 = silu_f(cctx[k]); a0 += wv * s0; a1 += wv * s1; a2 += wv * s2; b0 += wx * s0; b1 += wx * s1; b2 += wx * s2; }
        *(LAS f32x4*)(red + (F.wave * 3 + 0) * 384 + F.lane * 4) = a0; *(LAS f32x4*)(red + (F.wave * 3 + 1) * 384 + F.lane * 4) = a1; *(LAS f32x4*)(red + (F.wave * 3 + 2) * 384 + F.lane * 4) = a2;
        if (ex) { *(LAS f32x4*)(red + (F.wave * 3 + 0) * 384 + 256 + F.lane * 4) = b0; *(LAS f32x4*)(red + (F.wave * 3 + 1) * 384 + 256 + F.lane * 4) = b1; *(LAS f32x4*)(red + (F.wave * 3 + 2) * 384 + 256 + F.lane * 4) = b2; }
        __syncthreads();
        for (int idx = F.tid; idx < 3 * 384; idx += 512) { const int v = idx / 384, cc = idx % 384; float s = 0.f;
#pragma unroll
            for (int w = 0; w < 8; ++w) s += red[(w * 3 + v) * 384 + cc];
            modp[(size_t)(kq * 3 + v) * (6 * D) + cg * 384 + cc] = s; }
        __syncthreads();
    }
    LAS float* scr = (LAS float*)(F.lds + F.wave * (64 * 65 * 4));
    for (int it = gw; it < TI_SMALL; it += NGW) {
        if (it + NGW < TI_SMALL) transpose_small_load(F, it + NGW, tn);
        transpose_small_finish(F, it, scr, tc);
#pragma unroll
        for (int i = 0; i < 16; ++i) tc[i] = tn[i];
    }
}

__device__ __forceinline__ const float* row_src(Frame& F, int row) { return row < ML ? F.in[I_X] + (size_t)row * D : F.in[I_CTX] + (size_t)(row - ML) * D; }
__device__ __forceinline__ int row_vec(int row) { return row < SEQ ? 0 : (row < ML ? 1 : 2); }
__device__ __forceinline__ void p1_ln0(Frame& F) {
    const int rpw = (MTOT + F.G - 1) / F.G, r0 = F.bid * rpw, r1 = (r0 + rpw < MTOT) ? r0 + rpw : MTOT;
    const float* modp = WSP(const float, WS_MODP); const float* bada = F.in[I_BADA];
    LAS float* SC = (LAS float*)F.lds;
    LAS float* SH = SC + 3 * D;
    if (r0 < r1) {
        const int vlo = row_vec(r0), vhi = row_vec(r1 - 1);
        for (int v = vlo; v <= vhi; ++v)
            for (int d = F.tid; d < D; d += 512) { float sh = bada[d], sc = bada[D + d];
#pragma unroll
                for (int p = 0; p < NPART; ++p) { sh += modp[(size_t)(p * 3 + v) * (6 * D) + d]; sc += modp[(size_t)(p * 3 + v) * (6 * D) + D + d]; }
                const float g0 = F.in[I_LN0G][d], b0 = F.in[I_LN0B][d];
                SC[v * D + d] = g0 * (1.f + sc); SH[v * D + d] = b0 * (1.f + sc) + sh; }
    }
    __syncthreads();
    bf16_t* HM = WSP(bf16_t, WS_HM); f32x2* st = WSP(f32x2, WS_STAT0);
    f32x4 xn[8];
    if (r0 + F.wave < r1) { const f32x4* xr = (const f32x4*)row_src(F, r0 + F.wave) + F.lane;
#pragma unroll
        for (int j = 0; j < 8; ++j) xn[j] = xr[64 * j]; }
    for (int row = r0 + F.wave; row < r1; row += 8) {
        const int v = row_vec(row);
        f32x4 x[8]; float s = 0.f;
#pragma unroll
        for (int j = 0; j < 8; ++j) { x[j] = xn[j]; s += (x[j].x + x[j].y) + (x[j].z + x[j].w); }
        if (row + 8 < r1) { const f32x4* xr = (const f32x4*)row_src(F, row + 8) + F.lane;
#pragma unroll
            for (int j = 0; j < 8; ++j) xn[j] = xr[64 * j]; }
        const float mean = wave_sum(s) * (1.f / D); float s2 = 0.f;
#pragma unroll
        for (int j = 0; j < 8; ++j) { x[j] = x[j] - mean; s2 += (x[j].x * x[j].x + x[j].y * x[j].y) + (x[j].z * x[j].z + x[j].w * x[j].w); }
        const float rstd = 1.f / sqrtf(wave_sum(s2) * (1.f / D) + LN_EPS);
        if (F.lane == 0) st[row] = (f32x2){mean, rstd};
        u32x2* o = (u32x2*)(HM + (size_t)row * D) + F.lane;
#pragma unroll
        for (int j = 0; j < 8; ++j) { const int d = 4 * F.lane + 256 * j; const f32x4 a = *(const LAS f32x4*)(SC + v * D + d), b = *(const LAS f32x4*)(SH + v * D + d);
            const f32x4 y = x[j] * rstd * a + b; u32x2 w; w.x = cvt_pk_bf16(y.x, y.y); w.y = cvt_pk_bf16(y.z, y.w); o[64 * j] = w; }
    }
    float* modf = WSP(float, WS_MODF);
    for (int idx = F.bid * 512 + F.tid; idx < 3 * 6 * D; idx += F.G * 512) { const int v = idx / (6 * D), n = idx % (6 * D); float s = bada[n];
#pragma unroll
        for (int p = 0; p < NPART; ++p) s += modp[(size_t)(p * 3 + v) * (6 * D) + n];
        modf[idx] = s; }
}

struct NoPre {};
struct InProj {
    static constexpr bool PERM = true, GATHER = false, FP8 = false, BBLK = false; typedef NoPre Pre;
    __device__ __forceinline__ Pre prefetch(const Unit&, int, int, int, int) const { return Pre{}; }
    int K; const char* A; const char* Bt; bf16_t* P; int G, c;
    __device__ __forceinline__ bool next(int i, Unit& u) const {
        const int L = i * G + c; constexpr int NMAIN = (ML / 256) * (NINP / 256), NCTXT = (GIN + 255) / 256;
        if (L < NMAIN) { pg8::tile_order(L, ML / 256, NINP / 256, u.pm, u.pn); u.e = 0; return true; }
        const int j = L - NMAIN; if (j >= (MC / 256) * NCTXT) return false;
        u.pm = ML / 256 + j / NCTXT; u.pn = j % NCTXT; u.e = 0; return true;
    }
    __device__ __forceinline__ const char* bptr(const Unit& u, int half) const { return Bt + (size_t)(u.pn * 256 + half * 128) * K * 2; }
    __device__ __forceinline__ unsigned arow_i(int, const Unit& u, int r) const { return (unsigned)(u.pm * 256 + r); }
    __device__ __forceinline__ void epi(const f32x4 (&acc)[2][2][4][2], const Unit& u, int wr, int wc, int fr, int fq, const Pre&) const {
        const int row0 = u.pm * 256 + wr * 64 + fr, col0 = u.pn * 256 + wc * 32 + 8 * fq;
#pragma unroll
        for (int ai = 0; ai < 2; ++ai)
#pragma unroll
            for (int m = 0; m < 4; ++m) { bf16_t* rowp = P + (size_t)(row0 + ai * 128 + m * 16) * NINP + col0;
#pragma unroll
                for (int bj = 0; bj < 2; ++bj) { const f32x4 v0 = acc[ai][bj][m][0], v1 = acc[ai][bj][m][1];
                    u32x4 w; w.x = cvt_pk_bf16(v0[0], v0[1]); w.y = cvt_pk_bf16(v0[2], v0[3]); w.z = cvt_pk_bf16(v1[0], v1[1]); w.w = cvt_pk_bf16(v1[2], v1[3]);
                    *(u32x4*)(rowp + bj * 128) = w; } }
    }
};

typedef float f32x16 __attribute__((ext_vector_type(16)));
typedef __bf16 bf2_t __attribute__((ext_vector_type(2)));
__device__ __forceinline__ unsigned pk(float a, float b) { f32x2 v = {a, b}; return __builtin_bit_cast(unsigned, __builtin_convertvector(v, bf2_t)); }
__device__ __forceinline__ bf16_t f2bf(float a) { return (bf16_t)(pk(a, 0.f) & 0xffffu); }
#define MFMA16(a, b, c) __builtin_amdgcn_mfma_f32_16x16x32_bf16((a), (b), (c), 0, 0, 0)
#define MFMA32(a, b, c) __builtin_amdgcn_mfma_f32_32x32x16_bf16((a), (b), (c), 0, 0, 0)
__device__ __forceinline__ void unit_rows(int b, int cidx, int& rowbase, int& segbase, int& len) {
    if (cidx < CTXL / 64) { segbase = ML + b * CTXL; len = CTXL; rowbase = segbase + cidx * 64; }
    else { segbase = b * SEQ; len = SEQ; rowbase = segbase + (cidx - CTXL / 64) * 64; }
}
constexpr int TOKB = 9;
__device__ __forceinline__ int tok_seg(int r) { return r < ML ? r / SEQ : NBATCH + (r - ML) / CTXL; }
template <bool MASKED>
__device__ __forceinline__ void tok_block(const bf16_t* P, bf16_t* QKVb, const float* cw, int b0, int nrow, int lane) {
#pragma unroll 1
    for (int jj = 0; jj < 6; ++jj) {
        const int col = jj * 512 + lane * 8;
        u32x4 R[TOKB + 4];
#pragma unroll
        for (int t = 0; t < TOKB + 4; ++t) { const int r = b0 - 2 + t; const bool ok = !MASKED || (r >= 0 && r < MTOT);
            R[t] = (u32x4){0u, 0u, 0u, 0u}; if (ok) R[t] = *(const u32x4*)(P + (size_t)r * NINP + col); }
        f32x4 cwr[5][2];
#pragma unroll
        for (int i = 0; i < 5; ++i) { cwr[i][0] = *(const f32x4*)(cw + i * GQKV + col); cwr[i][1] = *(const f32x4*)(cw + i * GQKV + col + 4); }
#pragma unroll
        for (int rr = 0; rr < TOKB; ++rr) {
            if (rr < nrow) { const int row = b0 + rr;
                float a[8];
#pragma unroll
                for (int q = 0; q < 8; ++q) a[q] = 0.f;
#pragma unroll
                for (int i = 0; i < 5; ++i) { const f32x4 w0 = cwr[i][0], w1 = cwr[i][1]; u32x4 p = R[rr + i];
                    if (MASKED) { const int tr = row + i - 2; const bool v = tr >= 0 && tr < MTOT && tok_seg(tr < 0 ? 0 : (tr < MTOT ? tr : MTOT - 1)) == tok_seg(row); if (!v) p = (u32x4){0u, 0u, 0u, 0u}; }
                    a[0] += bf_lo(p.x) * w0.x; a[1] += bf_hi(p.x) * w0.y; a[2] += bf_lo(p.y) * w0.z; a[3] += bf_hi(p.y) * w0.w;
                    a[4] += bf_lo(p.z) * w1.x; a[5] += bf_hi(p.z) * w1.y; a[6] += bf_lo(p.w) * w1.z; a[7] += bf_hi(p.w) * w1.w; }
                float ss = 0.f;
#pragma unroll
                for (int q = 0; q < 8; ++q) { a[q] = silu_f(a[q]); ss += a[q] * a[q]; }
                if (jj < 4) { ss += __shfl_xor(ss, 1); ss += __shfl_xor(ss, 2); ss += __shfl_xor(ss, 4); ss += __shfl_xor(ss, 8);
                    float sc = __builtin_amdgcn_rsqf(ss + 1e-6f); if (jj < 2) sc *= 0.08838834764831845f;
#pragma unroll
                    for (int q = 0; q < 8; ++q) a[q] *= sc; }
                *(u32x4*)(QKVb + (size_t)row * GQKV + col) = (u32x4){pk(a[0], a[1]), pk(a[2], a[3]), pk(a[4], a[5]), pk(a[6], a[7])}; }
        }
    }
}
__device__ __forceinline__ void p3a_tokens(Frame& F) {
    const bf16_t* P = WSP(const bf16_t, WS_P); bf16_t* QKVb = WSP(bf16_t, WS_QKVB); float* GBf = WSP(float, WS_GBF);
    const float* cw = F.in[I_CONVQKV];
    int tz_ = threadIdx.x; asm volatile("" : "+v"(tz_));
    const int lane_ = tz_ & 63, wave_ = __builtin_amdgcn_readfirstlane(tz_ >> 6);
    for (int blk = F.bid * 8 + wave_; blk * TOKB < MTOT; blk += F.G * 8) {
        const int b0 = blk * TOKB, nrow = (b0 + TOKB <= MTOT) ? TOKB : MTOT - b0;
        const bool clean = b0 >= 2 && b0 + TOKB + 1 < MTOT && tok_seg(b0 - 2) == tok_seg(b0 + TOKB + 1);
        if (clean) tok_block<false>(P, QKVb, cw, b0, nrow, lane_); else tok_block<true>(P, QKVb, cw, b0, nrow, lane_);
        if (lane_ < 32) { const int i = lane_ & 15; float gv[TOKB];
#pragma unroll
            for (int rr = 0; rr < TOKB; ++rr) gv[rr] = (rr < nrow) ? bf2f(P[(size_t)(b0 + rr) * NINP + (lane_ < 16 ? COL_A : COL_B) + i]) : 0.f;
            const float al = -__expf(F.in[I_ALOG][i]), dt = F.in[I_DTB][i];
#pragma unroll
            for (int rr = 0; rr < TOKB; ++rr) if (rr < nrow) { const float v = gv[rr]; GBf[(size_t)(b0 + rr) * 32 + lane_] = (lane_ < 16) ? al * softplus_f(v + dt) : sigmoid_f(v); } }
    }
}
constexpr int PL_QS = 0, PL_KS = 17408, PL_KBG = 34816, PL_VB = 53248, PL_AM = 71680, PL_QKM = 89088, PL_TB = 106496, PL_EGC = 115712, PL_EKD = 115968, PL_TF = 116224, PL_GC = 133632, PL_BETA = 133888;
constexpr int QP = 136, TP = 72, FP = 68;
#define MFMA4F(a, b, c) __builtin_amdgcn_mfma_f32_16x16x4f32((a), (b), (c), 0, 0, 0)
__device__ __forceinline__ void p3_prep(Frame& F) {
    const bf16_t* QKVb = WSP(const bf16_t, WS_QKVB); const float* GBf = WSP(const float, WS_GBF);
    LAS bf16_t* Qs = (LAS bf16_t*)(F.lds + PL_QS); LAS bf16_t* Ks = (LAS bf16_t*)(F.lds + PL_KS); LAS bf16_t* KbgT = (LAS bf16_t*)(F.lds + PL_KBG); LAS bf16_t* VbT = (LAS bf16_t*)(F.lds + PL_VB);
    LAS float* Am = (LAS float*)(F.lds + PL_AM); LAS float* QKm = (LAS float*)(F.lds + PL_QKM); LAS bf16_t* Tb = (LAS bf16_t*)(F.lds + PL_TB); LAS float* Tf = (LAS float*)(F.lds + PL_TF);
    LAS float* egc_s = (LAS float*)(F.lds + PL_EGC); LAS float* ekd_s = (LAS float*)(F.lds + PL_EKD); LAS float* gc_s = (LAS float*)(F.lds + PL_GC); LAS float* beta_s = (LAS float*)(F.lds + PL_BETA);
    LAS bf16_t* Ws = Qs; LAS bf16_t* Us = Ks;
    int tz = threadIdx.x; asm volatile("" : "+v"(tz));
    const int tid = tz, lane = tz & 63, w = __builtin_amdgcn_readfirstlane(tz >> 6), l15 = lane & 15, l4 = lane >> 4, r31 = lane & 31, hh = lane >> 5;
    u32x4 pre[3][2]; float pg = 0.f, pb = 0.f;
#define PREP_LOAD(uid_) do { const int _dir = (uid_) & 1, _h = ((uid_) >> 1) & 7, _cb = (uid_) >> 4, _cidx = _cb % NCHUNK, _b = _cb / NCHUNK; int _rb, _sb, _ln; unit_rows(_b, _cidx, _rb, _sb, _ln); \
        _Pragma("unroll") for (int _p = 0; _p < 3; ++_p) _Pragma("unroll") for (int _hf = 0; _hf < 2; ++_hf) { const int _r = 2 * (tid >> 4) + _hf; \
            pre[_p][_hf] = *(const u32x4*)(QKVb + (size_t)(_rb + (_dir ? 63 - _r : _r)) * GQKV + _p * GQK + _h * 128 + (tid & 15) * 8); } \
        { const size_t _pr = (size_t)(_rb + (_dir ? 63 - lane : lane)); pg = GBf[_pr * 32 + _dir * 8 + _h]; pb = GBf[_pr * 32 + 16 + _dir * 8 + _h]; } } while (0)
    if (F.bid < NUNITS) PREP_LOAD(F.bid);
    for (int uid = F.bid; uid < NUNITS; uid += F.G) {
        unsigned char* ub = F.ws + WS_PREP + (size_t)uid * UNIT_BYTES;
        float gc = pg; const float beta = pb;
#pragma unroll
        for (int off = 1; off < 64; off <<= 1) { const float t = __shfl_up(gc, off); if (lane >= off) gc += t; }
        const float glast = __shfl(gc, 63), egcv = __expf(gc);
        if (w == 0) { egc_s[lane] = egcv; ekd_s[lane] = __expf(glast - gc); gc_s[lane] = gc; beta_s[lane] = beta; }
        { const int r0 = 2 * (tid >> 4), c16 = tid & 15;
          const float br0 = __shfl(beta, r0), br1 = __shfl(beta, r0 + 1), sk0 = br0 * __shfl(egcv, r0), sk1 = br1 * __shfl(egcv, r0 + 1);
          const int rs = (((r0 >> 3) ^ (c16 >> 1)) << 3) + (r0 & 7);
          *(LAS u32x4*)(Qs + r0 * QP + c16 * 8) = pre[0][0]; *(LAS u32x4*)(Qs + (r0 + 1) * QP + c16 * 8) = pre[0][1];
          *(LAS u32x4*)(Ks + r0 * QP + c16 * 8) = pre[1][0]; *(LAS u32x4*)(Ks + (r0 + 1) * QP + c16 * 8) = pre[1][1];
#pragma unroll
          for (int e = 0; e < 4; ++e) { const unsigned k0 = pre[1][0][e], k1 = pre[1][1][e], v0 = pre[2][0][e], v1 = pre[2][1][e];
              *(LAS unsigned*)(KbgT + (c16 * 8 + 2 * e) * TP + rs) = pk(bf_lo(k0) * sk0, bf_lo(k1) * sk1); *(LAS unsigned*)(KbgT + (c16 * 8 + 2 * e + 1) * TP + rs) = pk(bf_hi(k0) * sk0, bf_hi(k1) * sk1);
              *(LAS unsigned*)(VbT + (c16 * 8 + 2 * e) * TP + rs) = pk(bf_lo(v0) * br0, bf_lo(v1) * br1); *(LAS unsigned*)(VbT + (c16 * 8 + 2 * e + 1) * TP + rs) = pk(bf_hi(v0) * br0, bf_hi(v1) * br1); } }
        if (uid + F.G < NUNITS) PREP_LOAD(uid + F.G);
        __syncthreads();
        { const bool isq = w >= 4; const int rt = w & 3; const LAS bf16_t* X = isq ? Qs : Ks; LAS float* OUT = isq ? QKm : Am;
          bf16x8 af[4], bfr[4][4];
#pragma unroll
          for (int ks = 0; ks < 4; ++ks) af[ks] = *(const LAS bf16x8*)(X + (rt * 16 + l15) * QP + 32 * ks + 8 * l4);
#pragma unroll
          for (int st = 0; st < 4; ++st)
#pragma unroll
              for (int ks = 0; ks < 4; ++ks) bfr[st][ks] = *(const LAS bf16x8*)(Ks + (st * 16 + l15) * QP + 32 * ks + 8 * l4);
          const f32x4 gcr4 = *(const LAS f32x4*)(gc_s + rt * 16 + 4 * l4), br4 = *(const LAS f32x4*)(beta_s + rt * 16 + 4 * l4);
          float gcs4[4];
#pragma unroll
          for (int st = 0; st < 4; ++st) gcs4[st] = gc_s[st * 16 + l15];
#pragma unroll
          for (int st = 0; st < 4; ++st) { f32x4 acc = {0.f, 0.f, 0.f, 0.f};
#pragma unroll
              for (int ks = 0; ks < 4; ++ks) acc = MFMA16(af[ks], bfr[st][ks], acc);
              const int sidx = st * 16 + l15; const float gcs = gcs4[st];
#pragma unroll
              for (int reg = 0; reg < 4; ++reg) { const int ridx = rt * 16 + 4 * l4 + reg; const float gcr = gcr4[reg], br = br4[reg];
                  const float e = __expf(fminf(gcr - gcs, 0.f));
                  const float val = isq ? (ridx >= sidx ? acc[reg] * e : 0.f) : (ridx > sidx ? br * acc[reg] * e : 0.f);
                  OUT[ridx * FP + sidx] = val; } } }
#pragma unroll
        for (int q2 = 0; q2 < 2; ++q2) { const int frag = w + 8 * q2;
            { const int mt = frag >> 3, kt = (frag >> 1) & 3, s2 = frag & 1, row = 32 * mt + r31, col0 = 32 * kt + 16 * s2 + 4 * hh; const float e = egc_s[row];
              const u32x2 lo = *(const LAS u32x2*)(Qs + row * QP + col0), hi = *(const LAS u32x2*)(Qs + row * QP + col0 + 8);
              *(u32x4*)(ub + UO_QD + frag * 1024 + lane * 16) = (u32x4){pk(bf_lo(lo.x) * e, bf_hi(lo.x) * e), pk(bf_lo(lo.y) * e, bf_hi(lo.y) * e), pk(bf_lo(hi.x) * e, bf_hi(hi.x) * e), pk(bf_lo(hi.y) * e, bf_hi(hi.y) * e)}; }
            { const int kt = frag >> 2, ct = (frag >> 1) & 1, s2 = frag & 1; float v[8];
#pragma unroll
              for (int j = 0; j < 8; ++j) { const int tok = 32 * ct + 16 * s2 + 8 * (j >> 2) + 4 * hh + (j & 3); v[j] = bf2f(Ks[tok * QP + 32 * kt + r31]); }
              { const int t0 = 32 * ct + 16 * s2 + 4 * hh; const f32x4 e0 = *(const LAS f32x4*)(ekd_s + t0), e1 = *(const LAS f32x4*)(ekd_s + t0 + 8);
                v[0] *= e0.x; v[1] *= e0.y; v[2] *= e0.z; v[3] *= e0.w; v[4] *= e1.x; v[5] *= e1.y; v[6] *= e1.z; v[7] *= e1.w; }
              *(u32x4*)(ub + UO_KDT + frag * 1024 + lane * 16) = (u32x4){pk(v[0], v[1]), pk(v[2], v[3]), pk(v[4], v[5]), pk(v[6], v[7])}; } }
        __syncthreads();
        if (w < 4) { float t[16];
            f32x4 ar[4];
#pragma unroll
            for (int c4 = 0; c4 < 4; ++c4) ar[c4] = *(const LAS f32x4*)(Am + (16 * w + l15) * FP + 16 * w + 4 * c4);
#pragma unroll
            for (int i = 0; i < 16; ++i) { float a0 = (i == lane) ? 1.f : 0.f;
#pragma unroll
                for (int m = 0; m < i; ++m) { const float av = ar[m >> 2][m & 3];
                    a0 -= __builtin_bit_cast(float, __builtin_amdgcn_readlane(__builtin_bit_cast(int, av), i)) * t[m]; }
                t[i] = a0; }
            if (lane < 16) {
#pragma unroll
                for (int i = 0; i < 16; ++i) Tf[(16 * w + i) * FP + 16 * w + lane] = t[i]; } }
        __syncthreads();
#pragma unroll
        for (int lv = 1; lv < 4; ++lv) {
            if (w < 4 - lv) { const int bj = w, bi = w + lv;
                f32x4 aop[3]; float bop[3][4];
#pragma unroll
                for (int t = 0; t < lv; ++t) { const int bk = bj + t; aop[t] = *(const LAS f32x4*)(Am + (16 * bi + l15) * FP + 16 * bk + 4 * l4);
#pragma unroll
                    for (int ks = 0; ks < 4; ++ks) bop[t][ks] = Tf[(16 * bk + 4 * l4 + ks) * FP + 16 * bj + l15]; }
                const f32x4 tdg = *(const LAS f32x4*)(Tf + (16 * bi + l15) * FP + 16 * bi + 4 * l4);
                f32x4 x = {0.f, 0.f, 0.f, 0.f};
#pragma unroll
                for (int t = 0; t < lv; ++t)
#pragma unroll
                    for (int ks = 0; ks < 4; ++ks) x = MFMA4F(aop[t][ks], bop[t][ks], x);
                f32x4 y = {0.f, 0.f, 0.f, 0.f};
#pragma unroll
                for (int ks = 0; ks < 4; ++ks) y = MFMA4F(tdg[ks], x[ks], y);
#pragma unroll
                for (int reg = 0; reg < 4; ++reg) Tf[(16 * bi + 4 * l4 + reg) * FP + 16 * bj + l15] = -y[reg]; }
            __syncthreads();
        }
#pragma unroll
        for (int q = 0; q < 4; ++q) { const int idx = tid + 512 * q, i = idx >> 5, j = (idx & 31) * 2; const f32x2 tv = *(const LAS f32x2*)(Tf + i * FP + j);
            *(LAS unsigned*)(Tb + i * TP + j) = pk(j <= i ? tv.x : 0.f, j + 1 <= i ? tv.y : 0.f); }
        __syncthreads();
        { bf16x8 bu[2], bw[2];
#pragma unroll
          for (int ks = 0; ks < 2; ++ks) { const int ch = 8 * ((4 * ks + l4) ^ w);
              bu[ks] = *(const LAS bf16x8*)(VbT + (w * 16 + l15) * TP + ch); bw[ks] = *(const LAS bf16x8*)(KbgT + (w * 16 + l15) * TP + ch); }
#pragma unroll
          for (int rt = 0; rt < 4; ++rt) { const bf16x8 a0 = *(const LAS bf16x8*)(Tb + (rt * 16 + l15) * TP + 8 * l4), a1 = *(const LAS bf16x8*)(Tb + (rt * 16 + l15) * TP + 32 + 8 * l4);
              f32x4 au = {0.f, 0.f, 0.f, 0.f}, aw = {0.f, 0.f, 0.f, 0.f};
              au = MFMA16(bu[0], a0, au); au = MFMA16(bu[1], a1, au); aw = MFMA16(bw[0], a0, aw); aw = MFMA16(bw[1], a1, aw);
              { const int r = rt * 16 + l15, f0 = w * 16 + 4 * l4;
                *(LAS u32x2*)(Us + r * QP + f0) = (u32x2){pk(au[0], au[1]), pk(au[2], au[3])}; *(LAS u32x2*)(Ws + r * QP + f0) = (u32x2){pk(-aw[0], -aw[1]), pk(-aw[2], -aw[3])}; } } }
        __syncthreads();
#pragma unroll
        for (int q2 = 0; q2 < 2; ++q2) { const int frag = w + 8 * q2, mt = frag >> 3, kt = (frag >> 1) & 3, s2 = frag & 1, row = 32 * mt + r31, col0 = 32 * kt + 16 * s2 + 4 * hh;
            const u32x2 lo = *(const LAS u32x2*)(Ws + row * QP + col0), hi = *(const LAS u32x2*)(Ws + row * QP + col0 + 8);
            *(u32x4*)(ub + UO_NW + frag * 1024 + lane * 16) = (u32x4){lo.x, lo.y, hi.x, hi.y}; }
        { const int mt = w >> 2, nt = w & 3; unsigned o[8];
#pragma unroll
          for (int p = 0; p < 8; ++p) { const int reg0 = 2 * p, row0 = 32 * mt + (reg0 & 3) + 8 * (reg0 >> 2) + 4 * hh;
              o[p] = (unsigned)Us[row0 * QP + 32 * nt + r31] | ((unsigned)Us[(row0 + 1) * QP + 32 * nt + r31] << 16); }
          *(u32x4*)(ub + UO_U + w * 2048 + lane * 32) = (u32x4){o[0], o[1], o[2], o[3]}; *(u32x4*)(ub + UO_U + w * 2048 + lane * 32 + 16) = (u32x4){o[4], o[5], o[6], o[7]}; }
        { const int mt = w >> 2, ct = (w >> 1) & 1, s2 = w & 1, row = 32 * mt + r31, col0 = 32 * ct + 16 * s2 + 4 * hh;
          const f32x4 x0 = *(const LAS f32x4*)(QKm + row * FP + col0), x1 = *(const LAS f32x4*)(QKm + row * FP + col0 + 8);
          *(u32x4*)(ub + UO_QK + w * 1024 + lane * 16) = (u32x4){pk(x0.x, x0.y), pk(x0.z, x0.w), pk(x1.x, x1.y), pk(x1.z, x1.w)}; }
        if (tid == 0) *(float*)(ub + UO_DL) = __expf(glast);
        __syncthreads();
    }
#undef PREP_LOAD
}

__device__ __forceinline__ bf16x8 pack_step(const f32x16& x, int s) { return __builtin_bit_cast(bf16x8, ((u32x4){pk(x[8 * s], x[8 * s + 1]), pk(x[8 * s + 2], x[8 * s + 3]), pk(x[8 * s + 4], x[8 * s + 5]), pk(x[8 * s + 6], x[8 * s + 7])})); }
__device__ __forceinline__ void p4_scan(Frame& F) {
    constexpr int NSCAN = NBATCH * NH * 2;
    if (F.bid >= NSCAN) {
        const int nconv = (F.G - NSCAN) < NCONV_SCAN ? (F.G - NSCAN) : NCONV_SCAN;
        if (F.bid - NSCAN < nconv) convert_experts(F, (F.bid - NSCAN) * 8 + F.wave, nconv * 8, ti_early(F.G), TI_EXP);
        return;
    }
    const int b = F.bid >> 4, h = (F.bid >> 1) & 7, dir = F.bid & 1, lane = F.lane;
    const unsigned char* prep = F.ws + WS_PREP;
#define STEP_CIDX(n) (dir ? ((n) < CTXL / 64 ? CTXL / 64 - 1 - (n) : NCHUNK + CTXL / 64 - 1 - (n)) : (n))
#define STEP_UNIT(n) (prep + (size_t)((((b * NCHUNK + STEP_CIDX(n)) * NH + h) * 2) + dir) * UNIT_BYTES)
    const int wv = F.wave;
#define ISSUE(n) do { const unsigned char* _ub = STEP_UNIT(n); LAS unsigned char* _lb = F.lds + ((n) & 1) * UNIT_DMA; _Pragma("unroll") for (int _p = 0; _p < 10; ++_p) \
            if (_p * 8 + wv < UNIT_DMA / 1024) __builtin_amdgcn_global_load_lds((const unsigned*)(_ub + (_p * 8 + wv) * 1024 + lane * 16), (LAS unsigned*)(_lb + (_p * 8 + wv) * 1024), 16, 0, 0); } while (0)
    ISSUE(0);
    if (F.wave >= 4) {
        for (int n = 0; n < NCHUNK; ++n) { VM_WAIT(); __builtin_amdgcn_s_barrier(); asm volatile("" ::: "memory"); if (n + 1 < NCHUNK) ISSUE(n + 1); }
        VM_WAIT();
        return;
    }
    const int nt = F.wave, c = lane & 31, hh = lane >> 5;
    bf16_t* OGb = WSP(bf16_t, WS_OGB) + (size_t)dir * ML * 1024;
    f32x16 S[4];
#pragma unroll
    for (int kt = 0; kt < 4; ++kt)
#pragma unroll
        for (int i = 0; i < 16; ++i) S[kt][i] = 0.f;
    bool stored = false;
#pragma unroll 1
    for (int n = 0; n < NCHUNK; ++n) {
        if (stored) asm volatile("s_waitcnt vmcnt(32)" ::: "memory"); else VM_WAIT();
        __builtin_amdgcn_s_barrier(); asm volatile("" ::: "memory");
        if (n + 1 < NCHUNK) ISSUE(n + 1);
        const LAS unsigned char* lb = F.lds + (n & 1) * UNIT_DMA;
        const float dlc = *(const LAS float*)(lb + UO_DL);
        u32x4 ucur[2][2];
#pragma unroll
        for (int mt = 0; mt < 2; ++mt) { ucur[mt][0] = *(const LAS u32x4*)(lb + UO_U + (mt * 4 + nt) * 2048 + lane * 32); ucur[mt][1] = *(const LAS u32x4*)(lb + UO_U + (mt * 4 + nt) * 2048 + lane * 32 + 16); }
#define FRAG(off, idx) (*(const LAS bf16x8*)(lb + (off) + (idx) * 1024 + lane * 16))
        f32x16 VN[2], O[2];
#pragma unroll
        for (int mt = 0; mt < 2; ++mt) {
#pragma unroll
            for (int p = 0; p < 4; ++p) { VN[mt][2 * p] = bf_lo(ucur[mt][0][p]); VN[mt][2 * p + 1] = bf_hi(ucur[mt][0][p]); VN[mt][8 + 2 * p] = bf_lo(ucur[mt][1][p]); VN[mt][8 + 2 * p + 1] = bf_hi(ucur[mt][1][p]); }
#pragma unroll
            for (int i = 0; i < 16; ++i) O[mt][i] = 0.f; }
#pragma unroll
        for (int kt = 0; kt < 4; ++kt) { const bf16x8 sb0 = pack_step(S[kt], 0), sb1 = pack_step(S[kt], 1);
#pragma unroll
            for (int mt = 0; mt < 2; ++mt) { const int fi = (mt * 4 + kt) * 2;
                VN[mt] = MFMA32(FRAG(UO_NW, fi), sb0, VN[mt]); VN[mt] = MFMA32(FRAG(UO_NW, fi + 1), sb1, VN[mt]);
                O[mt] = MFMA32(FRAG(UO_QD, fi), sb0, O[mt]); O[mt] = MFMA32(FRAG(UO_QD, fi + 1), sb1, O[mt]); } }
        bf16x8 vb[2][2];
#pragma unroll
        for (int ct = 0; ct < 2; ++ct) { vb[ct][0] = pack_step(VN[ct], 0); vb[ct][1] = pack_step(VN[ct], 1); }
#pragma unroll
        for (int mt = 0; mt < 2; ++mt)
#pragma unroll
            for (int ct = 0; ct < 2; ++ct) { const int fi = (mt * 2 + ct) * 2; O[mt] = MFMA32(FRAG(UO_QK, fi), vb[ct][0], O[mt]); O[mt] = MFMA32(FRAG(UO_QK, fi + 1), vb[ct][1], O[mt]); }
#pragma unroll
        for (int kt = 0; kt < 4; ++kt) {
#pragma unroll
            for (int i = 0; i < 16; ++i) S[kt][i] *= dlc;
#pragma unroll
            for (int ct = 0; ct < 2; ++ct) { const int fi = (kt * 2 + ct) * 2; S[kt] = MFMA32(FRAG(UO_KDT, fi), vb[ct][0], S[kt]); S[kt] = MFMA32(FRAG(UO_KDT, fi + 1), vb[ct][1], S[kt]); } }
#undef FRAG
        const int cidx = STEP_CIDX(n);
        stored = cidx >= CTXL / 64;
        if (cidx >= CTXL / 64) { const int rowbase = b * SEQ + (cidx - CTXL / 64) * 64;
#pragma unroll
            for (int mt = 0; mt < 2; ++mt)
#pragma unroll
                for (int reg = 0; reg < 16; ++reg) { const int row = 32 * mt + (reg & 3) + 8 * (reg >> 2) + 4 * hh, prow = rowbase + (dir ? 63 - row : row);
                    OGb[(size_t)prow * 1024 + h * 128 + 32 * nt + c] = f2bf(O[mt][reg]); } }
    }
    VM_WAIT();
#undef ISSUE
#undef STEP_CIDX
#undef STEP_UNIT
}

struct MixRow { u32x4 oa[2], ob[2], zz[2], sb[2], cv[3][2], xv[3][2]; };
__device__ __forceinline__ MixRow mix_load(const bf16_t* P, const bf16_t* OGb, int row, int f0, int c0, bool horiz) {
    MixRow m; const int t = row % SEQ, gr = t / 64, gc = t % 64, dlt = horiz ? 1 : 64;
    const bool hasp = horiz ? (gc > 0) : (gr > 0), hasn = horiz ? (gc < 63) : (gr < SEQ / 64 - 1);
#pragma unroll
    for (int q = 0; q < 2; ++q) { m.oa[q] = *(const u32x4*)(OGb + (size_t)row * 1024 + f0 + 8 * q); m.ob[q] = *(const u32x4*)(OGb + (size_t)ML * 1024 + (size_t)row * 1024 + f0 + 8 * q);
        m.zz[q] = *(const u32x4*)(P + (size_t)row * NINP + COL_Z + f0 + 8 * q); m.sb[q] = *(const u32x4*)(P + (size_t)row * NINP + COL_SB + c0 + 8 * q); }
#pragma unroll
    for (int i = 0; i < 3; ++i) { const bool ok = i == 1 || (i == 0 ? hasp : hasn); const size_t rr = (size_t)(row + (ok ? (i - 1) * dlt : 0));
#pragma unroll
        for (int q = 0; q < 2; ++q) { m.cv[i][q] = *(const u32x4*)(P + rr * NINP + COL_SC + c0 + 8 * q); m.xv[i][q] = *(const u32x4*)(P + rr * NINP + COL_SX + c0 + 8 * q);
            if (!ok) m.cv[i][q] = (u32x4){0u, 0u, 0u, 0u}; } }
    return m;
}
__device__ __forceinline__ void p5_mix_out(Frame& F) {
    const bf16_t* P = WSP(const bf16_t, WS_P); const bf16_t* OGb = WSP(const bf16_t, WS_OGB); bf16_t* Y = WSP(bf16_t, WS_Y);
    const float* nw = F.in[I_GNW]; const float* cs = F.in[I_CONVSC];
    const int gw = F.bid * 8 + F.wave, NGW = F.G * 8;
    const int f0 = F.lane * 16, c0 = F.lane * 16; const bool horiz = c0 < 512;
    LAS float* nwL = (LAS float*)F.lds; LAS float* csL = nwL + 128;
    if (F.tid < 128) nwL[F.tid] = nw[F.tid];
    for (int i = F.tid; i < 3 * 1024; i += 512) csL[i] = cs[i];
    __syncthreads();
    if (gw >= ML) return;
    MixRow nx = mix_load(P, OGb, gw, f0, c0, horiz);
    for (int row = gw; row < ML; row += NGW) {
        const MixRow m = nx;
        if (row + NGW < ML) nx = mix_load(P, OGb, row + NGW, f0, c0, horiz);
        { float o[16]; float ss = 0.f;
#pragma unroll
          for (int q = 0; q < 2; ++q)
#pragma unroll
              for (int e = 0; e < 4; ++e) { const float s0 = bf_lo(m.oa[q][e]) + bf_lo(m.ob[q][e]), s1 = bf_hi(m.oa[q][e]) + bf_hi(m.ob[q][e]); o[8 * q + 2 * e] = s0; o[8 * q + 2 * e + 1] = s1; ss += s0 * s0 + s1 * s1; }
          ss += __shfl_xor(ss, 1); ss += __shfl_xor(ss, 2); ss += __shfl_xor(ss, 4);
          const float r = __builtin_amdgcn_rsqf(ss * (1.f / 128.f) + RMS_EPS);
          unsigned ow[8];
#pragma unroll
          for (int q = 0; q < 8; ++q) { const int f = (f0 + 2 * q) & 127; const unsigned zw = m.zz[q >> 2][q & 3];
              const float y0 = o[2 * q] * r * nwL[f] * silu_f(bf_lo(zw)), y1 = o[2 * q + 1] * r * nwL[f + 1] * silu_f(bf_hi(zw)); ow[q] = cvt_pk_bf16(y0, y1); }
          *(u32x4*)(Y + (size_t)row * D + f0) = (u32x4){ow[0], ow[1], ow[2], ow[3]}; *(u32x4*)(Y + (size_t)row * D + f0 + 8) = (u32x4){ow[4], ow[5], ow[6], ow[7]}; }
        { float acc[16];
#pragma unroll
          for (int q = 0; q < 16; ++q) acc[q] = 0.f;
#pragma unroll
          for (int i = 0; i < 3; ++i)
#pragma unroll
              for (int hh = 0; hh < 2; ++hh)
#pragma unroll
                  for (int q = 0; q < 4; ++q) { const int ch = c0 + 8 * hh + 2 * q; const unsigned cw = m.cv[i][hh][q], xw = m.xv[i][hh][q];
                      acc[8 * hh + 2 * q] += bf_lo(cw) * bf_lo(xw) * csL[i * 1024 + ch]; acc[8 * hh + 2 * q + 1] += bf_hi(cw) * bf_hi(xw) * csL[i * 1024 + ch + 1]; }
          unsigned ow[8];
#pragma unroll
          for (int q = 0; q < 8; ++q) { const unsigned bw = m.sb[q >> 2][q & 3]; ow[q] = cvt_pk_bf16(bf_lo(bw) * acc[2 * q], bf_hi(bw) * acc[2 * q + 1]); }
          *(u32x4*)(Y + (size_t)row * D + 1024 + c0) = (u32x4){ow[0], ow[1], ow[2], ow[3]}; *(u32x4*)(Y + (size_t)row * D + 1024 + c0 + 8) = (u32x4){ow[4], ow[5], ow[6], ow[7]}; }
    }
}

struct OutProj {
    static constexpr bool PERM = true, GATHER = false, FP8 = false, BBLK = false; typedef NoPre Pre;
    __device__ __forceinline__ Pre prefetch(const Unit&, int, int, int, int) const { return Pre{}; }
    int K; const char* A; const char* Bt; bf16_t* V; const float* x; const f32x2* st0; const float* g0; const float* b0; const float* modf; int G, c;
    __device__ __forceinline__ bool next(int i, Unit& u) const { const int L = i * G + c; if (L >= (ML / 256) * (D / 256)) return false; pg8::tile_order(L, ML / 256, D / 256, u.pm, u.pn); u.e = 0; return true; }
    __device__ __forceinline__ const char* bptr(const Unit& u, int half) const { return Bt + (size_t)(u.pn * 256 + half * 128) * K * 2; }
    __device__ __forceinline__ unsigned arow_i(int, const Unit& u, int r) const { return (unsigned)(u.pm * 256 + r); }
    __device__ __forceinline__ void epi(const f32x4 (&acc)[2][2][4][2], const Unit& u, int wr, int wc, int fr, int fq, const Pre&) const {
        const int row0 = u.pm * 256 + wr * 64 + fr, col0 = u.pn * 256 + wc * 32 + 8 * fq;
        const float* gt1 = modf + (size_t)(u.pm * 256 / SEQ) * (6 * D) + 2 * D;
        constexpr int XW = 4;
        f32x4 XA[16], XB[16]; f32x2 SS[16]; f32x4 PG[2][2], PB[2][2], PT[2][2];
#define OP_ROW(it_) (row0 + (((it_) >> 2) & 1) * 128 + ((it_) & 3) * 16)
#define OP_COL(it_) (col0 + ((it_) >> 3) * 128)
#define OP_LOAD(it_) do { SS[it_] = st0[OP_ROW(it_)]; XA[it_] = *(const f32x4*)(x + (size_t)OP_ROW(it_) * D + OP_COL(it_)); XB[it_] = *(const f32x4*)(x + (size_t)OP_ROW(it_) * D + OP_COL(it_) + 4); } while (0)
#define OP_PARAMS(bj_) do { const int _c = col0 + (bj_) * 128; PG[bj_][0] = *(const f32x4*)(g0 + _c); PG[bj_][1] = *(const f32x4*)(g0 + _c + 4); PB[bj_][0] = *(const f32x4*)(b0 + _c); PB[bj_][1] = *(const f32x4*)(b0 + _c + 4); \
            PT[bj_][0] = *(const f32x4*)(gt1 + _c); PT[bj_][1] = *(const f32x4*)(gt1 + _c + 4); } while (0)
        OP_PARAMS(0);
#pragma unroll
        for (int it = 0; it < XW; ++it) OP_LOAD(it);
#pragma unroll
        for (int it = 0; it < 16; ++it) { const int bj = it >> 3, ai = (it >> 2) & 1, m = it & 3; const f32x2 sv = SS[it];
            const f32x4 va = ((XA[it] - sv.x) * sv.y * PG[bj][0] + PB[bj][0]) * DN_ALPHA + PT[bj][0] * acc[ai][bj][m][0], vb = ((XB[it] - sv.x) * sv.y * PG[bj][1] + PB[bj][1]) * DN_ALPHA + PT[bj][1] * acc[ai][bj][m][1];
            *(u32x4*)(V + (size_t)OP_ROW(it) * D + OP_COL(it)) = (u32x4){cvt_pk_bf16(va[0], va[1]), cvt_pk_bf16(va[2], va[3]), cvt_pk_bf16(vb[0], vb[1]), cvt_pk_bf16(vb[2], vb[3])};
            if (it == 3) OP_PARAMS(1);
            if (it + XW < 16) OP_LOAD(it + XW); }
#undef OP_ROW
#undef OP_COL
#undef OP_LOAD
#undef OP_PARAMS
    }
};

constexpr int UT_PITCH = D + 4;
__device__ __forceinline__ void p7_ln1_router(Frame& F) {
    int tz_ = threadIdx.x; asm volatile("" : "+v"(tz_));
    const int tid_ = tz_, lane_ = tz_ & 63, wave_ = __builtin_amdgcn_readfirstlane(tz_ >> 6);
    LAS float* uT = (LAS float*)F.lds;
    LAS float* part = uT + 16 * UT_PITCH;
    LAS float* logit = part + 8 * 16 * 32;
    const bf16_t* V = WSP(const bf16_t, WS_V); f32x2* st1 = WSP(f32x2, WS_STAT1); const float* modf = WSP(const float, WS_MODF); unsigned char* U8 = WSP(unsigned char, WS_U);
    const float* g1 = F.in[I_LN1G]; const float* b1 = F.in[I_LN1B]; const float* wrt = F.in[I_WR]; const float* brt = F.in[I_BR];
    int* toke = WSP(int, WS_TOKE); int* tokp = WSP(int, WS_TOKP); float* tokg = WSP(float, WS_TOKG); int* list = WSP(int, WS_LIST);
    const int r16 = lane_ & 15, kk = lane_ >> 4;
    u32x2 vw[2][8];
#define LN1_LOAD(tile_) do { _Pragma("unroll") for (int _rr = 0; _rr < 2; ++_rr) { const u32x2* _xr = (const u32x2*)(V + (size_t)((tile_) * 16 + wave_ * 2 + _rr) * D) + lane_; \
            _Pragma("unroll") for (int _j = 0; _j < 8; ++_j) vw[_rr][_j] = _xr[64 * _j]; } } while (0)
    if (F.bid < ML / 16) LN1_LOAD(F.bid);
    for (int tile = F.bid; tile < ML / 16; tile += F.G) {
        const int rbase = tile * 16; const int bidx = rbase / SEQ; const float* sh2 = modf + (size_t)bidx * (6 * D) + 3 * D; const float* sc2 = sh2 + D;
        f32x4 pa[8], pc[8];
        unsigned dofs = 4u * (unsigned)lane_; asm volatile("" : "+v"(dofs));
#pragma unroll
        for (int j = 0; j < 8; ++j) { const f32x4 sc = *(const f32x4*)((sc2 + 256 * j) + dofs) + 1.f;
            pa[j] = *(const f32x4*)((g1 + 256 * j) + dofs) * sc; pc[j] = *(const f32x4*)((b1 + 256 * j) + dofs) * sc + *(const f32x4*)((sh2 + 256 * j) + dofs);
            if (j == 3) asm volatile("" ::: "memory"); }
#pragma unroll
        for (int rr = 0; rr < 2; ++rr) {
            const int lr = wave_ * 2 + rr, row = rbase + lr;
            f32x4 x[8]; float s = 0.f;
#pragma unroll
            for (int j = 0; j < 8; ++j) { const u32x2 w = vw[rr][j]; x[j] = (f32x4){bf_lo(w.x), bf_hi(w.x), bf_lo(w.y), bf_hi(w.y)}; s += (x[j].x + x[j].y) + (x[j].z + x[j].w); }
            const float mean = wave_sum(s) * (1.f / D); float s2 = 0.f;
#pragma unroll
            for (int j = 0; j < 8; ++j) { x[j] = x[j] - mean; s2 += (x[j].x * x[j].x + x[j].y * x[j].y) + (x[j].z * x[j].z + x[j].w * x[j].w); }
            const float rstd = 1.f / sqrtf(wave_sum(s2) * (1.f / D) + LN_EPS);
            if (lane_ == 0) st1[row] = (f32x2){mean, rstd}; unsigned* uo = (unsigned*)(U8 + (size_t)row * D) + lane_;
#pragma unroll
            for (int j = 0; j < 8; ++j) { const int d = 4 * lane_ + 256 * j;
                const f32x4 u = (x[j] * rstd) * pa[j] + pc[j];
                uo[64 * j] = pk_fp8x4(u.x, u.y, u.z, u.w);
                *(LAS f32x4*)(uT + lr * UT_PITCH + d) = u; }
        }
        unsigned wlo = (unsigned)(4 * kk * NE + r16); asm volatile("" : "+v"(wlo));
        float wl[16][4][2]; asm volatile("" ::: "memory");
#define RW_LOAD(m_) do { _Pragma("unroll") for (int _j = 0; _j < 4; ++_j) _Pragma("unroll") for (int _nt = 0; _nt < 2; ++_nt) \
            wl[m_][_j][_nt] = (wrt + (256 * wave_ + 16 * (m_)) * NE)[wlo + (unsigned)(_j * NE + 16 * _nt)]; } while (0)
#pragma unroll
        for (int m = 0; m < 12; ++m) RW_LOAD(m);
        __syncthreads();
        f32x4 lacc[2] = {{0.f, 0.f, 0.f, 0.f}, {0.f, 0.f, 0.f, 0.f}};
#pragma unroll
        for (int m = 0; m < 16; ++m) { const f32x4 a = *(const LAS f32x4*)(uT + r16 * UT_PITCH + 256 * wave_ + 16 * m + 4 * kk);
#pragma unroll
            for (int j = 0; j < 4; ++j) { lacc[0] = __builtin_amdgcn_mfma_f32_16x16x4f32(a[j], wl[m][j][0], lacc[0], 0, 0, 0); lacc[1] = __builtin_amdgcn_mfma_f32_16x16x4f32(a[j], wl[m][j][1], lacc[1], 0, 0, 0); }
            if (m == 3) { __builtin_amdgcn_sched_barrier(0); RW_LOAD(12); RW_LOAD(13); RW_LOAD(14); RW_LOAD(15); __builtin_amdgcn_sched_barrier(0); } }
#undef RW_LOAD
#pragma unroll
        for (int nt = 0; nt < 2; ++nt)
#pragma unroll
            for (int q = 0; q < 4; ++q) part[(wave_ * 16 + 4 * kk + q) * 32 + 16 * nt + r16] = lacc[nt][q];
        __syncthreads();
        if (tile + F.G < ML / 16) LN1_LOAD(tile + F.G);
        { const int lr = tid_ >> 5, e = tid_ & 31; float s = brt[e];
#pragma unroll
          for (int w = 0; w < 8; ++w) s += part[(w * 16 + lr) * 32 + e];
          logit[lr * 32 + e] = s; }
        __syncthreads();
        if (tid_ < 16) { const int row = rbase + tid_; float lv[32];
#pragma unroll
            for (int e = 0; e < 32; ++e) lv[e] = logit[tid_ * 32 + e];
            float tv[4]; int ti[4];
#pragma unroll
            for (int s4 = 0; s4 < 4; ++s4) { float best = -3.0e38f; int bi = 0;
#pragma unroll
                for (int e = 0; e < 32; ++e) { const bool take = lv[e] > best; best = take ? lv[e] : best; bi = take ? e : bi; }
                tv[s4] = best; ti[s4] = bi;
#pragma unroll
                for (int e = 0; e < 32; ++e) lv[e] = (e == bi) ? -3.0e38f : lv[e]; }
            const float e0 = 1.f, e1 = __expf(tv[1] - tv[0]), e2 = __expf(tv[2] - tv[0]), e3 = __expf(tv[3] - tv[0]); const float inv = 1.f / (e0 + e1 + e2 + e3);
            const float gg[4] = {e0 * inv, e1 * inv, e2 * inv, e3 * inv};
            int pos[4];
#pragma unroll
            for (int s4 = 0; s4 < 4; ++s4) pos[s4] = (int)__hip_atomic_fetch_add(F.ctl + CW_CNT + 64 * ti[s4], 1u, __ATOMIC_RELAXED, __HIP_MEMORY_SCOPE_AGENT);
            *(i32x4*)(toke + row * 4) = (i32x4){ti[0], ti[1], ti[2], ti[3]}; *(f32x4*)(tokg + row * 4) = (f32x4){gg[0], gg[1], gg[2], gg[3]};
            *(i32x4*)(tokp + row * 4) = (i32x4){pos[0], pos[1], pos[2], pos[3]};
#pragma unroll
            for (int s4 = 0; s4 < 4; ++s4) list[(size_t)ti[s4] * ML + pos[s4]] = row; }
        __syncthreads();
    }
#undef LN1_LOAD
}

struct MoeTab { const LAS int* cnt; const LAS int* pstart; };
__device__ __forceinline__ void moe_tables(Frame& F) {
    LAS int* cnt = (LAS int*)(F.lds + TAB_OFF); LAS int* ps = cnt + 32;
    if (F.tid < 32) cnt[F.tid] = (int)__hip_atomic_load(F.ctl + CW_CNT + 64 * F.tid, __ATOMIC_RELAXED, __HIP_MEMORY_SCOPE_AGENT);
    __syncthreads();
    if (F.tid == 0) { int a = 0; for (int e = 0; e < 32; ++e) { ps[e] = a; a += (cnt[e] + 255) / 256 * 256; } ps[32] = a; }
    __syncthreads();
    if (F.tid < MAXTILES) { int e = 0; const int r = F.tid * 256;
#pragma unroll
        for (int q = 1; q < 32; ++q) e = (ps[q] <= r) ? q : e;
        ps[48 + F.tid] = e; }
    __syncthreads();
}
__device__ __forceinline__ int moe_tile_expert(const LAS int* ps, int tile) { return ps[48 + tile]; }

struct MoeUp {
    static constexpr bool PERM = true, GATHER = true, FP8 = true, BBLK = true;
    int K, NB; const char* A; const char* Wg; const char* Wu; unsigned char* H; const float* bg; const float* bu; const int* list; const LAS int* cnt; const LAS int* ps; const LAS int* gtab; int G, c;
    __device__ __forceinline__ bool next(int i, Unit& u) const {
        const int NT = ps[32] / 256, NU = NT * 16, L = i * G + c; if (L >= NU) return false;
        pg8::tile_order(L, NT, 16, u.pm, u.pn); u.e = moe_tile_expert(ps, u.pm); return true;
    }
    __device__ __forceinline__ const char* bptr(const Unit& u, int half) const { return (half ? Wu : Wg) + (size_t)u.e * D * D + (size_t)(u.pn * 128) * 16; }
    __device__ __forceinline__ unsigned arow(const Unit& u, int r) const { const int loc = u.pm * 256 + r - ps[u.e]; return loc < cnt[u.e] ? (unsigned)list[(size_t)u.e * ML + loc] : 0u; }
    __device__ __forceinline__ unsigned arow_i(int ord, const Unit&, int r) const { return (unsigned)gtab[ord * 256 + r]; }
    struct Pre { f32x4 g0, g1, u0, u1; };
    __device__ __forceinline__ Pre prefetch(const Unit& u, int wr, int wc, int fr, int fq) const { const int col0 = u.pn * 128 + wc * 32 + 8 * fq; Pre p;
        p.g0 = *(const f32x4*)(bg + (size_t)u.e * D + col0); p.g1 = *(const f32x4*)(bg + (size_t)u.e * D + col0 + 4); p.u0 = *(const f32x4*)(bu + (size_t)u.e * D + col0); p.u1 = *(const f32x4*)(bu + (size_t)u.e * D + col0 + 4); return p; }
    __device__ __forceinline__ void epi(const f32x4 (&acc)[2][2][4][2], const Unit& u, int wr, int wc, int fr, int fq, const Pre& pre) const {
        const int row0 = u.pm * 256 + wr * 64 + fr, col0 = u.pn * 128 + wc * 32 + 8 * fq;
        const f32x4 g0 = pre.g0, g1 = pre.g1, u0 = pre.u0, u1 = pre.u1;
#pragma unroll
        for (int ai = 0; ai < 2; ++ai)
#pragma unroll
            for (int m = 0; m < 4; ++m) { float hv[8];
#pragma unroll
                for (int n = 0; n < 2; ++n)
#pragma unroll
                    for (int jp = 0; jp < 2; ++jp) { const int j = 2 * jp;
                        const f32x2 bgv = n ? (f32x2){g1[j], g1[j + 1]} : (f32x2){g0[j], g0[j + 1]}, buv = n ? (f32x2){u1[j], u1[j + 1]} : (f32x2){u0[j], u0[j + 1]};
                        f32x2 glu = (f32x2){acc[ai][0][m][n][j], acc[ai][0][m][n][j + 1]} * (1.f / W8_SCALE) + bgv, lin = (f32x2){acc[ai][1][m][n][j], acc[ai][1][m][n][j + 1]} * (1.f / W8_SCALE) + buv;
                        glu.x = fminf(glu.x, 7.0f); glu.y = fminf(glu.y, 7.0f); lin.x = __builtin_amdgcn_fmed3f(lin.x, -7.0f, 7.0f); lin.y = __builtin_amdgcn_fmed3f(lin.y, -7.0f, 7.0f);
                        const f32x2 ea = glu * (-1.702f * 1.4426950408889634f); f32x2 dn; dn.x = __builtin_amdgcn_exp2f(ea.x); dn.y = __builtin_amdgcn_exp2f(ea.y); dn = dn + 1.0f;
                        f32x2 sg; sg.x = __builtin_amdgcn_rcpf(dn.x); sg.y = __builtin_amdgcn_rcpf(dn.y);
                        const f32x2 hh2 = (glu * sg) * (lin * H8_SCALE + H8_SCALE); hv[4 * n + j] = hh2.x; hv[4 * n + j + 1] = hh2.y; }
                *(u32x2*)(H + (size_t)(row0 + ai * 128 + m * 16) * D + col0) = (u32x2){pk_fp8x4(hv[0], hv[1], hv[2], hv[3]), pk_fp8x4(hv[4], hv[5], hv[6], hv[7])}; }
    }
};
struct MoeDown {
    static constexpr bool PERM = true, GATHER = false, FP8 = true, BBLK = true;
    int K, NB; const char* A; const char* Wd; unsigned char* O; const float* bd; const LAS int* ps; int G, c;
    __device__ __forceinline__ bool next(int i, Unit& u) const {
        const int NT = ps[32] / 256, NU = NT * 8, L = i * G + c; if (L >= NU) return false;
        pg8::tile_order(L, NT, 8, u.pm, u.pn); u.e = moe_tile_expert(ps, u.pm); return true;
    }
    __device__ __forceinline__ const char* bptr(const Unit& u, int half) const { return Wd + (size_t)u.e * D * D + (size_t)(u.pn * 256 + half * 128) * 16; }
    __device__ __forceinline__ unsigned arow_i(int, const Unit& u, int r) const { return (unsigned)(u.pm * 256 + r); }
    struct Pre { f32x4 c[2][2]; };
    __device__ __forceinline__ Pre prefetch(const Unit& u, int wr, int wc, int fr, int fq) const { const int col0 = u.pn * 256 + wc * 32 + 8 * fq; Pre p;
#pragma unroll
        for (int bj = 0; bj < 2; ++bj) { p.c[bj][0] = *(const f32x4*)(bd + (size_t)u.e * D + col0 + bj * 128); p.c[bj][1] = *(const f32x4*)(bd + (size_t)u.e * D + col0 + bj * 128 + 4); }
        return p; }
    __device__ __forceinline__ void epi(const f32x4 (&acc)[2][2][4][2], const Unit& u, int wr, int wc, int fr, int fq, const Pre& pre) const {
        const int row0 = u.pm * 256 + wr * 64 + fr, col0 = u.pn * 256 + wc * 32 + 8 * fq;
#pragma unroll
        for (int bj = 0; bj < 2; ++bj) { const f32x4 c0 = pre.c[bj][0], c1 = pre.c[bj][1];
#pragma unroll
            for (int ai = 0; ai < 2; ++ai)
#pragma unroll
                for (int m = 0; m < 4; ++m) { const f32x4 v0 = acc[ai][bj][m][0] * (O8_SCALE / (W8_SCALE * H8_SCALE)) + c0 * O8_SCALE, v1 = acc[ai][bj][m][1] * (O8_SCALE / (W8_SCALE * H8_SCALE)) + c1 * O8_SCALE;
#define SAT8(x) __builtin_amdgcn_fmed3f((x), -448.f, 448.f)
                    *(u32x2*)(O + (size_t)(row0 + ai * 128 + m * 16) * D + col0 + bj * 128) = (u32x2){pk_fp8x4(SAT8(v0[0]), SAT8(v0[1]), SAT8(v0[2]), SAT8(v0[3])), pk_fp8x4(SAT8(v1[0]), SAT8(v1[1]), SAT8(v1[2]), SAT8(v1[3]))}; } }
#undef SAT8
    }
};

__device__ __forceinline__ void p10_final(Frame& F) {
    int tz_ = threadIdx.x; asm volatile("" : "+v"(tz_));
    const int tid_ = tz_, lane_ = tz_ & 63, wave_ = __builtin_amdgcn_readfirstlane(tz_ >> 6);
    const LAS int* ps = (const LAS int*)(F.lds + TAB_OFF) + 32;
    const unsigned char* O = WSP(const unsigned char, WS_O); const float* modf = WSP(const float, WS_MODF); const bf16_t* V = WSP(const bf16_t, WS_V); const f32x2* st1 = WSP(const f32x2, WS_STAT1);
    const float* g1 = F.in[I_LN1G]; const float* b1 = F.in[I_LN1B];
    const i32x4* toke = WSP(const i32x4, WS_TOKE); const i32x4* tokp = WSP(const i32x4, WS_TOKP); const f32x4* tokg = WSP(const f32x4, WS_TOKG);
    const float* g2 = F.in[I_LN2G]; const float* b2 = F.in[I_LN2B];
    const int gw = F.bid * 8 + wave_, NGW = F.G * 8;
    LAS float* PL = (LAS float*)F.lds;
    for (int i = tid_; i < D; i += 512) { PL[i] = g1[i]; PL[D + i] = b1[i]; PL[2 * D + i] = g2[i]; PL[3 * D + i] = b2[i]; PL[4 * D + i] = modf[5 * D + i]; PL[5 * D + i] = modf[(size_t)(6 * D) + 5 * D + i]; }
    __syncthreads();
    if (gw >= ML) return;
    i32x4 ne = toke[gw], np = tokp[gw]; f32x4 ng = tokg[gw];
    unsigned own[4][8]; u32x2 hwn[8]; f32x2 srn; f32x4 cgn;
#define FIN_GATHER(row_) do { _Pragma("unroll") for (int _s = 0; _s < 4; ++_s) { const unsigned* _or = (const unsigned*)(O + (size_t)(ps[ne[_s]] + np[_s]) * D) + lane_; \
            _Pragma("unroll") for (int _j = 0; _j < 8; ++_j) own[_s][_j] = _or[64 * _j]; } \
        { const u32x2* _hr = (const u32x2*)(V + (size_t)(row_) * D) + lane_; _Pragma("unroll") for (int _j = 0; _j < 8; ++_j) hwn[_j] = _hr[64 * _j]; } \
        srn = st1[row_]; cgn = ng; } while (0)
    FIN_GATHER(gw);
    if (gw + NGW < ML) { ne = toke[gw + NGW]; np = tokp[gw + NGW]; ng = tokg[gw + NGW]; }
    for (int row = gw; row < ML; row += NGW) {
        unsigned ow[4][8]; u32x2 hw[8];
#pragma unroll
        for (int s4 = 0; s4 < 4; ++s4)
#pragma unroll
            for (int j = 0; j < 8; ++j) ow[s4][j] = own[s4][j];
#pragma unroll
        for (int j = 0; j < 8; ++j) hw[j] = hwn[j];
        const f32x2 sr = srn; const f32x4 cg = cgn;
        if (row + NGW < ML) { FIN_GATHER(row + NGW);
            if (row + 2 * NGW < ML) { ne = toke[row + 2 * NGW]; np = tokp[row + 2 * NGW]; ng = tokg[row + 2 * NGW]; } }
        const LAS float* gt2 = PL + 4 * D + (row / SEQ) * D;
        f32x4 f[8]; float s = 0.f;
#pragma unroll
        for (int j = 0; j < 8; ++j) { f32x4 a = {0.f, 0.f, 0.f, 0.f};
#pragma unroll
            for (int s4 = 0; s4 < 4; ++s4) { const unsigned w = ow[s4][j]; const f32x2 lo = __builtin_amdgcn_cvt_pk_f32_fp8((int)w, false), hi = __builtin_amdgcn_cvt_pk_f32_fp8((int)w, true); a += (f32x4){lo.x, lo.y, hi.x, hi.y} * (cg[s4] * (1.f / O8_SCALE)); }
            const int d = 4 * lane_ + 256 * j; const u32x2 h = hw[j];
            const f32x4 h1 = ((f32x4){bf_lo(h.x), bf_hi(h.x), bf_lo(h.y), bf_hi(h.y)} - sr.x) * sr.y * *(const LAS f32x4*)(PL + d) + *(const LAS f32x4*)(PL + D + d);
            f[j] = h1 * DN_ALPHA + *(const LAS f32x4*)(gt2 + d) * a; s += (f[j].x + f[j].y) + (f[j].z + f[j].w);
            if (j & 1) __builtin_amdgcn_sched_barrier(0); }
        const float mean = wave_sum(s) * (1.f / D); float s2 = 0.f;
#pragma unroll
        for (int j = 0; j < 8; ++j) { f[j] = f[j] - mean; s2 += (f[j].x * f[j].x + f[j].y * f[j].y) + (f[j].z * f[j].z + f[j].w * f[j].w); }
        const float rstd = __builtin_amdgcn_rsqf(wave_sum(s2) * (1.f / D) + LN_EPS);
        f32x4* orw = (f32x4*)(F.out + (size_t)row * D) + lane_;
#pragma unroll
        for (int j = 0; j < 8; ++j) { const int d = 4 * lane_ + 256 * j; orw[64 * j] = f[j] * rstd * *(const LAS f32x4*)(PL + 2 * D + d) + *(const LAS f32x4*)(PL + 3 * D + d); }
    }
#undef FIN_GATHER
}

constexpr int NPHASE = 12;
__global__ void __launch_bounds__(512, 2) fwd_kernel(Args args) {
    extern __shared__ __attribute__((aligned(16))) unsigned char lds_raw[];
    Frame F;
    F.lds = (LAS unsigned char*)lds_raw; F.MISC = (volatile LAS unsigned*)(F.lds + MISC_OFF);
    F.tid = threadIdx.x; F.lane = F.tid & 63; F.wave = __builtin_amdgcn_readfirstlane(F.tid >> 6); F.G = gridDim.x; F.bid = blockIdx.x;
    F.ws = args.ws; F.ctl = (unsigned*)(args.ws + WS_CTL); F.in = args.in; F.out = args.out;
    if (F.tid < 128) ((LAS unsigned*)(F.lds + MISC_OFF))[F.tid] = 0u;
    __syncthreads();
    const int lo = args.ph_lo, hi = args.ph_hi;
    XcdBarrier bar; bar.bar = F.ctl + CW_BAR + args.li * XCD_BAR_WORDS; bar.x = 0; bar.st = nullptr;
    if (hi - lo > 1) bar = xcd_barrier_post(F.ctl + CW_BAR + args.li * XCD_BAR_WORDS, F.MISC);
#ifndef PH_MASK
#define PH_MASK 0xfff
#endif
#define IN(k) (((PH_MASK >> (k)) & 1) && lo <= (k) && (k) < hi)
#define SEAM(k) do { if (IN(k) && IN((k) + 1)) xcd_barrier(bar); } while (0)
#ifndef PROBE_DBL
#define PROBE_DBL -1
#endif
#define REP(k) for (int _rep = 0; _rep < ((PROBE_DBL == (k)) ? 2 : 1); ++_rep)
    if (IN(0)) REP(0) { p0_prologue(F); if (PROBE_DBL == 0) { VM_WAIT(); __syncthreads(); } } SEAM(0);
    if (IN(1)) REP(1) { p1_ln0(F); if (PROBE_DBL == 1) { VM_WAIT(); __syncthreads(); } } SEAM(1);
    if (IN(2)) REP(2) { const int gconv = (F.G > 2 * NCONV_WG) ? NCONV_WG : 0, ggemm = F.G - gconv;
                 if (F.bid < ggemm) { InProj S{D, (const char*)WSP(bf16_t, WS_HM), (const char*)WSP(bf16_t, WS_WIN), WSP(bf16_t, WS_P), ggemm, F.bid}; pg8::gemm_phase(F.lds, S); }
                 else if (PROBE_DBL != 2 || _rep == 0) convert_experts(F, (F.bid - ggemm) * 8 + F.wave, gconv * 8, 0, ti_early(F.G)); } SEAM(2);
    if (IN(3)) REP(3) { p3a_tokens(F); if (PROBE_DBL == 3) { VM_WAIT(); __syncthreads(); } } SEAM(3);
    if (IN(4)) REP(4) { p3_prep(F); if (PROBE_DBL == 4) { VM_WAIT(); __syncthreads(); } } SEAM(4);
    if (IN(5)) { p4_scan(F); if (PROBE_DBL == 5) { VM_WAIT(); __syncthreads(); p4_scan(F); } } SEAM(5);
    if (IN(6)) REP(6) { p5_mix_out(F); if (PROBE_DBL == 6) { VM_WAIT(); __syncthreads(); } } SEAM(6);
    if (IN(7)) REP(7) { OutProj S{D, (const char*)WSP(bf16_t, WS_Y), (const char*)WSP(bf16_t, WS_WOUT), WSP(bf16_t, WS_V), F.in[I_X], WSP(const f32x2, WS_STAT0), F.in[I_LN0G], F.in[I_LN0B], WSP(const float, WS_MODF), F.G, F.bid};
                 pg8::gemm_phase(F.lds, S); } SEAM(7);
    if (IN(8)) { p7_ln1_router(F); } SEAM(8);
    if (IN(9) || IN(10) || IN(11)) moe_tables(F);
    if (IN(9)) REP(9) { const LAS int* cnt = (const LAS int*)(F.lds + TAB_OFF);
                 LAS int* gtab = (LAS int*)(F.lds + GTAB_OFF);
                 MoeUp S{D / 2, D, (const char*)WSP(unsigned char, WS_U), (const char*)WSP(unsigned char, WS_WG), (const char*)WSP(unsigned char, WS_WU), WSP(unsigned char, WS_H), F.in[I_BGATE], F.in[I_BUP], WSP(const int, WS_LIST), cnt, cnt + 32, gtab, F.G, F.bid};
                 { int gi[GTAB_UNITS / 2];
#pragma unroll
                   for (int k = 0; k < GTAB_UNITS / 2; ++k) { const int i = 2 * k + (F.tid >> 8); Unit u; gi[k] = -1; if (S.next(i, u)) gi[k] = (int)S.arow(u, F.tid & 255); }
#pragma unroll
                   for (int k = 0; k < GTAB_UNITS / 2; ++k) { const int i = 2 * k + (F.tid >> 8); if (gi[k] >= 0) gtab[i * 256 + (F.tid & 255)] = gi[k]; } }
                 __syncthreads();
                 pg8::gemm_phase(F.lds, S); } SEAM(9);
    if (IN(10)) REP(10) { const LAS int* cnt = (const LAS int*)(F.lds + TAB_OFF);
                 MoeDown S{D / 2, D, (const char*)WSP(unsigned char, WS_H), (const char*)WSP(unsigned char, WS_WD), WSP(unsigned char, WS_O), F.in[I_BDOWN], cnt + 32, F.G, F.bid};
                 pg8::gemm_phase(F.lds, S); } SEAM(10);
    if (IN(11)) { p10_final(F); }
#undef IN
#undef SEAM
}

extern "C" void kernel_launch(void* const* d_in, const int* in_sizes, int n_in, void* d_out, int out_size, void* d_ws, size_t ws_size, hipStream_t stream) {
    static int grid = 0;
    if (grid == 0) {
        if (n_in != 27 || out_size != ML * D || ws_size < WS_END) { fprintf(stderr, "kernel_launch: unexpected problem (n_in %d, out %d, ws %zu < %zu)\n", n_in, out_size, ws_size, (size_t)WS_END); grid = -1; return; }
        int dev = 0, cus = 0, per_cu = 0;
        if (hipGetDevice(&dev) != hipSuccess || hipDeviceGetAttribute(&cus, hipDeviceAttributeMultiprocessorCount, dev) != hipSuccess) { grid = -1; return; }
        if (hipFuncSetAttribute((const void*)fwd_kernel, hipFuncAttributeMaxDynamicSharedMemorySize, LDS_BYTES) != hipSuccess) { fprintf(stderr, "kernel_launch: hipFuncSetAttribute failed\n"); grid = -1; return; }
        if (hipOccupancyMaxActiveBlocksPerMultiprocessor(&per_cu, (const void*)fwd_kernel, 512, LDS_BYTES) != hipSuccess || per_cu < 1) { fprintf(stderr, "kernel_launch: occupancy query says %d\n", per_cu); }
        (void)hipGetLastError();
        grid = cus;
    }
    if (grid < 0) return;
    if (hipMemsetAsync((char*)d_ws + WS_CTL, 0, CTL_BYTES, stream) != hipSuccess) return;
    Args a{};
    for (int i = 0; i < 27; ++i) a.in[i] = (const float*)d_in[i];
    a.out = (float*)d_out; a.ws = (unsigned char*)d_ws; a.pad = 0;
#if MK_N_LAUNCHES == 1
    a.ph_lo = 0; a.ph_hi = NPHASE; a.li = 0;
    hipLaunchKernelGGL(fwd_kernel, dim3(grid), dim3(512), LDS_BYTES, stream, a);
#else
    for (int p = 0; p < NPHASE; ++p) { a.ph_lo = p; a.ph_hi = p + 1; a.li = 0; hipLaunchKernelGGL(fwd_kernel, dim3(grid), dim3(512), LDS_BYTES, stream, a); }
#endif
}
```

```cpp
#include <hip/hip_runtime.h>
#include <cstdio>
#include <cstdint>

#ifndef MK_N_LAUNCHES
#define MK_N_LAUNCHES 1
#endif

#define LAS __attribute__((address_space(3)))
#define GAS __attribute__((address_space(1)))
typedef unsigned short bf16_t;
typedef short bf16x8 __attribute__((ext_vector_type(8)));
typedef float f32x4 __attribute__((ext_vector_type(4)));
typedef float f32x2 __attribute__((ext_vector_type(2)));
typedef unsigned u32x4 __attribute__((ext_vector_type(4)));
typedef unsigned u32x2 __attribute__((ext_vector_type(2)));

constexpr int D = 2048, NBATCH = 2, SEQ = 8192, ML = NBATCH * SEQ, CTXL = 256, MC = NBATCH * CTXL, MTOT = ML + MC;
constexpr int NH = 8, DK = 128, GQK = 1024, GQKV = 3072, GIN = 3104, NIN = 7200, NINP = 7424;
constexpr int COL_A = 3072, COL_B = 3088, COL_Z = 3104, COL_SB = 4128, COL_SC = 5152, COL_SX = 6176;
constexpr int NE = 32, TOPK = 4, MAXROWS = ML * TOPK + NE * 256, MAXTILES = MAXROWS / 256;
constexpr float LN_EPS = 1e-5f, RMS_EPS = 1e-6f;
constexpr float DN_ALPHA = 1.189207115002721f;
constexpr int NPART = 8;

constexpr size_t MiB = 1ull << 20;
constexpr size_t WS_CTL = 0, CTL_BYTES = 64 * 1024;
constexpr size_t WS_MODP = 1 * MiB;
constexpr size_t WS_MODF = 3 * MiB;
constexpr size_t WS_STAT0 = 4 * MiB;
constexpr size_t WS_STAT1 = 4 * MiB + 512 * 1024;
constexpr size_t WS_TOKE = 5 * MiB;
constexpr size_t WS_TOKP = WS_TOKE + 256 * 1024;
constexpr size_t WS_TOKG = WS_TOKP + 256 * 1024;
constexpr size_t WS_LIST = 6 * MiB;
constexpr size_t WS_WIN = 8 * MiB;
constexpr size_t WS_WOUT = 38 * MiB;
constexpr size_t WS_WG = 48 * MiB, WS_WU = 304 * MiB, WS_WD = 560 * MiB;
constexpr size_t WS_HM = 816 * MiB;
constexpr size_t WS_P = 882 * MiB;
constexpr size_t WS_PREP = 1122 * MiB;
constexpr size_t WS_OGB = 1424 * MiB;
constexpr size_t WS_Y = 1488 * MiB;
constexpr size_t WS_V = 1552 * MiB;
constexpr size_t WS_H1B = 1616 * MiB;
constexpr size_t WS_U = 1680 * MiB;
constexpr size_t WS_H = 882 * MiB;
constexpr size_t WS_O = 1170 * MiB;
constexpr size_t WS_END = 1744 * MiB;
constexpr size_t WS_QKVB = WS_V;
constexpr size_t WS_GBF = WS_U;
#ifdef GDN_NAIVE
constexpr size_t WS_QKV = 1744 * MiB;
constexpr size_t WS_GB = 1942 * MiB;
constexpr size_t WS_OG = 1946 * MiB;
#endif
constexpr int NCHUNK = (CTXL + SEQ) / 64, NUNITS = NBATCH * NCHUNK * NH * 2;
constexpr int UNIT_BYTES = 74752, UO_NW = 0, UO_QD = 16384, UO_KDT = 32768, UO_QK = 49152, UO_U = 57344, UO_DL = 73728, UNIT_DMA = 74752;
static_assert(WS_WIN + (size_t)NINP * D * 2 <= WS_WOUT && WS_P + (size_t)MTOT * NINP * 2 <= WS_PREP && WS_PREP + (size_t)NUNITS * UNIT_BYTES <= WS_OGB, "ws map");
static_assert(WS_H + (size_t)MAXROWS * D * 2 <= WS_O && WS_O + (size_t)MAXROWS * D * 2 <= WS_Y && WS_OGB + (size_t)2 * ML * 1024 * 2 <= WS_Y, "ws map 2");
constexpr int CW_CNT = 1024;
constexpr int CW_BAR = 8192;

constexpr int LDS_BYTES = 155648;
constexpr int MISC_OFF = 155136;
constexpr int BIAS_OFF = 149504;
constexpr int GTAB_OFF = 131072, GTAB_UNITS = 18;
constexpr int TAB_OFF = 151552;

__device__ __forceinline__ unsigned cvt_pk_bf16(float lo, float hi) { unsigned r; asm volatile("v_cvt_pk_bf16_f32 %0, %1, %2" : "=v"(r) : "v"(lo), "v"(hi)); return r; }
__device__ __forceinline__ float bf_lo(unsigned w) { return __uint_as_float(w << 16); }
__device__ __forceinline__ float bf_hi(unsigned w) { return __uint_as_float(w & 0xffff0000u); }
__device__ __forceinline__ float bf2f(bf16_t b) { return __uint_as_float(((unsigned)b) << 16); }
__device__ __forceinline__ float silu_f(float x) { return x * __builtin_amdgcn_rcpf(1.0f + __expf(-x)); }
__device__ __forceinline__ float sigmoid_f(float x) { return __builtin_amdgcn_rcpf(1.0f + __expf(-x)); }
__device__ __forceinline__ float softplus_f(float x) { return x > 20.f ? x : log1pf(__expf(x)); }
__device__ __forceinline__ float wave_sum(float v) {
#pragma unroll
    for (int o = 1; o < 64; o <<= 1) v += __shfl_xor(v, o);
    return v;
}
typedef int i32x8 __attribute__((ext_vector_type(8)));
typedef int i32x4 __attribute__((ext_vector_type(4)));
__device__ __forceinline__ unsigned pk_fp8x4(float a, float b, float c, float d) { int w = __builtin_amdgcn_cvt_pk_fp8_f32(a, b, 0, false); w = __builtin_amdgcn_cvt_pk_fp8_f32(c, d, w, true); return (unsigned)w; }
constexpr float W8_SCALE = 64.f, H8_SCALE = 8.f, O8_SCALE = 16.f;
#define LDS_WAIT() asm volatile("s_waitcnt lgkmcnt(0)" ::: "memory")
#define VM_WAIT() asm volatile("s_waitcnt vmcnt(0)" ::: "memory")

#define XB_TMO      128
#define XB_XCNT(j)  (256  + 64 * (j))
#define XB_XSUB(j)  (1280 + 64 * (j))
#define XB_XGEN(j)  (2304 + 64 * (j))
#define XB_TOP      3328
#define XB_TOPGEN   3392
#define XCD_BAR_WORDS 3456
#define XB_SPIN_CAP (1u << 22)

__device__ __forceinline__ unsigned xb_ld(unsigned* p)              { return __hip_atomic_load(p, __ATOMIC_RELAXED, __HIP_MEMORY_SCOPE_AGENT); }
__device__ __forceinline__ unsigned xb_add(unsigned* p, unsigned v) { return __hip_atomic_fetch_add(p, v, __ATOMIC_RELAXED, __HIP_MEMORY_SCOPE_AGENT); }
__device__ __forceinline__ unsigned xb_xcc_id() { return (unsigned)__builtin_amdgcn_s_getreg((3 << 11) | 20) & 0xFu; }
#define XB_SPIN(cond, bar) do { unsigned _sp = 0; while (cond) { __builtin_amdgcn_s_sleep(1); \
    if ((++_sp & 255u) == 0u) { if (xb_ld(&(bar)[XB_TMO])) break; if (_sp > XB_SPIN_CAP) { atomicAdd(&(bar)[XB_TMO], 1u); break; } } } } while (0)

struct XcdBarrier { unsigned* bar; unsigned x; volatile LAS unsigned* st; };

__device__ __forceinline__ XcdBarrier xcd_barrier_post(unsigned* bar, volatile LAS unsigned* st) {
    XcdBarrier b; b.bar = bar; b.x = xb_xcc_id(); b.st = st;
    if (threadIdx.x == 0) (void)xb_add(&bar[XB_XCNT(b.x)], 1u);
    return b;
}
__device__ __forceinline__ void xcd_barrier_complete(unsigned* bar, unsigned x, unsigned& nloc, unsigned& nx) {
    const unsigned G = gridDim.x * gridDim.y * gridDim.z;
    unsigned sum, cnt, mine, sp = 0u;
    for (;;) {
        sum = 0u; cnt = 0u; mine = 0u;
#pragma unroll
        for (unsigned j = 0; j < 16; ++j) { const unsigned c = xb_ld(&bar[XB_XCNT(j)]); sum += c; cnt += (c > 0u) ? 1u : 0u; mine = (j == x) ? c : mine; }
        if (sum == G) break;
        __builtin_amdgcn_s_sleep(1);
        if ((++sp & 255u) == 0u) { if (xb_ld(&bar[XB_TMO])) break; if (sp > XB_SPIN_CAP) { atomicAdd(&bar[XB_TMO], 1u); break; } }
    }
    nloc = mine > 0u ? mine : 1u; nx = cnt > 0u ? cnt : 1u;
}
__device__ __forceinline__ void xcd_barrier(const XcdBarrier& b) {
    asm volatile("s_waitcnt vmcnt(0)" ::: "memory");
    __syncthreads();
    if (threadIdx.x == 0) {
        unsigned* bar = b.bar;
        __builtin_amdgcn_s_waitcnt(0);
        unsigned nloc = b.st[0], nx = b.st[1];
        if (nloc == 0u) { xcd_barrier_complete(bar, b.x, nloc, nx); b.st[0] = nloc; b.st[1] = nx; }
        const unsigned old = xb_add(&bar[XB_XSUB(b.x)], 1u);
        const unsigned gen = old / nloc;
        if (old + 1u == (gen + 1u) * nloc) {
            __builtin_amdgcn_fence(__ATOMIC_RELEASE, "agent");
            asm volatile("s_waitcnt vmcnt(0)" ::: "memory");
            const unsigned og = xb_add(&bar[XB_TOP], 1u);
            const unsigned tg = og / nx;
            if (og + 1u == (tg + 1u) * nx) xb_add(&bar[XB_TOPGEN], 1u);
            else XB_SPIN(xb_ld(&bar[XB_TOPGEN]) == tg, bar);
            __builtin_amdgcn_fence(__ATOMIC_ACQUIRE, "agent");
            xb_add(&bar[XB_XGEN(b.x)], 1u);
            asm volatile("s_waitcnt vmcnt(0)" ::: "memory");
        } else {
            XB_SPIN(xb_ld(&bar[XB_XGEN(b.x)]) == gen, bar);
            __builtin_amdgcn_fence(__ATOMIC_ACQUIRE, "agent");
            asm volatile("s_waitcnt vmcnt(0)" ::: "memory");
        }
    }
    __syncthreads();
}

struct Args { const float* in[27]; float* out; unsigned char* ws; int ph_lo, ph_hi, li, pad; };
enum { I_X = 0, I_C, I_CTX, I_CCTX, I_LN0G, I_LN0B, I_WADA, I_BADA, I_WIN, I_CONVQKV, I_ALOG, I_DTB, I_GNW, I_CONVSC, I_WOUT, I_LN1G, I_LN1B, I_WR, I_BR,
       I_WGATE, I_BGATE, I_WUP, I_BUP, I_WDOWN, I_BDOWN, I_LN2G, I_LN2B };

namespace pg8 {
constexpr int BM = 256, BK = 64, HALF = 128, HTB = HALF * BK * 2, STAGE_BYTES = 8 * HTB, NXCD = 8, WGM = 8;
__host__ __device__ __forceinline__ int lds_byte(int r, int c) { const int st = (r >> 4) * 2 + (c >> 5), rr = r & 15, cc = c & 31, ob = rr * 64 + cc * 2; return st * 1024 + (ob ^ (((ob >> 9) & 1) << 5)); }
__host__ __device__ __forceinline__ void stage_rc(int b, int& R, int& C) { const int st = b / 1024, sb = b % 1024, swz = sb ^ (((sb >> 9) & 1) << 5); R = (st >> 1) * 16 + swz / 64; C = (st & 1) * 32 + (swz % 64) / 2; }
__host__ __device__ __forceinline__ int perm32(int rho) { const int n = rho >> 4, i = rho & 15; return 8 * (i >> 2) + 4 * n + (i & 3); }

struct Unit { int pm, pn, e; };
__device__ __forceinline__ void tile_order(int L, int nM, int nN, int& pm, int& pn) {
    const int nwg = nM * nN; int wgid = L;
    { const int q = nwg / NXCD, r = nwg % NXCD, xcd = wgid % NXCD, off = wgid / NXCD; wgid = (xcd < r ? xcd * (q + 1) : r * (q + 1) + (xcd - r) * q) + off; }
    const int nig = WGM * nN, gid = wgid / nig, fm = gid * WGM, gsz = (nM - fm) < WGM ? (nM - fm) : WGM;
    pm = fm + ((wgid % nig) % gsz); pn = (wgid % nig) / gsz;
}

template <class P>
__device__ __forceinline__ void gemm_phase(LAS unsigned char* lds, const P& S) {
    int tid = threadIdx.x; asm volatile("" : "+v"(tid));
    const int wid = __builtin_amdgcn_readfirstlane(tid >> 6), lane = tid & 63, wr = wid >> 2, wc = wid & 3, fr = lane & 15, fq = lane >> 4;
    const int K = S.K, nt = K / BK;
    unsigned voffB[2]; int RA[2], CA[2];
#pragma unroll
    for (int i = 0; i < 2; ++i) { int R, C; stage_rc(tid * 16 + i * 8192, R, C); const int Rb = P::PERM ? ((R & ~31) + perm32(R & 31)) : R;
        RA[i] = R; CA[i] = C; if constexpr (P::BBLK) voffB[i] = (unsigned)((C >> 3) * S.NB + Rb) * 16u; else voffB[i] = (unsigned)(Rb * K + C) * 2u; }
    const size_t kstep = (size_t)(BK * 2);
    size_t kstepB = kstep; if constexpr (P::BBLK) kstepB = (size_t)128 * (size_t)S.NB;
    const unsigned ldsw = (unsigned)wid * 1024u;
    const int aoff = lds_byte(wr * 64 + fr, fq * 8), boff = lds_byte(wc * 32 + fr, fq * 8);
#define PG8_SA(b, h) (((b) * 2 + (h)) * HTB)
#define PG8_SB(b, h) ((4 + (b) * 2 + (h)) * HTB)
#define PG8_STAGE_B(bufoff, gbase) do { _Pragma("unroll") for (int _i = 0; _i < 2; ++_i) \
        __builtin_amdgcn_global_load_lds((const unsigned*)((const char*)(gbase) + voffB[_i]), (LAS unsigned*)(lds + (bufoff) + ldsw + _i * 8192), 16, 0, 0); } while (0)
#define PG8_STAGE_A(bufoff, AO, h, kb) do { _Pragma("unroll") for (int _i = 0; _i < 2; ++_i) \
        __builtin_amdgcn_global_load_lds((const unsigned*)(S.A + (size_t)(AO)[h][_i] + (size_t)(kb)), (LAS unsigned*)(lds + (bufoff) + ldsw + _i * 8192), 16, 0, 0); } while (0)
#define PG8_LDA(dst, b, h) do { _Pragma("unroll") for (int m = 0; m < 4; ++m) { dst[m].lo = *(const LAS i32x4*)(lds + PG8_SA(b, h) + aoff + m * 2048); dst[m].hi = *(const LAS i32x4*)(lds + PG8_SA(b, h) + aoff + m * 2048 + 1024); } } while (0)
#define PG8_LDB(dst, b, h) do { _Pragma("unroll") for (int n = 0; n < 2; ++n) { dst[n].lo = *(const LAS i32x4*)(lds + PG8_SB(b, h) + boff + n * 2048); dst[n].hi = *(const LAS i32x4*)(lds + PG8_SB(b, h) + boff + n * 2048 + 1024); } } while (0)
#define PG8_MMA(ai, bj, At, Bt) do { __builtin_amdgcn_s_setprio(1); \
        if constexpr (P::FP8) { _Pragma("unroll") for (int m = 0; m < 4; ++m) _Pragma("unroll") for (int n = 0; n < 2; ++n) \
            { FP8_MMA_ONE(acc[ai][bj][m][n], Bt[n], At[m]); } } \
        else { _Pragma("unroll") for (int m = 0; m < 4; ++m) _Pragma("unroll") for (int n = 0; n < 2; ++n) { \
            const i32x4 _bl = __builtin_shufflevector(Bt[n], Bt[n], 0, 1, 2, 3), _bh = __builtin_shufflevector(Bt[n], Bt[n], 4, 5, 6, 7), _al = __builtin_shufflevector(At[m], At[m], 0, 1, 2, 3), _ah = __builtin_shufflevector(At[m], At[m], 4, 5, 6, 7); \
            acc[ai][bj][m][n] = __builtin_amdgcn_mfma_f32_16x16x32_bf16(__builtin_bit_cast(bf16x8, _bl), __builtin_bit_cast(bf16x8, _al), acc[ai][bj][m][n], 0, 0, 0); \
            acc[ai][bj][m][n] = __builtin_amdgcn_mfma_f32_16x16x32_bf16(__builtin_bit_cast(bf16x8, _bh), __builtin_bit_cast(bf16x8, _ah), acc[ai][bj][m][n], 0, 0, 0); } } \
        __builtin_amdgcn_s_setprio(0); } while (0)
typedef int i32x2 __attribute__((ext_vector_type(2)));
#ifdef FP8_LEGACY_MFMA
#define FP8_MMA_ONE(c, b8, a8) do { \
        const i32x2 _b0 = __builtin_shufflevector(b8, b8, 0, 1), _b1 = __builtin_shufflevector(b8, b8, 2, 3), _b2 = __builtin_shufflevector(b8, b8, 4, 5), _b3 = __builtin_shufflevector(b8, b8, 6, 7); \
        const i32x2 _a0 = __builtin_shufflevector(a8, a8, 0, 1), _a1 = __builtin_shufflevector(a8, a8, 2, 3), _a2 = __builtin_shufflevector(a8, a8, 4, 5), _a3 = __builtin_shufflevector(a8, a8, 6, 7); \
        asm volatile("s_nop 1\n\tv_mfma_f32_16x16x32_fp8_fp8 %0, %1, %2, %0\n\ts_nop 7\n\tv_mfma_f32_16x16x32_fp8_fp8 %0, %3, %4, %0\n\ts_nop 7\n\tv_mfma_f32_16x16x32_fp8_fp8 %0, %5, %6, %0\n\ts_nop 7\n\tv_mfma_f32_16x16x32_fp8_fp8 %0, %7, %8, %0" \
                     : "+v"(c) : "v"(_b0), "v"(_a0), "v"(_b1), "v"(_a1), "v"(_b2), "v"(_a2), "v"(_b3), "v"(_a3)); } while (0)
#else
#define FP8_MMA_ONE(c, b8, a8) asm volatile("v_mfma_f32_16x16x128_f8f6f4 %0, %1, %2, %0" : "+v"(c) : "v"(b8), "v"(a8))
#endif
#define PG8_WAIT_V(n) asm volatile("s_waitcnt vmcnt(" #n ")" ::: "memory")
#define PG8_WAIT_L(n) asm volatile("s_waitcnt lgkmcnt(" #n ")" ::: "memory")
#define PG8_BAR __builtin_amdgcn_s_barrier()
#define PG8_SCHED __builtin_amdgcn_sched_barrier(0)
#define PG8_AOFF(AO, u, ord) do { _Pragma("unroll") for (int _h = 0; _h < 2; ++_h) _Pragma("unroll") for (int _i = 0; _i < 2; ++_i) \
        (AO)[_h][_i] = (unsigned)((size_t)S.arow_i((ord), (u), _h * HALF + RA[_i]) * (size_t)K + (size_t)CA[_i]) * 2u; } while (0)
    Unit cur, nxt; int ui = 0;
    if (!S.next(0, cur)) return;
    f32x4 acc[2][2][4][2];
#pragma unroll
    for (int a = 0; a < 2; ++a)
#pragma unroll
        for (int b = 0; b < 2; ++b)
#pragma unroll
            for (int m = 0; m < 4; ++m)
#pragma unroll
                for (int n = 0; n < 2; ++n) acc[a][b][m][n] = (f32x4){0.f, 0.f, 0.f, 0.f};
    i32x8 At[4], B0[2], B1[2];
    unsigned ac[2][2], a2[2][2];
    PG8_AOFF(ac, cur, 0);
    const char* cB0 = S.bptr(cur, 0); const char* cB1 = S.bptr(cur, 1);
    PG8_STAGE_B(PG8_SB(0, 0), cB0); PG8_STAGE_A(PG8_SA(0, 0), ac, 0, 0); PG8_STAGE_B(PG8_SB(0, 1), cB1); PG8_STAGE_A(PG8_SA(0, 1), ac, 1, 0);
    if (wr == 1) PG8_BAR;
    PG8_WAIT_V(4); PG8_BAR;
    PG8_STAGE_B(PG8_SB(1, 0), cB0 + kstepB); PG8_STAGE_A(PG8_SA(1, 0), ac, 0, kstep); PG8_STAGE_B(PG8_SB(1, 1), cB1 + kstepB);
    PG8_WAIT_V(6); PG8_BAR;
    for (;;) {
        const bool has_next = S.next(ui + 1, nxt);
        const char* nB0 = has_next ? S.bptr(nxt, 0) : cB0; const char* nB1 = has_next ? S.bptr(nxt, 1) : cB1;
        typename P::Pre pre{};
        for (int t = 0; t < nt; t += 2) {
            const bool last = (t == nt - 2);
            if (last) { S.bias_issue(cur, lds + BIAS_OFF, wid, lane); pre = S.prefetch(cur, wr, wc, fr, fq); }
            if (last && has_next) { PG8_AOFF(a2, nxt, ui + 1); } else {
#pragma unroll
                for (int _h = 0; _h < 2; ++_h)
#pragma unroll
                    for (int _i = 0; _i < 2; ++_i) a2[_h][_i] = last ? ac[_h][_i] : ac[_h][_i] + (unsigned)((t + 2) * (BK * 2)); }
            const size_t k1 = (size_t)(t + 1) * kstep;
            const char* b20 = last ? nB0 : cB0 + (size_t)(t + 2) * kstepB; const char* b21 = last ? nB1 : cB1 + (size_t)(t + 2) * kstepB;
            PG8_LDB(B0, 0, 0); PG8_SCHED; PG8_LDA(At, 0, 0); PG8_STAGE_A(PG8_SA(1, 1), ac, 1, k1);
            PG8_WAIT_L(8); PG8_BAR; PG8_WAIT_L(0); PG8_MMA(0, 0, At, B0); PG8_BAR; PG8_SCHED;
            PG8_LDB(B1, 0, 1); PG8_STAGE_B(PG8_SB(0, 0), b20);
            PG8_BAR; PG8_WAIT_L(0); PG8_MMA(0, 1, At, B1); PG8_BAR;
            PG8_LDA(At, 0, 1); PG8_STAGE_A(PG8_SA(0, 0), a2, 0, 0);
            PG8_BAR; PG8_WAIT_L(0); PG8_MMA(1, 0, At, B0); PG8_BAR; PG8_SCHED;
            PG8_STAGE_B(PG8_SB(0, 1), b21);
            PG8_WAIT_V(6); PG8_BAR; PG8_MMA(1, 1, At, B1); PG8_BAR;
            PG8_LDB(B0, 1, 0); PG8_SCHED; PG8_LDA(At, 1, 0); PG8_STAGE_A(PG8_SA(0, 1), a2, 1, 0);
            PG8_WAIT_L(8); PG8_BAR; PG8_WAIT_L(0); PG8_MMA(0, 0, At, B0); PG8_BAR; PG8_SCHED;
            PG8_LDB(B1, 1, 1); PG8_STAGE_B(PG8_SB(1, 0), b20 + kstepB);
            PG8_BAR; PG8_WAIT_L(0); PG8_MMA(0, 1, At, B1); PG8_BAR;
            PG8_LDA(At, 1, 1); PG8_STAGE_A(PG8_SA(1, 0), a2, 0, kstep);
            PG8_BAR; PG8_WAIT_L(0); PG8_MMA(1, 0, At, B0); PG8_BAR; PG8_SCHED;
            PG8_STAGE_B(PG8_SB(1, 1), b21 + kstepB);
            PG8_WAIT_V(6); PG8_BAR; PG8_MMA(1, 1, At, B1); PG8_BAR;
        }
        if constexpr (P::FP8) asm volatile("s_nop 15\n\ts_nop 15" ::: "memory");
        S.epi(acc, cur, wr, wc, fr, fq, S.bias_read(lds + BIAS_OFF, wc, fq, pre));
        if (!has_next) break;
#pragma unroll
        for (int a = 0; a < 2; ++a)
#pragma unroll
            for (int b = 0; b < 2; ++b)
#pragma unroll
                for (int m = 0; m < 4; ++m)
#pragma unroll
                    for (int n = 0; n < 2; ++n) acc[a][b][m][n] = (f32x4){0.f, 0.f, 0.f, 0.f};
        cur = nxt; cB0 = nB0; cB1 = nB1; ++ui;
#pragma unroll
        for (int _h = 0; _h < 2; ++_h)
#pragma unroll
            for (int _i = 0; _i < 2; ++_i) ac[_h][_i] = a2[_h][_i];
    }
    PG8_WAIT_V(0);
    if (wr == 0) PG8_BAR;
    PG8_BAR;
#undef PG8_SA
#undef PG8_SB
#undef PG8_STAGE_A
#undef PG8_STAGE_B
#undef PG8_LDA
#undef PG8_LDB
#undef PG8_MMA
#undef PG8_WAIT_V
#undef PG8_WAIT_L
#undef PG8_BAR
#undef PG8_SCHED
#undef PG8_AOFF
}
}
using pg8::Unit;

struct Frame {
    LAS unsigned char* lds;
    volatile LAS unsigned* MISC;
    unsigned* ctl;
    unsigned char* ws;
    int tid, lane, wave, G, bid;
    const float* const* in;
    float* out;
};
#define WSP(T, off) ((T*)(F.ws + (off)))

__device__ __forceinline__ void transpose_load(const float* __restrict__ W, int N, int item, int lane, f32x4 (&v)[16]) {
    const int nblk = (N + 63) / 64, kb = item / nblk, nb = item % nblk, k0 = 64 * kb, n0 = 64 * nb;
    const int lk = lane >> 4, ln = (lane & 15) * 4; const bool ok = n0 + ln < N;
#pragma unroll
    for (int i = 0; i < 16; ++i) v[i] = ok ? *(const f32x4*)(W + (size_t)(k0 + 4 * i + lk) * N + n0 + ln) : (f32x4){0.f, 0.f, 0.f, 0.f};
}
__device__ __forceinline__ void transpose_finish(int K, int N, bf16_t* __restrict__ WT, int row_off, LAS float* scr, int item, int lane, const f32x4 (&v)[16]) {
    const int nblk = (N + 63) / 64, kb = item / nblk, nb = item % nblk, k0 = 64 * kb, n0 = 64 * nb;
    const int lk = lane >> 4, ln = (lane & 15) * 4;
#pragma unroll
    for (int i = 0; i < 16; ++i) { LAS float* d = scr + (4 * i + lk) * 65 + ln; d[0] = v[i].x; d[1] = v[i].y; d[2] = v[i].z; d[3] = v[i].w; }
    LDS_WAIT(); asm volatile("" ::: "memory");
    const int c = lane & 7;
#pragma unroll
    for (int j = 0; j < 8; ++j) { const int n = (lane >> 3) + 8 * j; const LAS float* s = scr + (8 * c) * 65 + n;
        if (n0 + n < N) { u32x4 o; o.x = cvt_pk_bf16(s[0 * 65], s[1 * 65]); o.y = cvt_pk_bf16(s[2 * 65], s[3 * 65]); o.z = cvt_pk_bf16(s[4 * 65], s[5 * 65]); o.w = cvt_pk_bf16(s[6 * 65], s[7 * 65]);
            *(u32x4*)(WT + (size_t)(row_off + n0 + n) * K + k0 + 8 * c) = o; } }
    LDS_WAIT(); asm volatile("" ::: "memory");
}
constexpr int TI_PER_MAT = (D / 64) * (D / 64);
constexpr int TI_WIN = (D / 64) * ((NIN + 63) / 64);
constexpr int TI_SMALL = TI_WIN + TI_PER_MAT;
constexpr int TI_EXP = 3 * NE * TI_PER_MAT;
#ifndef NCONV_SCAN
#define NCONV_SCAN 168
#endif
#ifndef NCONV_WG
#define NCONV_WG 20
#endif
#ifndef TI_EARLY_PCT
#define TI_EARLY_PCT 12
#endif
__host__ __device__ constexpr int ti_early(int G) { return (G > 2 * NCONV_WG) ? (TI_EXP / 100) * TI_EARLY_PCT : 0; }
__device__ __forceinline__ void transpose_small_load(Frame& F, int it, f32x4 (&v)[16]) {
    if (it < TI_WIN) transpose_load(F.in[I_WIN], NIN, it, F.lane, v); else transpose_load(F.in[I_WOUT], D, it - TI_WIN, F.lane, v);
}
__device__ __forceinline__ void transpose_small_finish(Frame& F, int it, LAS float* scr, const f32x4 (&v)[16]) {
    if (it < TI_WIN) transpose_finish(D, NIN, WSP(bf16_t, WS_WIN), 0, scr, it, F.lane, v); else transpose_finish(D, D, WSP(bf16_t, WS_WOUT), 0, scr, it - TI_WIN, F.lane, v);
}
__device__ __forceinline__ void convert_load(Frame& F, int it, f32x4 (&v)[16]) {
    const int mat = it / TI_PER_MAT, r = it % TI_PER_MAT, type = mat / NE, e = mat % NE, kb = r >> 3, n4 = (r & 7) * 256 + F.lane * 4;
    const float* src = F.in[type == 0 ? I_WGATE : (type == 1 ? I_WUP : I_WDOWN)] + (size_t)e * D * D + (size_t)(kb * 16) * D + n4;
#pragma unroll
    for (int i = 0; i < 16; ++i) v[i] = __builtin_nontemporal_load((const f32x4*)(src + (size_t)i * D));
}
__device__ __forceinline__ void convert_store(Frame& F, int it, const f32x4 (&v)[16]) {
    const int mat = it / TI_PER_MAT, r = it % TI_PER_MAT, type = mat / NE, e = mat % NE, kb = r >> 3, n4 = (r & 7) * 256 + F.lane * 4;
    unsigned char* dst = F.ws + (type == 0 ? WS_WG : (type == 1 ? WS_WU : WS_WD)) + (size_t)e * D * D + ((size_t)kb * D + n4) * 16;
#pragma unroll
    for (int nn = 0; nn < 4; ++nn)
        *(u32x4*)(dst + nn * 16) = (u32x4){pk_fp8x4(v[0][nn] * W8_SCALE, v[1][nn] * W8_SCALE, v[2][nn] * W8_SCALE, v[3][nn] * W8_SCALE), pk_fp8x4(v[4][nn] * W8_SCALE, v[5][nn] * W8_SCALE, v[6][nn] * W8_SCALE, v[7][nn] * W8_SCALE),
                                          pk_fp8x4(v[8][nn] * W8_SCALE, v[9][nn] * W8_SCALE, v[10][nn] * W8_SCALE, v[11][nn] * W8_SCALE), pk_fp8x4(v[12][nn] * W8_SCALE, v[13][nn] * W8_SCALE, v[14][nn] * W8_SCALE, v[15][nn] * W8_SCALE)};
}
__device__ __forceinline__ void convert_experts(Frame& F, int gw, int NGW, int it0, int it1) {
    f32x4 A[16], B[16];
    for (int it = it0 + gw; it < it1; it += 2 * NGW) {
        const int i2 = it + NGW; const bool h2 = i2 < it1;
        convert_load(F, it, A); convert_load(F, h2 ? i2 : it, B); __builtin_amdgcn_sched_barrier(0);
        convert_store(F, it, A);
        if (h2) convert_store(F, i2, B);
    }
}
__device__ __forceinline__ void p0_prologue(Frame& F) {
    LAS float* red = (LAS float*)F.lds;
    const float* c = F.in[I_C]; const float* cctx = F.in[I_CCTX]; const float* wada = F.in[I_WADA];
    float* modp = WSP(float, WS_MODP);
    const int gw = F.bid * 8 + F.wave, NGW = F.G * 8;
    f32x4 tc[16], tn[16];
    if (gw < TI_SMALL) transpose_small_load(F, gw, tc);
    for (int it = F.bid; it < NPART * 32; it += F.G) {
        const int kq = it / 32, cg = it % 32, kb = kq * 256 + F.wave * 32, col = cg * 384 + F.lane * 4, col2 = cg * 384 + 256 + (F.lane & 31) * 4; const bool ex = F.lane < 32;
        f32x4 a0 = {0.f, 0.f, 0.f, 0.f}, a1 = a0, a2 = a0, b0 = a0, b1 = a0, b2 = a0;
#pragma unroll 8
        for (int i = 0; i < 32; ++i) { const int k = kb + i; const f32x4 wv = *(const f32x4*)(wada + (size_t)k * (6 * D) + col); f32x4 wx = {0.f, 0.f, 0.f, 0.f}; if (ex) wx = *(const f32x4*)(wada + (size_t)k * (6 * D) + col2);
            const float s0 = silu_f(c[k]), s1 = silu_f(c[D + k]), s2 = silu_f(cctx[k]); a0 += wv * s0; a1 += wv * s1; a2 += wv * s2; b0 += wx * s0; b1 += wx * s1; b2 += wx * s2; }
        *(LAS f32x4*)(red + (F.wave * 3 + 0) * 384 + F.lane * 4) = a0; *(LAS f32x4*)(red + (F.wave * 3 + 1) * 384 + F.lane * 4) = a1; *(LAS f32x4*)(red + (F.wave * 3 + 2) * 384 + F.lane * 4) = a2;
        if (ex) { *(LAS f32x4*)(red + (F.wave * 3 + 0) * 384 + 256 + F.lane * 4) = b0; *(LAS f32x4*)(red + (F.wave * 3 + 1) * 384 + 256 + F.lane * 4) = b1; *(LAS f32x4*)(red + (F.wave * 3 + 2) * 384 + 256 + F.lane * 4) = b2; }
        __syncthreads();
        for (int idx = F.tid; idx < 3 * 384; idx += 512) { const int v = idx / 384, cc = idx % 384; float s = 0.f;
#pragma unroll
            for (int w = 0; w < 8; ++w) s += red[(w * 3 + v) * 384 + cc];
            modp[(size_t)(kq * 3 + v) * (6 * D) + cg * 384 + cc] = s; }
        __syncthreads();
    }
    LAS float* scr = (LAS float*)(F.lds + F.wave * (64 * 65 * 4));
    for (int it = gw; it < TI_SMALL; it += NGW) {
        if (it + NGW < TI_SMALL) transpose_small_load(F, it + NGW, tn);
        transpose_small_finish(F, it, scr, tc);
#pragma unroll
        for (int i = 0; i < 16; ++i) tc[i] = tn[i];
    }
}

__device__ __forceinline__ const float* row_src(Frame& F, int row) { return row < ML ? F.in[I_X] + (size_t)row * D : F.in[I_CTX] + (size_t)(row - ML) * D; }
__device__ __forceinline__ int row_vec(int row) { return row < SEQ ? 0 : (row < ML ? 1 : 2); }
__device__ __forceinline__ void p1_ln0(Frame& F) {
    const int rpw = (MTOT + F.G - 1) / F.G, r0 = F.bid * rpw, r1 = (r0 + rpw < MTOT) ? r0 + rpw : MTOT;
    const float* modp = WSP(const float, WS_MODP); const float* bada = F.in[I_BADA];
    LAS float* SC = (LAS float*)F.lds;
    LAS float* SH = SC + 3 * D;
    if (r0 < r1) {
        const int vlo = row_vec(r0), vhi = row_vec(r1 - 1);
        for (int v = vlo; v <= vhi; ++v)
            for (int d = F.tid; d < D; d += 512) { float sh = bada[d], sc = bada[D + d];
#pragma unroll
                for (int p = 0; p < NPART; ++p) { sh += modp[(size_t)(p * 3 + v) * (6 * D) + d]; sc += modp[(size_t)(p * 3 + v) * (6 * D) + D + d]; }
                const float g0 = F.in[I_LN0G][d], b0 = F.in[I_LN0B][d];
                SC[v * D + d] = g0 * (1.f + sc); SH[v * D + d] = b0 * (1.f + sc) + sh; }
    }
    __syncthreads();
    bf16_t* HM = WSP(bf16_t, WS_HM); f32x2* st = WSP(f32x2, WS_STAT0);
    f32x4 xn[8];
    if (r0 + F.wave < r1) { const f32x4* xr = (const f32x4*)row_src(F, r0 + F.wave) + F.lane;
#pragma unroll
        for (int j = 0; j < 8; ++j) xn[j] = xr[64 * j]; }
    for (int row = r0 + F.wave; row < r1; row += 8) {
        const int v = row_vec(row);
        f32x4 x[8]; float s = 0.f;
#pragma unroll
        for (int j = 0; j < 8; ++j) { x[j] = xn[j]; s += (x[j].x + x[j].y) + (x[j].z + x[j].w); }
        if (row + 8 < r1) { const f32x4* xr = (const f32x4*)row_src(F, row + 8) + F.lane;
#pragma unroll
            for (int j = 0; j < 8; ++j) xn[j] = xr[64 * j]; }
        const float mean = wave_sum(s) * (1.f / D); float s2 = 0.f;
#pragma unroll
        for (int j = 0; j < 8; ++j) { x[j] = x[j] - mean; s2 += (x[j].x * x[j].x + x[j].y * x[j].y) + (x[j].z * x[j].z + x[j].w * x[j].w); }
        const float rstd = 1.f / sqrtf(wave_sum(s2) * (1.f / D) + LN_EPS);
        if (F.lane == 0) st[row] = (f32x2){mean, rstd};
        u32x2* o = (u32x2*)(HM + (size_t)row * D) + F.lane;
#pragma unroll
        for (int j = 0; j < 8; ++j) { const int d = 4 * F.lane + 256 * j; const f32x4 a = *(const LAS f32x4*)(SC + v * D + d), b = *(const LAS f32x4*)(SH + v * D + d);
            const f32x4 y = x[j] * rstd * a + b; u32x2 w; w.x = cvt_pk_bf16(y.x, y.y); w.y = cvt_pk_bf16(y.z, y.w); o[64 * j] = w; }
    }
    float* modf = WSP(float, WS_MODF);
    for (int idx = F.bid * 512 + F.tid; idx < 3 * 6 * D; idx += F.G * 512) { const int v = idx / (6 * D), n = idx % (6 * D); float s = bada[n];
#pragma unroll
        for (int p = 0; p < NPART; ++p) s += modp[(size_t)(p * 3 + v) * (6 * D) + n];
        modf[idx] = s; }
}

struct NoPre {};
struct InProj {
    static constexpr bool PERM = true, GATHER = false, FP8 = false, BBLK = false; typedef NoPre Pre;
    __device__ __forceinline__ Pre prefetch(const Unit&, int, int, int, int) const { return Pre{}; }
    __device__ __forceinline__ void bias_issue(const Unit&, LAS unsigned char*, int, int) const {}
    __device__ __forceinline__ Pre bias_read(const LAS unsigned char*, int, int, const Pre& p) const { return p; }
    int K; const char* A; const char* Bt; bf16_t* P; int G, c;
    __device__ __forceinline__ bool next(int i, Unit& u) const {
        const int L = i * G + c; constexpr int NMAIN = (ML / 256) * (NINP / 256), NCTXT = (GIN + 255) / 256;
        if (L < NMAIN) { pg8::tile_order(L, ML / 256, NINP / 256, u.pm, u.pn); u.e = 0; return true; }
        const int j = L - NMAIN; if (j >= (MC / 256) * NCTXT) return false;
        u.pm = ML / 256 + j / NCTXT; u.pn = j % NCTXT; u.e = 0; return true;
    }
    __device__ __forceinline__ const char* bptr(const Unit& u, int half) const { return Bt + (size_t)(u.pn * 256 + half * 128) * K * 2; }
    __device__ __forceinline__ unsigned arow_i(int, const Unit& u, int r) const { return (unsigned)(u.pm * 256 + r); }
    __device__ __forceinline__ void epi(const f32x4 (&acc)[2][2][4][2], const Unit& u, int wr, int wc, int fr, int fq, const Pre&) const {
        const int row0 = u.pm * 256 + wr * 64 + fr, col0 = u.pn * 256 + wc * 32 + 8 * fq;
#pragma unroll
        for (int ai = 0; ai < 2; ++ai)
#pragma unroll
            for (int m = 0; m < 4; ++m) { bf16_t* rowp = P + (size_t)(row0 + ai * 128 + m * 16) * NINP + col0;
#pragma unroll
                for (int bj = 0; bj < 2; ++bj) { const f32x4 v0 = acc[ai][bj][m][0], v1 = acc[ai][bj][m][1];
                    u32x4 w; w.x = cvt_pk_bf16(v0[0], v0[1]); w.y = cvt_pk_bf16(v0[2], v0[3]); w.z = cvt_pk_bf16(v1[0], v1[1]); w.w = cvt_pk_bf16(v1[2], v1[3]);
                    *(u32x4*)(rowp + bj * 128) = w; } }
    }
};

typedef float f32x16 __attribute__((ext_vector_type(16)));
typedef __bf16 bf2_t __attribute__((ext_vector_type(2)));
__device__ __forceinline__ unsigned pk(float a, float b) { f32x2 v = {a, b}; return __builtin_bit_cast(unsigned, __builtin_convertvector(v, bf2_t)); }
__device__ __forceinline__ bf16_t f2bf(float a) { return (bf16_t)(pk(a, 0.f) & 0xffffu); }
#define MFMA16(a, b, c) __builtin_amdgcn_mfma_f32_16x16x32_bf16((a), (b), (c), 0, 0, 0)
#define MFMA32(a, b, c) __builtin_amdgcn_mfma_f32_32x32x16_bf16((a), (b), (c), 0, 0, 0)
__device__ __forceinline__ void unit_rows(int b, int cidx, int& rowbase, int& segbase, int& len) {
    if (cidx < CTXL / 64) { segbase = ML + b * CTXL; len = CTXL; rowbase = segbase + cidx * 64; }
    else { segbase = b * SEQ; len = SEQ; rowbase = segbase + (cidx - CTXL / 64) * 64; }
}
constexpr int TOKB = 9;
__device__ __forceinline__ int tok_seg(int r) { return r < ML ? r / SEQ : NBATCH + (r - ML) / CTXL; }
template <bool MASKED>
__device__ __forceinline__ void tok_block(const bf16_t* P, bf16_t* QKVb, const float* cw, int b0, int nrow, int lane) {
#pragma unroll 1
    for (int jj = 0; jj < 6; ++jj) {
        const int col = jj * 512 + lane * 8;
        u32x4 R[TOKB + 4];
#pragma unroll
        for (int t = 0; t < TOKB + 4; ++t) { const int r = b0 - 2 + t; const bool ok = !MASKED || (r >= 0 && r < MTOT);
            R[t] = (u32x4){0u, 0u, 0u, 0u}; if (ok) R[t] = *(const u32x4*)(P + (size_t)r * NINP + col); }
        f32x4 cwr[5][2];
#pragma unroll
        for (int i = 0; i < 5; ++i) { cwr[i][0] = *(const f32x4*)(cw + i * GQKV + col); cwr[i][1] = *(const f32x4*)(cw + i * GQKV + col + 4); }
#pragma unroll
        for (int rr = 0; rr < TOKB; ++rr) {
            if (rr < nrow) { const int row = b0 + rr;
                float a[8];
#pragma unroll
                for (int q = 0; q < 8; ++q) a[q] = 0.f;
#pragma unroll
                for (int i = 0; i < 5; ++i) { const f32x4 w0 = cwr[i][0], w1 = cwr[i][1]; u32x4 p = R[rr + i];
                    if (MASKED) { const int tr = row + i - 2; const bool v = tr >= 0 && tr < MTOT && tok_seg(tr < 0 ? 0 : (tr < MTOT ? tr : MTOT - 1)) == tok_seg(row); if (!v) p = (u32x4){0u, 0u, 0u, 0u}; }
                    a[0] += bf_lo(p.x) * w0.x; a[1] += bf_hi(p.x) * w0.y; a[2] += bf_lo(p.y) * w0.z; a[3] += bf_hi(p.y) * w0.w;
                    a[4] += bf_lo(p.z) * w1.x; a[5] += bf_hi(p.z) * w1.y; a[6] += bf_lo(p.w) * w1.z; a[7] += bf_hi(p.w) * w1.w; }
                float ss = 0.f;
#pragma unroll
                for (int q = 0; q < 8; ++q) { a[q] = silu_f(a[q]); ss += a[q] * a[q]; }
                if (jj < 4) { ss += __shfl_xor(ss, 1); ss += __shfl_xor(ss, 2); ss += __shfl_xor(ss, 4); ss += __shfl_xor(ss, 8);
                    float sc = __builtin_amdgcn_rsqf(ss + 1e-6f); if (jj < 2) sc *= 0.08838834764831845f;
#pragma unroll
                    for (int q = 0; q < 8; ++q) a[q] *= sc; }
                *(u32x4*)(QKVb + (size_t)row * GQKV + col) = (u32x4){pk(a[0], a[1]), pk(a[2], a[3]), pk(a[4], a[5]), pk(a[6], a[7])}; }
        }
    }
}
__device__ __forceinline__ void p3a_tokens(Frame& F) {
    const bf16_t* P = WSP(const bf16_t, WS_P); bf16_t* QKVb = WSP(bf16_t, WS_QKVB); float* GBf = WSP(float, WS_GBF);
    const float* cw = F.in[I_CONVQKV];
    int tz_ = threadIdx.x; asm volatile("" : "+v"(tz_));
    const int lane_ = tz_ & 63, wave_ = __builtin_amdgcn_readfirstlane(tz_ >> 6);
    for (int blk = F.bid * 8 + wave_; blk * TOKB < MTOT; blk += F.G * 8) {
        const int b0 = blk * TOKB, nrow = (b0 + TOKB <= MTOT) ? TOKB : MTOT - b0;
        const bool clean = b0 >= 2 && b0 + TOKB + 1 < MTOT && tok_seg(b0 - 2) == tok_seg(b0 + TOKB + 1);
        if (clean) tok_block<false>(P, QKVb, cw, b0, nrow, lane_); else tok_block<true>(P, QKVb, cw, b0, nrow, lane_);
        if (lane_ < 32) { const int i = lane_ & 15; float gv[TOKB];
#pragma unroll
            for (int rr = 0; rr < TOKB; ++rr) gv[rr] = (rr < nrow) ? bf2f(P[(size_t)(b0 + rr) * NINP + (lane_ < 16 ? COL_A : COL_B) + i]) : 0.f;
            const float al = -__expf(F.in[I_ALOG][i]), dt = F.in[I_DTB][i];
#pragma unroll
            for (int rr = 0; rr < TOKB; ++rr) if (rr < nrow) { const float v = gv[rr]; GBf[(size_t)(b0 + rr) * 32 + lane_] = (lane_ < 16) ? al * softplus_f(v + dt) : sigmoid_f(v); } }
    }
}
constexpr int PL_QS = 0, PL_KS = 17408, PL_KBG = 34816, PL_VB = 53248, PL_AM = 71680, PL_QKM = 89088, PL_TB = 106496, PL_EGC = 115712, PL_EKD = 115968, PL_TF = 116224, PL_GC = 133632, PL_BETA = 133888;
constexpr int QP = 136, TP = 72, FP = 68;
#define MFMA4F(a, b, c) __builtin_amdgcn_mfma_f32_16x16x4f32((a), (b), (c), 0, 0, 0)
__device__ __forceinline__ void p3_prep(Frame& F) {
    const bf16_t* QKVb = WSP(const bf16_t, WS_QKVB); const float* GBf = WSP(const float, WS_GBF);
    LAS bf16_t* Qs = (LAS bf16_t*)(F.lds + PL_QS); LAS bf16_t* Ks = (LAS bf16_t*)(F.lds + PL_KS); LAS bf16_t* KbgT = (LAS bf16_t*)(F.lds + PL_KBG); LAS bf16_t* VbT = (LAS bf16_t*)(F.lds + PL_VB);
    LAS float* Am = (LAS float*)(F.lds + PL_AM); LAS float* QKm = (LAS float*)(F.lds + PL_QKM); LAS bf16_t* Tb = (LAS bf16_t*)(F.lds + PL_TB); LAS float* Tf = (LAS float*)(F.lds + PL_TF);
    LAS float* egc_s = (LAS float*)(F.lds + PL_EGC); LAS float* ekd_s = (LAS float*)(F.lds + PL_EKD); LAS float* gc_s = (LAS float*)(F.lds + PL_GC); LAS float* beta_s = (LAS float*)(F.lds + PL_BETA);
    LAS bf16_t* Ws = Qs; LAS bf16_t* Us = Ks;
    int tz = threadIdx.x; asm volatile("" : "+v"(tz));
    const int tid = tz, lane = tz & 63, w = __builtin_amdgcn_readfirstlane(tz >> 6), l15 = lane & 15, l4 = lane >> 4, r31 = lane & 31, hh = lane >> 5;
    u32x4 pre[3][2]; float pg = 0.f, pb = 0.f;
#define PREP_LOAD(uid_) do { const int _dir = (uid_) & 1, _h = ((uid_) >> 1) & 7, _cb = (uid_) >> 4, _cidx = _cb % NCHUNK, _b = _cb / NCHUNK; int _rb, _sb, _ln; unit_rows(_b, _cidx, _rb, _sb, _ln); \
        _Pragma("unroll") for (int _p = 0; _p < 3; ++_p) _Pragma("unroll") for (int _hf = 0; _hf < 2; ++_hf) { const int _r = 2 * (tid >> 4) + _hf; \
            pre[_p][_hf] = *(const u32x4*)(QKVb + (size_t)(_rb + (_dir ? 63 - _r : _r)) * GQKV + _p * GQK + _h * 128 + (tid & 15) * 8); } \
        { const size_t _pr = (size_t)(_rb + (_dir ? 63 - lane : lane)); pg = GBf[_pr * 32 + _dir * 8 + _h]; pb = GBf[_pr * 32 + 16 + _dir * 8 + _h]; } } while (0)
    if (F.bid < NUNITS) PREP_LOAD(F.bid);
    for (int uid = F.bid; uid < NUNITS; uid += F.G) {
        unsigned char* ub = F.ws + WS_PREP + (size_t)uid * UNIT_BYTES;
        float gc = pg; const float beta = pb;
#pragma unroll
        for (int off = 1; off < 64; off <<= 1) { const float t = __shfl_up(gc, off); if (lane >= off) gc += t; }
        const float glast = __shfl(gc, 63), egcv = __expf(gc);
        if (w == 0) { egc_s[lane] = egcv; ekd_s[lane] = __expf(glast - gc); gc_s[lane] = gc; beta_s[lane] = beta; }
        { const int r0 = 2 * (tid >> 4), c16 = tid & 15;
          const float br0 = __shfl(beta, r0), br1 = __shfl(beta, r0 + 1), sk0 = br0 * __shfl(egcv, r0), sk1 = br1 * __shfl(egcv, r0 + 1);
          const int rs = (((r0 >> 3) ^ (c16 >> 1)) << 3) + (r0 & 7);
          *(LAS u32x4*)(Qs + r0 * QP + c16 * 8) = pre[0][0]; *(LAS u32x4*)(Qs + (r0 + 1) * QP + c16 * 8) = pre[0][1];
          *(LAS u32x4*)(Ks + r0 * QP + c16 * 8) = pre[1][0]; *(LAS u32x4*)(Ks + (r0 + 1) * QP + c16 * 8) = pre[1][1];
#pragma unroll
          for (int e = 0; e < 4; ++e) { const unsigned k0 = pre[1][0][e], k1 = pre[1][1][e], v0 = pre[2][0][e], v1 = pre[2][1][e];
              *(LAS unsigned*)(KbgT + (c16 * 8 + 2 * e) * TP + rs) = pk(bf_lo(k0) * sk0, bf_lo(k1) * sk1); *(LAS unsigned*)(KbgT + (c16 * 8 + 2 * e + 1) * TP + rs) = pk(bf_hi(k0) * sk0, bf_hi(k1) * sk1);
              *(LAS unsigned*)(VbT + (c16 * 8 + 2 * e) * TP + rs) = pk(bf_lo(v0) * br0, bf_lo(v1) * br1); *(LAS unsigned*)(VbT + (c16 * 8 + 2 * e + 1) * TP + rs) = pk(bf_hi(v0) * br0, bf_hi(v1) * br1); } }
        if (uid + F.G < NUNITS) PREP_LOAD(uid + F.G);
        __syncthreads();
        { const bool isq = w >= 4; const int rt = w & 3; const LAS bf16_t* X = isq ? Qs : Ks; LAS float* OUT = isq ? QKm : Am;
          bf16x8 af[4], bfr[4][4];
#pragma unroll
          for (int ks = 0; ks < 4; ++ks) af[ks] = *(const LAS bf16x8*)(X + (rt * 16 + l15) * QP + 32 * ks + 8 * l4);
#pragma unroll
          for (int st = 0; st < 4; ++st)
#pragma unroll
              for (int ks = 0; ks < 4; ++ks) bfr[st][ks] = *(const LAS bf16x8*)(Ks + (st * 16 + l15) * QP + 32 * ks + 8 * l4);
          const f32x4 gcr4 = *(const LAS f32x4*)(gc_s + rt * 16 + 4 * l4), br4 = *(const LAS f32x4*)(beta_s + rt * 16 + 4 * l4);
          float gcs4[4];
#pragma unroll
          for (int st = 0; st < 4; ++st) gcs4[st] = gc_s[st * 16 + l15];
#pragma unroll
          for (int st = 0; st < 4; ++st) { f32x4 acc = {0.f, 0.f, 0.f, 0.f};
#pragma unroll
              for (int ks = 0; ks < 4; ++ks) acc = MFMA16(af[ks], bfr[st][ks], acc);
              const int sidx = st * 16 + l15; const float gcs = gcs4[st];
#pragma unroll
              for (int reg = 0; reg < 4; ++reg) { const int ridx = rt * 16 + 4 * l4 + reg; const float gcr = gcr4[reg], br = br4[reg];
                  const float e = __expf(fminf(gcr - gcs, 0.f));
                  const float val = isq ? (ridx >= sidx ? acc[reg] * e : 0.f) : (ridx > sidx ? br * acc[reg] * e : 0.f);
                  OUT[ridx * FP + sidx] = val; } } }
#pragma unroll
        for (int q2 = 0; q2 < 2; ++q2) { const int frag = w + 8 * q2;
            { const int mt = frag >> 3, kt = (frag >> 1) & 3, s2 = frag & 1, row = 32 * mt + r31, col0 = 32 * kt + 16 * s2 + 4 * hh; const float e = egc_s[row];
              const u32x2 lo = *(const LAS u32x2*)(Qs + row * QP + col0), hi = *(const LAS u32x2*)(Qs + row * QP + col0 + 8);
              *(u32x4*)(ub + UO_QD + frag * 1024 + lane * 16) = (u32x4){pk(bf_lo(lo.x) * e, bf_hi(lo.x) * e), pk(bf_lo(lo.y) * e, bf_hi(lo.y) * e), pk(bf_lo(hi.x) * e, bf_hi(hi.x) * e), pk(bf_lo(hi.y) * e, bf_hi(hi.y) * e)}; }
            { const int kt = frag >> 2, ct = (frag >> 1) & 1, s2 = frag & 1; float v[8];
#pragma unroll
              for (int j = 0; j < 8; ++j) { const int tok = 32 * ct + 16 * s2 + 8 * (j >> 2) + 4 * hh + (j & 3); v[j] = bf2f(Ks[tok * QP + 32 * kt + r31]); }
              { const int t0 = 32 * ct + 16 * s2 + 4 * hh; const f32x4 e0 = *(const LAS f32x4*)(ekd_s + t0), e1 = *(const LAS f32x4*)(ekd_s + t0 + 8);
                v[0] *= e0.x; v[1] *= e0.y; v[2] *= e0.z; v[3] *= e0.w; v[4] *= e1.x; v[5] *= e1.y; v[6] *= e1.z; v[7] *= e1.w; }
              *(u32x4*)(ub + UO_KDT + frag * 1024 + lane * 16) = (u32x4){pk(v[0], v[1]), pk(v[2], v[3]), pk(v[4], v[5]), pk(v[6], v[7])}; } }
        __syncthreads();
        if (w < 4) { float t[16];
            f32x4 ar[4];
#pragma unroll
            for (int c4 = 0; c4 < 4; ++c4) ar[c4] = *(const LAS f32x4*)(Am + (16 * w + l15) * FP + 16 * w + 4 * c4);
#pragma unroll
            for (int i = 0; i < 16; ++i) { float a0 = (i == lane) ? 1.f : 0.f;
#pragma unroll
                for (int m = 0; m < i; ++m) { const float av = ar[m >> 2][m & 3];
                    a0 -= __builtin_bit_cast(float, __builtin_amdgcn_readlane(__builtin_bit_cast(int, av), i)) * t[m]; }
                t[i] = a0; }
            if (lane < 16) {
#pragma unroll
                for (int i = 0; i < 16; ++i) Tf[(16 * w + i) * FP + 16 * w + lane] = t[i]; } }
        __syncthreads();
#pragma unroll
        for (int lv = 1; lv < 4; ++lv) {
            if (w < 4 - lv) { const int bj = w, bi = w + lv;
                f32x4 aop[3]; float bop[3][4];
#pragma unroll
                for (int t = 0; t < lv; ++t) { const int bk = bj + t; aop[t] = *(const LAS f32x4*)(Am + (16 * bi + l15) * FP + 16 * bk + 4 * l4);
#pragma unroll
                    for (int ks = 0; ks < 4; ++ks) bop[t][ks] = Tf[(16 * bk + 4 * l4 + ks) * FP + 16 * bj + l15]; }
                const f32x4 tdg = *(const LAS f32x4*)(Tf + (16 * bi + l15) * FP + 16 * bi + 4 * l4);
                f32x4 x = {0.f, 0.f, 0.f, 0.f};
#pragma unroll
                for (int t = 0; t < lv; ++t)
#pragma unroll
                    for (int ks = 0; ks < 4; ++ks) x = MFMA4F(aop[t][ks], bop[t][ks], x);
                f32x4 y = {0.f, 0.f, 0.f, 0.f};
#pragma unroll
                for (int ks = 0; ks < 4; ++ks) y = MFMA4F(tdg[ks], x[ks], y);
#pragma unroll
                for (int reg = 0; reg < 4; ++reg) Tf[(16 * bi + 4 * l4 + reg) * FP + 16 * bj + l15] = -y[reg]; }
            __syncthreads();
        }
#pragma unroll
        for (int q = 0; q < 4; ++q) { const int idx = tid + 512 * q, i = idx >> 5, j = (idx & 31) * 2; const f32x2 tv = *(const LAS f32x2*)(Tf + i * FP + j);
            *(LAS unsigned*)(Tb + i * TP + j) = pk(j <= i ? tv.x : 0.f, j + 1 <= i ? tv.y : 0.f); }
        __syncthreads();
        { bf16x8 bu[2], bw[2];
#pragma unroll
          for (int ks = 0; ks < 2; ++ks) { const int ch = 8 * ((4 * ks + l4) ^ w);
              bu[ks] = *(const LAS bf16x8*)(VbT + (w * 16 + l15) * TP + ch); bw[ks] = *(const LAS bf16x8*)(KbgT + (w * 16 + l15) * TP + ch); }
#pragma unroll
          for (int rt = 0; rt < 4; ++rt) { const bf16x8 a0 = *(const LAS bf16x8*)(Tb + (rt * 16 + l15) * TP + 8 * l4), a1 = *(const LAS bf16x8*)(Tb + (rt * 16 + l15) * TP + 32 + 8 * l4);
              f32x4 au = {0.f, 0.f, 0.f, 0.f}, aw = {0.f, 0.f, 0.f, 0.f};
              au = MFMA16(bu[0], a0, au); au = MFMA16(bu[1], a1, au); aw = MFMA16(bw[0], a0, aw); aw = MFMA16(bw[1], a1, aw);
              { const int r = rt * 16 + l15, f0 = w * 16 + 4 * l4;
                *(LAS u32x2*)(Us + r * QP + f0) = (u32x2){pk(au[0], au[1]), pk(au[2], au[3])}; *(LAS u32x2*)(Ws + r * QP + f0) = (u32x2){pk(-aw[0], -aw[1]), pk(-aw[2], -aw[3])}; } } }
        __syncthreads();
#pragma unroll
        for (int q2 = 0; q2 < 2; ++q2) { const int frag = w + 8 * q2, mt = frag >> 3, kt = (frag >> 1) & 3, s2 = frag & 1, row = 32 * mt + r31, col0 = 32 * kt + 16 * s2 + 4 * hh;
            const u32x2 lo = *(const LAS u32x2*)(Ws + row * QP + col0), hi = *(const LAS u32x2*)(Ws + row * QP + col0 + 8);
            *(u32x4*)(ub + UO_NW + frag * 1024 + lane * 16) = (u32x4){lo.x, lo.y, hi.x, hi.y}; }
        { const int mt = w >> 2, nt = w & 3; unsigned o[8];
#pragma unroll
          for (int p = 0; p < 8; ++p) { const int reg0 = 2 * p, row0 = 32 * mt + (reg0 & 3) + 8 * (reg0 >> 2) + 4 * hh;
              o[p] = (unsigned)Us[row0 * QP + 32 * nt + r31] | ((unsigned)Us[(row0 + 1) * QP + 32 * nt + r31] << 16); }
          *(u32x4*)(ub + UO_U + w * 2048 + lane * 32) = (u32x4){o[0], o[1], o[2], o[3]}; *(u32x4*)(ub + UO_U + w * 2048 + lane * 32 + 16) = (u32x4){o[4], o[5], o[6], o[7]}; }
        { const int mt = w >> 2, ct = (w >> 1) & 1, s2 = w & 1, row = 32 * mt + r31, col0 = 32 * ct + 16 * s2 + 4 * hh;
          const f32x4 x0 = *(const LAS f32x4*)(QKm + row * FP + col0), x1 = *(const LAS f32x4*)(QKm + row * FP + col0 + 8);
          *(u32x4*)(ub + UO_QK + w * 1024 + lane * 16) = (u32x4){pk(x0.x, x0.y), pk(x0.z, x0.w), pk(x1.x, x1.y), pk(x1.z, x1.w)}; }
        if (tid == 0) *(float*)(ub + UO_DL) = __expf(glast);
        __syncthreads();
    }
#undef PREP_LOAD
}

__device__ __forceinline__ bf16x8 pack_step(const f32x16& x, int s) { return __builtin_bit_cast(bf16x8, ((u32x4){pk(x[8 * s], x[8 * s + 1]), pk(x[8 * s + 2], x[8 * s + 3]), pk(x[8 * s + 4], x[8 * s + 5]), pk(x[8 * s + 6], x[8 * s + 7])})); }
__device__ __forceinline__ void p4_scan(Frame& F) {
    constexpr int NSCAN = NBATCH * NH * 2;
    if (F.bid >= NSCAN) {
        const int nconv = (F.G - NSCAN) < NCONV_SCAN ? (F.G - NSCAN) : NCONV_SCAN;
        if (F.bid - NSCAN < nconv) convert_experts(F, (F.bid - NSCAN) * 8 + F.wave, nconv * 8, ti_early(F.G), TI_EXP);
        return;
    }
    const int b = F.bid >> 4, h = (F.bid >> 1) & 7, dir = F.bid & 1, lane = F.lane;
    const unsigned char* prep = F.ws + WS_PREP;
#define STEP_CIDX(n) (dir ? ((n) < CTXL / 64 ? CTXL / 64 - 1 - (n) : NCHUNK + CTXL / 64 - 1 - (n)) : (n))
#define STEP_UNIT(n) (prep + (size_t)((((b * NCHUNK + STEP_CIDX(n)) * NH + h) * 2) + dir) * UNIT_BYTES)
    const int wv = F.wave;
#define ISSUE(n) do { const unsigned char* _ub = STEP_UNIT(n); LAS unsigned char* _lb = F.lds + ((n) & 1) * UNIT_DMA; _Pragma("unroll") for (int _p = 0; _p < 10; ++_p) \
            if (_p * 8 + wv < UNIT_DMA / 1024) __builtin_amdgcn_global_load_lds((const unsigned*)(_ub + (_p * 8 + wv) * 1024 + lane * 16), (LAS unsigned*)(_lb + (_p * 8 + wv) * 1024), 16, 0, 0); } while (0)
    ISSUE(0);
    if (F.wave >= 4) {
        for (int n = 0; n < NCHUNK; ++n) { VM_WAIT(); __builtin_amdgcn_s_barrier(); asm volatile("" ::: "memory"); if (n + 1 < NCHUNK) ISSUE(n + 1); }
        VM_WAIT();
        return;
    }
    const int nt = F.wave, c = lane & 31, hh = lane >> 5;
    bf16_t* OGb = WSP(bf16_t, WS_OGB) + (size_t)dir * ML * 1024;
    f32x16 S[4];
#pragma unroll
    for (int kt = 0; kt < 4; ++kt)
#pragma unroll
        for (int i = 0; i < 16; ++i) S[kt][i] = 0.f;
#pragma unroll 1
    for (int n = 0; n < NCHUNK; ++n) {
        VM_WAIT(); __builtin_amdgcn_s_barrier(); asm volatile("" ::: "memory");
        if (n + 1 < NCHUNK) ISSUE(n + 1);
        const LAS unsigned char* lb = F.lds + (n & 1) * UNIT_DMA;
        const float dlc = *(const LAS float*)(lb + UO_DL);
        u32x4 ucur[2][2];
#pragma unroll
        for (int mt = 0; mt < 2; ++mt) { ucur[mt][0] = *(const LAS u32x4*)(lb + UO_U + (mt * 4 + nt) * 2048 + lane * 32); ucur[mt][1] = *(const LAS u32x4*)(lb + UO_U + (mt * 4 + nt) * 2048 + lane * 32 + 16); }
#define FRAG(off, idx) (*(const LAS bf16x8*)(lb + (off) + (idx) * 1024 + lane * 16))
        f32x16 VN[2], O[2];
#pragma unroll
        for (int mt = 0; mt < 2; ++mt) {
#pragma unroll
            for (int p = 0; p < 4; ++p) { VN[mt][2 * p] = bf_lo(ucur[mt][0][p]); VN[mt][2 * p + 1] = bf_hi(ucur[mt][0][p]); VN[mt][8 + 2 * p] = bf_lo(ucur[mt][1][p]); VN[mt][8 + 2 * p + 1] = bf_hi(ucur[mt][1][p]); }
#pragma unroll
            for (int i = 0; i < 16; ++i) O[mt][i] = 0.f; }
#pragma unroll
        for (int kt = 0; kt < 4; ++kt) { const bf16x8 sb0 = pack_step(S[kt], 0), sb1 = pack_step(S[kt], 1);
#pragma unroll
            for (int mt = 0; mt < 2; ++mt) { const int fi = (mt * 4 + kt) * 2;
                VN[mt] = MFMA32(FRAG(UO_NW, fi), sb0, VN[mt]); VN[mt] = MFMA32(FRAG(UO_NW, fi + 1), sb1, VN[mt]);
                O[mt] = MFMA32(FRAG(UO_QD, fi), sb0, O[mt]); O[mt] = MFMA32(FRAG(UO_QD, fi + 1), sb1, O[mt]); } }
        bf16x8 vb[2][2];
#pragma unroll
        for (int ct = 0; ct < 2; ++ct) { vb[ct][0] = pack_step(VN[ct], 0); vb[ct][1] = pack_step(VN[ct], 1); }
#pragma unroll
        for (int mt = 0; mt < 2; ++mt)
#pragma unroll
            for (int ct = 0; ct < 2; ++ct) { const int fi = (mt * 2 + ct) * 2; O[mt] = MFMA32(FRAG(UO_QK, fi), vb[ct][0], O[mt]); O[mt] = MFMA32(FRAG(UO_QK, fi + 1), vb[ct][1], O[mt]); }
#pragma unroll
        for (int kt = 0; kt < 4; ++kt) {
#pragma unroll
            for (int i = 0; i < 16; ++i) S[kt][i] *= dlc;
#pragma unroll
            for (int ct = 0; ct < 2; ++ct) { const int fi = (kt * 2 + ct) * 2; S[kt] = MFMA32(FRAG(UO_KDT, fi), vb[ct][0], S[kt]); S[kt] = MFMA32(FRAG(UO_KDT, fi + 1), vb[ct][1], S[kt]); } }
#undef FRAG
        const int cidx = STEP_CIDX(n);
        if (cidx >= CTXL / 64) { const int rowbase = b * SEQ + (cidx - CTXL / 64) * 64;
#pragma unroll
            for (int mt = 0; mt < 2; ++mt)
#pragma unroll
                for (int reg = 0; reg < 16; ++reg) { const int row = 32 * mt + (reg & 3) + 8 * (reg >> 2) + 4 * hh, prow = rowbase + (dir ? 63 - row : row);
                    OGb[(size_t)prow * 1024 + h * 128 + 32 * nt + c] = f2bf(O[mt][reg]); } }
    }
    VM_WAIT();
#undef ISSUE
#undef STEP_CIDX
#undef STEP_UNIT
}

struct MixRow { u32x4 oa[2], ob[2], zz[2], sb[2], cv[3][2], xv[3][2]; };
__device__ __forceinline__ MixRow mix_load(const bf16_t* P, const bf16_t* OGb, int row, int f0, int c0, bool horiz) {
    MixRow m; const int t = row % SEQ, gr = t / 64, gc = t % 64, dlt = horiz ? 1 : 64;
    const bool hasp = horiz ? (gc > 0) : (gr > 0), hasn = horiz ? (gc < 63) : (gr < SEQ / 64 - 1);
#pragma unroll
    for (int q = 0; q < 2; ++q) { m.oa[q] = *(const u32x4*)(OGb + (size_t)row * 1024 + f0 + 8 * q); m.ob[q] = *(const u32x4*)(OGb + (size_t)ML * 1024 + (size_t)row * 1024 + f0 + 8 * q);
        m.zz[q] = *(const u32x4*)(P + (size_t)row * NINP + COL_Z + f0 + 8 * q); m.sb[q] = *(const u32x4*)(P + (size_t)row * NINP + COL_SB + c0 + 8 * q); }
#pragma unroll
    for (int i = 0; i < 3; ++i) { const bool ok = i == 1 || (i == 0 ? hasp : hasn); const size_t rr = (size_t)(row + (ok ? (i - 1) * dlt : 0));
#pragma unroll
        for (int q = 0; q < 2; ++q) { m.cv[i][q] = *(const u32x4*)(P + rr * NINP + COL_SC + c0 + 8 * q); m.xv[i][q] = *(const u32x4*)(P + rr * NINP + COL_SX + c0 + 8 * q);
            if (!ok) m.cv[i][q] = (u32x4){0u, 0u, 0u, 0u}; } }
    return m;
}
__device__ __forceinline__ void p5_mix_out(Frame& F) {
    const bf16_t* P = WSP(const bf16_t, WS_P); const bf16_t* OGb = WSP(const bf16_t, WS_OGB); bf16_t* Y = WSP(bf16_t, WS_Y);
    const float* nw = F.in[I_GNW]; const float* cs = F.in[I_CONVSC];
    const int gw = F.bid * 8 + F.wave, NGW = F.G * 8;
    const int f0 = F.lane * 16, c0 = F.lane * 16; const bool horiz = c0 < 512;
    LAS float* nwL = (LAS float*)F.lds; LAS float* csL = nwL + 128;
    if (F.tid < 128) nwL[F.tid] = nw[F.tid];
    for (int i = F.tid; i < 3 * 1024; i += 512) csL[i] = cs[i];
    __syncthreads();
    if (gw >= ML) return;
    MixRow nx = mix_load(P, OGb, gw, f0, c0, horiz);
    for (int row = gw; row < ML; row += NGW) {
        const MixRow m = nx;
        if (row + NGW < ML) nx = mix_load(P, OGb, row + NGW, f0, c0, horiz);
        { float o[16]; float ss = 0.f;
#pragma unroll
          for (int q = 0; q < 2; ++q)
#pragma unroll
              for (int e = 0; e < 4; ++e) { const float s0 = bf_lo(m.oa[q][e]) + bf_lo(m.ob[q][e]), s1 = bf_hi(m.oa[q][e]) + bf_hi(m.ob[q][e]); o[8 * q + 2 * e] = s0; o[8 * q + 2 * e + 1] = s1; ss += s0 * s0 + s1 * s1; }
          ss += __shfl_xor(ss, 1); ss += __shfl_xor(ss, 2); ss += __shfl_xor(ss, 4);
          const float r = __builtin_amdgcn_rsqf(ss * (1.f / 128.f) + RMS_EPS);
          unsigned ow[8];
#pragma unroll
          for (int q = 0; q < 8; ++q) { const int f = (f0 + 2 * q) & 127; const unsigned zw = m.zz[q >> 2][q & 3];
              const float y0 = o[2 * q] * r * nwL[f] * silu_f(bf_lo(zw)), y1 = o[2 * q + 1] * r * nwL[f + 1] * silu_f(bf_hi(zw)); ow[q] = cvt_pk_bf16(y0, y1); }
          *(u32x4*)(Y + (size_t)row * D + f0) = (u32x4){ow[0], ow[1], ow[2], ow[3]}; *(u32x4*)(Y + (size_t)row * D + f0 + 8) = (u32x4){ow[4], ow[5], ow[6], ow[7]}; }
        { float acc[16];
#pragma unroll
          for (int q = 0; q < 16; ++q) acc[q] = 0.f;
#pragma unroll
          for (int i = 0; i < 3; ++i)
#pragma unroll
              for (int hh = 0; hh < 2; ++hh)
#pragma unroll
                  for (int q = 0; q < 4; ++q) { const int ch = c0 + 8 * hh + 2 * q; const unsigned cw = m.cv[i][hh][q], xw = m.xv[i][hh][q];
                      acc[8 * hh + 2 * q] += bf_lo(cw) * bf_lo(xw) * csL[i * 1024 + ch]; acc[8 * hh + 2 * q + 1] += bf_hi(cw) * bf_hi(xw) * csL[i * 1024 + ch + 1]; }
          unsigned ow[8];
#pragma unroll
          for (int q = 0; q < 8; ++q) { const unsigned bw = m.sb[q >> 2][q & 3]; ow[q] = cvt_pk_bf16(bf_lo(bw) * acc[2 * q], bf_hi(bw) * acc[2 * q + 1]); }
          *(u32x4*)(Y + (size_t)row * D + 1024 + c0) = (u32x4){ow[0], ow[1], ow[2], ow[3]}; *(u32x4*)(Y + (size_t)row * D + 1024 + c0 + 8) = (u32x4){ow[4], ow[5], ow[6], ow[7]}; }
    }
}

struct OutProj {
    static constexpr bool PERM = true, GATHER = false, FP8 = false, BBLK = false; typedef NoPre Pre;
    __device__ __forceinline__ Pre prefetch(const Unit&, int, int, int, int) const { return Pre{}; }
    __device__ __forceinline__ void bias_issue(const Unit&, LAS unsigned char*, int, int) const {}
    __device__ __forceinline__ Pre bias_read(const LAS unsigned char*, int, int, const Pre& p) const { return p; }
    int K; const char* A; const char* Bt; bf16_t* V; const float* x; const f32x2* st0; const float* g0; const float* b0; const float* modf; int G, c;
    __device__ __forceinline__ bool next(int i, Unit& u) const { const int L = i * G + c; if (L >= (ML / 256) * (D / 256)) return false; pg8::tile_order(L, ML / 256, D / 256, u.pm, u.pn); u.e = 0; return true; }
    __device__ __forceinline__ const char* bptr(const Unit& u, int half) const { return Bt + (size_t)(u.pn * 256 + half * 128) * K * 2; }
    __device__ __forceinline__ unsigned arow_i(int, const Unit& u, int r) const { return (unsigned)(u.pm * 256 + r); }
    __device__ __forceinline__ void epi(const f32x4 (&acc)[2][2][4][2], const Unit& u, int wr, int wc, int fr, int fq, const Pre&) const {
        const int row0 = u.pm * 256 + wr * 64 + fr, col0 = u.pn * 256 + wc * 32 + 8 * fq;
        const float* gt1 = modf + (size_t)(u.pm * 256 / SEQ) * (6 * D) + 2 * D;
        constexpr int XW = 4;
        f32x4 XA[16], XB[16]; f32x2 SS[16]; f32x4 PG[2][2], PB[2][2], PT[2][2];
#define OP_ROW(it_) (row0 + (((it_) >> 2) & 1) * 128 + ((it_) & 3) * 16)
#define OP_COL(it_) (col0 + ((it_) >> 3) * 128)
#define OP_LOAD(it_) do { SS[it_] = st0[OP_ROW(it_)]; XA[it_] = *(const f32x4*)(x + (size_t)OP_ROW(it_) * D + OP_COL(it_)); XB[it_] = *(const f32x4*)(x + (size_t)OP_ROW(it_) * D + OP_COL(it_) + 4); } while (0)
#define OP_PARAMS(bj_) do { const int _c = col0 + (bj_) * 128; PG[bj_][0] = *(const f32x4*)(g0 + _c); PG[bj_][1] = *(const f32x4*)(g0 + _c + 4); PB[bj_][0] = *(const f32x4*)(b0 + _c); PB[bj_][1] = *(const f32x4*)(b0 + _c + 4); \
            PT[bj_][0] = *(const f32x4*)(gt1 + _c); PT[bj_][1] = *(const f32x4*)(gt1 + _c + 4); } while (0)
        OP_PARAMS(0);
#pragma unroll
        for (int it = 0; it < XW; ++it) OP_LOAD(it);
#pragma unroll
        for (int it = 0; it < 16; ++it) { const int bj = it >> 3, ai = (it >> 2) & 1, m = it & 3; const f32x2 sv = SS[it];
            const f32x4 va = ((XA[it] - sv.x) * sv.y * PG[bj][0] + PB[bj][0]) * DN_ALPHA + PT[bj][0] * acc[ai][bj][m][0], vb = ((XB[it] - sv.x) * sv.y * PG[bj][1] + PB[bj][1]) * DN_ALPHA + PT[bj][1] * acc[ai][bj][m][1];
            *(u32x4*)(V + (size_t)OP_ROW(it) * D + OP_COL(it)) = (u32x4){cvt_pk_bf16(va[0], va[1]), cvt_pk_bf16(va[2], va[3]), cvt_pk_bf16(vb[0], vb[1]), cvt_pk_bf16(vb[2], vb[3])};
            if (it == 3) OP_PARAMS(1);
            if (it + XW < 16) OP_LOAD(it + XW); }
#undef OP_ROW
#undef OP_COL
#undef OP_LOAD
#undef OP_PARAMS
    }
};

constexpr int UT_PITCH = D + 4;
__device__ __forceinline__ void p7_ln1_router(Frame& F) {
    int tz_ = threadIdx.x; asm volatile("" : "+v"(tz_));
    const int tid_ = tz_, lane_ = tz_ & 63, wave_ = __builtin_amdgcn_readfirstlane(tz_ >> 6);
    LAS float* uT = (LAS float*)F.lds;
    LAS float* part = uT + 16 * UT_PITCH;
    LAS float* logit = part + 8 * 16 * 32;
    const bf16_t* V = WSP(const bf16_t, WS_V); f32x2* st1 = WSP(f32x2, WS_STAT1); const float* modf = WSP(const float, WS_MODF); unsigned char* U8 = WSP(unsigned char, WS_U);
    const float* g1 = F.in[I_LN1G]; const float* b1 = F.in[I_LN1B]; const float* wrt = F.in[I_WR]; const float* brt = F.in[I_BR];
    int* toke = WSP(int, WS_TOKE); int* tokp = WSP(int, WS_TOKP); float* tokg = WSP(float, WS_TOKG); int* list = WSP(int, WS_LIST);
    const int r16 = lane_ & 15, kk = lane_ >> 4;
    u32x2 vw[2][8];
#define LN1_LOAD(tile_) do { _Pragma("unroll") for (int _rr = 0; _rr < 2; ++_rr) { const u32x2* _xr = (const u32x2*)(V + (size_t)((tile_) * 16 + wave_ * 2 + _rr) * D) + lane_; \
            _Pragma("unroll") for (int _j = 0; _j < 8; ++_j) vw[_rr][_j] = _xr[64 * _j]; } } while (0)
    if (F.bid < ML / 16) LN1_LOAD(F.bid);
    for (int tile = F.bid; tile < ML / 16; tile += F.G) {
        const int rbase = tile * 16; const int bidx = rbase / SEQ; const float* sh2 = modf + (size_t)bidx * (6 * D) + 3 * D; const float* sc2 = sh2 + D;
        f32x4 pa[8], pc[8];
        unsigned dofs = 4u * (unsigned)lane_; asm volatile("" : "+v"(dofs));
#pragma unroll
        for (int j = 0; j < 8; ++j) { const f32x4 sc = *(const f32x4*)((sc2 + 256 * j) + dofs) + 1.f;
            pa[j] = *(const f32x4*)((g1 + 256 * j) + dofs) * sc; pc[j] = *(const f32x4*)((b1 + 256 * j) + dofs) * sc + *(const f32x4*)((sh2 + 256 * j) + dofs);
            if (j == 3) asm volatile("" ::: "memory"); }
#pragma unroll
        for (int rr = 0; rr < 2; ++rr) {
            const int lr = wave_ * 2 + rr, row = rbase + lr;
            f32x4 x[8]; float s = 0.f;
#pragma unroll
            for (int j = 0; j < 8; ++j) { const u32x2 w = vw[rr][j]; x[j] = (f32x4){bf_lo(w.x), bf_hi(w.x), bf_lo(w.y), bf_hi(w.y)}; s += (x[j].x + x[j].y) + (x[j].z + x[j].w); }
            const float mean = wave_sum(s) * (1.f / D); float s2 = 0.f;
#pragma unroll
            for (int j = 0; j < 8; ++j) { x[j] = x[j] - mean; s2 += (x[j].x * x[j].x + x[j].y * x[j].y) + (x[j].z * x[j].z + x[j].w * x[j].w); }
            const float rstd = 1.f / sqrtf(wave_sum(s2) * (1.f / D) + LN_EPS);
            if (lane_ == 0) st1[row] = (f32x2){mean, rstd}; unsigned* uo = (unsigned*)(U8 + (size_t)row * D) + lane_;
#pragma unroll
            for (int j = 0; j < 8; ++j) { const int d = 4 * lane_ + 256 * j;
                const f32x4 u = (x[j] * rstd) * pa[j] + pc[j];
                uo[64 * j] = pk_fp8x4(u.x, u.y, u.z, u.w);
                *(LAS f32x4*)(uT + lr * UT_PITCH + d) = u; }
        }
        unsigned wlo = (unsigned)(4 * kk * NE + r16); asm volatile("" : "+v"(wlo));
        float wl[16][4][2]; asm volatile("" ::: "memory");
#define RW_LOAD(m_) do { _Pragma("unroll") for (int _j = 0; _j < 4; ++_j) _Pragma("unroll") for (int _nt = 0; _nt < 2; ++_nt) \
            wl[m_][_j][_nt] = (wrt + (256 * wave_ + 16 * (m_)) * NE)[wlo + (unsigned)(_j * NE + 16 * _nt)]; } while (0)
#pragma unroll
        for (int m = 0; m < 12; ++m) RW_LOAD(m);
        __syncthreads();
        f32x4 lacc[2] = {{0.f, 0.f, 0.f, 0.f}, {0.f, 0.f, 0.f, 0.f}};
#pragma unroll
        for (int m = 0; m < 16; ++m) { const f32x4 a = *(const LAS f32x4*)(uT + r16 * UT_PITCH + 256 * wave_ + 16 * m + 4 * kk);
#pragma unroll
            for (int j = 0; j < 4; ++j) { lacc[0] = __builtin_amdgcn_mfma_f32_16x16x4f32(a[j], wl[m][j][0], lacc[0], 0, 0, 0); lacc[1] = __builtin_amdgcn_mfma_f32_16x16x4f32(a[j], wl[m][j][1], lacc[1], 0, 0, 0); }
            if (m == 3) { __builtin_amdgcn_sched_barrier(0); RW_LOAD(12); RW_LOAD(13); RW_LOAD(14); RW_LOAD(15); __builtin_amdgcn_sched_barrier(0); } }
#undef RW_LOAD
#pragma unroll
        for (int nt = 0; nt < 2; ++nt)
#pragma unroll
            for (int q = 0; q < 4; ++q) part[(wave_ * 16 + 4 * kk + q) * 32 + 16 * nt + r16] = lacc[nt][q];
        __syncthreads();
        if (tile + F.G < ML / 16) LN1_LOAD(tile + F.G);
        { const int lr = tid_ >> 5, e = tid_ & 31; float s = brt[e];
#pragma unroll
          for (int w = 0; w < 8; ++w) s += part[(w * 16 + lr) * 32 + e];
          logit[lr * 32 + e] = s; }
        __syncthreads();
        if (tid_ < 16) { const int row = rbase + tid_; float lv[32];
#pragma unroll
            for (int e = 0; e < 32; ++e) lv[e] = logit[tid_ * 32 + e];
            float tv[4]; int ti[4];
#pragma unroll
            for (int s4 = 0; s4 < 4; ++s4) { float best = -3.0e38f; int bi = 0;
#pragma unroll
                for (int e = 0; e < 32; ++e) { const bool take = lv[e] > best; best = take ? lv[e] : best; bi = take ? e : bi; }
                tv[s4] = best; ti[s4] = bi;
#pragma unroll
                for (int e = 0; e < 32; ++e) lv[e] = (e == bi) ? -3.0e38f : lv[e]; }
            const float e0 = 1.f, e1 = __expf(tv[1] - tv[0]), e2 = __expf(tv[2] - tv[0]), e3 = __expf(tv[3] - tv[0]); const float inv = 1.f / (e0 + e1 + e2 + e3);
            const float gg[4] = {e0 * inv, e1 * inv, e2 * inv, e3 * inv};
            int pos[4];
#pragma unroll
            for (int s4 = 0; s4 < 4; ++s4) pos[s4] = (int)__hip_atomic_fetch_add(F.ctl + CW_CNT + 64 * ti[s4], 1u, __ATOMIC_RELAXED, __HIP_MEMORY_SCOPE_AGENT);
            *(i32x4*)(toke + row * 4) = (i32x4){ti[0], ti[1], ti[2], ti[3]}; *(f32x4*)(tokg + row * 4) = (f32x4){gg[0], gg[1], gg[2], gg[3]};
            *(i32x4*)(tokp + row * 4) = (i32x4){pos[0], pos[1], pos[2], pos[3]};
#pragma unroll
            for (int s4 = 0; s4 < 4; ++s4) list[(size_t)ti[s4] * ML + pos[s4]] = row; }
        __syncthreads();
    }
#undef LN1_LOAD
}

struct MoeTab { const LAS int* cnt; const LAS int* pstart; };
__device__ __forceinline__ void moe_tables(Frame& F) {
    LAS int* cnt = (LAS int*)(F.lds + TAB_OFF); LAS int* ps = cnt + 32;
    if (F.tid < 32) cnt[F.tid] = (int)__hip_atomic_load(F.ctl + CW_CNT + 64 * F.tid, __ATOMIC_RELAXED, __HIP_MEMORY_SCOPE_AGENT);
    __syncthreads();
    if (F.tid == 0) { int a = 0; for (int e = 0; e < 32; ++e) { ps[e] = a; a += (cnt[e] + 255) / 256 * 256; } ps[32] = a; }
    __syncthreads();
    if (F.tid < MAXTILES) { int e = 0; const int r = F.tid * 256;
#pragma unroll
        for (int q = 1; q < 32; ++q) e = (ps[q] <= r) ? q : e;
        ps[48 + F.tid] = e; }
    __syncthreads();
}
__device__ __forceinline__ int moe_tile_expert(const LAS int* ps, int tile) { return ps[48 + tile]; }

struct MoeUp {
    static constexpr bool PERM = true, GATHER = true, FP8 = true, BBLK = true;
    int K, NB; const char* A; const char* Wg; const char* Wu; unsigned char* H; const float* bg; const float* bu; const int* list; const LAS int* cnt; const LAS int* ps; const LAS int* gtab; int G, c;
    __device__ __forceinline__ bool next(int i, Unit& u) const {
        const int NT = ps[32] / 256, NU = NT * 16, L = i * G + c; if (L >= NU) return false;
        pg8::tile_order(L, NT, 16, u.pm, u.pn); u.e = moe_tile_expert(ps, u.pm); return true;
    }
    __device__ __forceinline__ const char* bptr(const Unit& u, int half) const { return (half ? Wu : Wg) + (size_t)u.e * D * D + (size_t)(u.pn * 128) * 16; }
    __device__ __forceinline__ unsigned arow(const Unit& u, int r) const { const int loc = u.pm * 256 + r - ps[u.e]; return loc < cnt[u.e] ? (unsigned)list[(size_t)u.e * ML + loc] : 0u; }
    __device__ __forceinline__ unsigned arow_i(int ord, const Unit&, int r) const { return (unsigned)gtab[ord * 256 + r]; }
    struct Pre { f32x4 g0, g1, u0, u1; };
    __device__ __forceinline__ Pre prefetch(const Unit&, int, int, int, int) const { return Pre{}; }
    __device__ __forceinline__ void bias_issue(const Unit& u, LAS unsigned char* dst, int wid, int lane) const {
        if (wid == 0) { const float* src = (lane < 32 ? bg : bu) + (size_t)u.e * D + u.pn * 128 + (lane & 31) * 4;
            __builtin_amdgcn_global_load_lds((const unsigned*)src, (LAS unsigned*)dst, 16, 0, 0); } }
    __device__ __forceinline__ Pre bias_read(const LAS unsigned char* src, int wc, int fq, const Pre&) const { const LAS float* b = (const LAS float*)src + wc * 32 + 8 * fq; Pre p;
        p.g0 = *(const LAS f32x4*)(b); p.g1 = *(const LAS f32x4*)(b + 4); p.u0 = *(const LAS f32x4*)(b + 128); p.u1 = *(const LAS f32x4*)(b + 132); return p; }
    __device__ __forceinline__ void epi(const f32x4 (&acc)[2][2][4][2], const Unit& u, int wr, int wc, int fr, int fq, const Pre& pre) const {
        const int row0 = u.pm * 256 + wr * 64 + fr, col0 = u.pn * 128 + wc * 32 + 8 * fq;
        const f32x4 g0 = pre.g0, g1 = pre.g1, u0 = pre.u0, u1 = pre.u1;
#pragma unroll
        for (int ai = 0; ai < 2; ++ai)
#pragma unroll
            for (int m = 0; m < 4; ++m) { float hv[8];
#pragma unroll
                for (int n = 0; n < 2; ++n)
#pragma unroll
                    for (int jp = 0; jp < 2; ++jp) { const int j = 2 * jp;
                        const f32x2 bgv = n ? (f32x2){g1[j], g1[j + 1]} : (f32x2){g0[j], g0[j + 1]}, buv = n ? (f32x2){u1[j], u1[j + 1]} : (f32x2){u0[j], u0[j + 1]};
                        f32x2 glu = (f32x2){acc[ai][0][m][n][j], acc[ai][0][m][n][j + 1]} * (1.f / W8_SCALE) + bgv, lin = (f32x2){acc[ai][1][m][n][j], acc[ai][1][m][n][j + 1]} * (1.f / W8_SCALE) + buv;
                        glu.x = fminf(glu.x, 7.0f); glu.y = fminf(glu.y, 7.0f); lin.x = __builtin_amdgcn_fmed3f(lin.x, -7.0f, 7.0f); lin.y = __builtin_amdgcn_fmed3f(lin.y, -7.0f, 7.0f);
                        const f32x2 ea = glu * (-1.702f * 1.4426950408889634f); f32x2 dn; dn.x = __builtin_amdgcn_exp2f(ea.x); dn.y = __builtin_amdgcn_exp2f(ea.y); dn = dn + 1.0f;
                        f32x2 sg; sg.x = __builtin_amdgcn_rcpf(dn.x); sg.y = __builtin_amdgcn_rcpf(dn.y);
                        const f32x2 hh2 = (glu * sg) * (lin * H8_SCALE + H8_SCALE); hv[4 * n + j] = hh2.x; hv[4 * n + j + 1] = hh2.y; }
                *(u32x2*)(H + (size_t)(row0 + ai * 128 + m * 16) * D + col0) = (u32x2){pk_fp8x4(hv[0], hv[1], hv[2], hv[3]), pk_fp8x4(hv[4], hv[5], hv[6], hv[7])}; }
    }
};
struct MoeDown {
    static constexpr bool PERM = true, GATHER = false, FP8 = true, BBLK = true;
    int K, NB; const char* A; const char* Wd; unsigned char* O; const float* bd; const LAS int* ps; int G, c;
    __device__ __forceinline__ bool next(int i, Unit& u) const {
        const int NT = ps[32] / 256, NU = NT * 8, L = i * G + c; if (L >= NU) return false;
        pg8::tile_order(L, NT, 8, u.pm, u.pn); u.e = moe_tile_expert(ps, u.pm); return true;
    }
    __device__ __forceinline__ const char* bptr(const Unit& u, int half) const { return Wd + (size_t)u.e * D * D + (size_t)(u.pn * 256 + half * 128) * 16; }
    __device__ __forceinline__ unsigned arow_i(int, const Unit& u, int r) const { return (unsigned)(u.pm * 256 + r); }
    struct Pre { f32x4 c[2][2]; };
    __device__ __forceinline__ Pre prefetch(const Unit&, int, int, int, int) const { return Pre{}; }
    __device__ __forceinline__ void bias_issue(const Unit& u, LAS unsigned char* dst, int wid, int lane) const {
        if (wid == 0) __builtin_amdgcn_global_load_lds((const unsigned*)(bd + (size_t)u.e * D + u.pn * 256 + lane * 4), (LAS unsigned*)dst, 16, 0, 0); }
    __device__ __forceinline__ Pre bias_read(const LAS unsigned char* src, int wc, int fq, const Pre&) const { const LAS float* b = (const LAS float*)src + wc * 32 + 8 * fq; Pre p;
#pragma unroll
        for (int bj = 0; bj < 2; ++bj) { p.c[bj][0] = *(const LAS f32x4*)(b + bj * 128); p.c[bj][1] = *(const LAS f32x4*)(b + bj * 128 + 4); }
        return p; }
    __device__ __forceinline__ void epi(const f32x4 (&acc)[2][2][4][2], const Unit& u, int wr, int wc, int fr, int fq, const Pre& pre) const {
        const int row0 = u.pm * 256 + wr * 64 + fr, col0 = u.pn * 256 + wc * 32 + 8 * fq;
#pragma unroll
        for (int bj = 0; bj < 2; ++bj) { const f32x4 c0 = pre.c[bj][0], c1 = pre.c[bj][1];
#pragma unroll
            for (int ai = 0; ai < 2; ++ai)
#pragma unroll
                for (int m = 0; m < 4; ++m) { const f32x4 v0 = acc[ai][bj][m][0] * (O8_SCALE / (W8_SCALE * H8_SCALE)) + c0 * O8_SCALE, v1 = acc[ai][bj][m][1] * (O8_SCALE / (W8_SCALE * H8_SCALE)) + c1 * O8_SCALE;
#define SAT8(x) __builtin_amdgcn_fmed3f((x), -448.f, 448.f)
                    *(u32x2*)(O + (size_t)(row0 + ai * 128 + m * 16) * D + col0 + bj * 128) = (u32x2){pk_fp8x4(SAT8(v0[0]), SAT8(v0[1]), SAT8(v0[2]), SAT8(v0[3])), pk_fp8x4(SAT8(v1[0]), SAT8(v1[1]), SAT8(v1[2]), SAT8(v1[3]))}; } }
#undef SAT8
    }
};

__device__ __forceinline__ void p10_final(Frame& F) {
    int tz_ = threadIdx.x; asm volatile("" : "+v"(tz_));
    const int tid_ = tz_, lane_ = tz_ & 63, wave_ = __builtin_amdgcn_readfirstlane(tz_ >> 6);
    const LAS int* ps = (const LAS int*)(F.lds + TAB_OFF) + 32;
    const unsigned char* O = WSP(const unsigned char, WS_O); const float* modf = WSP(const float, WS_MODF); const bf16_t* V = WSP(const bf16_t, WS_V); const f32x2* st1 = WSP(const f32x2, WS_STAT1);
    const float* g1 = F.in[I_LN1G]; const float* b1 = F.in[I_LN1B];
    const i32x4* toke = WSP(const i32x4, WS_TOKE); const i32x4* tokp = WSP(const i32x4, WS_TOKP); const f32x4* tokg = WSP(const f32x4, WS_TOKG);
    const float* g2 = F.in[I_LN2G]; const float* b2 = F.in[I_LN2B];
    const int gw = F.bid * 8 + wave_, NGW = F.G * 8;
    LAS float* PL = (LAS float*)F.lds;
    for (int i = tid_; i < D; i += 512) { PL[i] = g1[i]; PL[D + i] = b1[i]; PL[2 * D + i] = g2[i]; PL[3 * D + i] = b2[i]; PL[4 * D + i] = modf[5 * D + i]; PL[5 * D + i] = modf[(size_t)(6 * D) + 5 * D + i]; }
    __syncthreads();
    if (gw >= ML) return;
    i32x4 ne = toke[gw], np = tokp[gw]; f32x4 ng = tokg[gw];
    unsigned own[4][8]; u32x2 hwn[8]; f32x2 srn; f32x4 cgn;
#define FIN_GATHER(row_) do { _Pragma("unroll") for (int _s = 0; _s < 4; ++_s) { const unsigned* _or = (const unsigned*)(O + (size_t)(ps[ne[_s]] + np[_s]) * D) + lane_; \
            _Pragma("unroll") for (int _j = 0; _j < 8; ++_j) own[_s][_j] = _or[64 * _j]; } \
        { const u32x2* _hr = (const u32x2*)(V + (size_t)(row_) * D) + lane_; _Pragma("unroll") for (int _j = 0; _j < 8; ++_j) hwn[_j] = _hr[64 * _j]; } \
        srn = st1[row_]; cgn = ng; } while (0)
    FIN_GATHER(gw);
    if (gw + NGW < ML) { ne = toke[gw + NGW]; np = tokp[gw + NGW]; ng = tokg[gw + NGW]; }
    for (int row = gw; row < ML; row += NGW) {
        unsigned ow[4][8]; u32x2 hw[8];
#pragma unroll
        for (int s4 = 0; s4 < 4; ++s4)
#pragma unroll
            for (int j = 0; j < 8; ++j) ow[s4][j] = own[s4][j];
#pragma unroll
        for (int j = 0; j < 8; ++j) hw[j] = hwn[j];
        const f32x2 sr = srn; const f32x4 cg = cgn;
        if (row + NGW < ML) { FIN_GATHER(row + NGW);
            if (row + 2 * NGW < ML) { ne = toke[row + 2 * NGW]; np = tokp[row + 2 * NGW]; ng = tokg[row + 2 * NGW]; } }
        const LAS float* gt2 = PL + 4 * D + (row / SEQ) * D;
        f32x4 f[8]; float s = 0.f;
#pragma unroll
        for (int j = 0; j < 8; ++j) { f32x4 a = {0.f, 0.f, 0.f, 0.f};
#pragma unroll
            for (int s4 = 0; s4 < 4; ++s4) { const unsigned w = ow[s4][j]; const f32x2 lo = __builtin_amdgcn_cvt_pk_f32_fp8((int)w, false), hi = __builtin_amdgcn_cvt_pk_f32_fp8((int)w, true); a += (f32x4){lo.x, lo.y, hi.x, hi.y} * (cg[s4] * (1.f / O8_SCALE)); }
            const int d = 4 * lane_ + 256 * j; const u32x2 h = hw[j];
            const f32x4 h1 = ((f32x4){bf_lo(h.x), bf_hi(h.x), bf_lo(h.y), bf_hi(h.y)} - sr.x) * sr.y * *(const LAS f32x4*)(PL + d) + *(const LAS f32x4*)(PL + D + d);
            f[j] = h1 * DN_ALPHA + *(const LAS f32x4*)(gt2 + d) * a; s += (f[j].x + f[j].y) + (f[j].z + f[j].w);
            if (j & 1) __builtin_amdgcn_sched_barrier(0); }
        const float mean = wave_sum(s) * (1.f / D); float s2 = 0.f;
#pragma unroll
        for (int j = 0; j < 8; ++j) { f[j] = f[j] - mean; s2 += (f[j].x * f[j].x + f[j].y * f[j].y) + (f[j].z * f[j].z + f[j].w * f[j].w); }
        const float rstd = __builtin_amdgcn_rsqf(wave_sum(s2) * (1.f / D) + LN_EPS);
        f32x4* orw = (f32x4*)(F.out + (size_t)row * D) + lane_;
#pragma unroll
        for (int j = 0; j < 8; ++j) { const int d = 4 * lane_ + 256 * j; orw[64 * j] = f[j] * rstd * *(const LAS f32x4*)(PL + 2 * D + d) + *(const LAS f32x4*)(PL + 3 * D + d); }
    }
#undef FIN_GATHER
}

constexpr int NPHASE = 12;
__global__ void __launch_bounds__(512, 2) fwd_kernel(Args args) {
    extern __shared__ __attribute__((aligned(16))) unsigned char lds_raw[];
    Frame F;
    F.lds = (LAS unsigned char*)lds_raw; F.MISC = (volatile LAS unsigned*)(F.lds + MISC_OFF);
    F.tid = threadIdx.x; F.lane = F.tid & 63; F.wave = __builtin_amdgcn_readfirstlane(F.tid >> 6); F.G = gridDim.x; F.bid = blockIdx.x;
    F.ws = args.ws; F.ctl = (unsigned*)(args.ws + WS_CTL); F.in = args.in; F.out = args.out;
    if (F.tid < 128) ((LAS unsigned*)(F.lds + MISC_OFF))[F.tid] = 0u;
    __syncthreads();
    const int lo = args.ph_lo, hi = args.ph_hi;
    XcdBarrier bar; bar.bar = F.ctl + CW_BAR + args.li * XCD_BAR_WORDS; bar.x = 0; bar.st = nullptr;
    if (hi - lo > 1) bar = xcd_barrier_post(F.ctl + CW_BAR + args.li * XCD_BAR_WORDS, F.MISC);
#ifndef PH_MASK
#define PH_MASK 0xfff
#endif
#define IN(k) (((PH_MASK >> (k)) & 1) && lo <= (k) && (k) < hi)
#define SEAM(k) do { if (IN(k) && IN((k) + 1)) xcd_barrier(bar); } while (0)
#ifndef PROBE_DBL
#define PROBE_DBL -1
#endif
#define REP(k) for (int _rep = 0; _rep < ((PROBE_DBL == (k)) ? 2 : 1); ++_rep)
    if (IN(0)) REP(0) { p0_prologue(F); if (PROBE_DBL == 0) { VM_WAIT(); __syncthreads(); } } SEAM(0);
    if (IN(1)) REP(1) { p1_ln0(F); if (PROBE_DBL == 1) { VM_WAIT(); __syncthreads(); } } SEAM(1);
    if (IN(2)) REP(2) { const int gconv = (F.G > 2 * NCONV_WG) ? NCONV_WG : 0, ggemm = F.G - gconv;
                 if (F.bid < ggemm) { InProj S{D, (const char*)WSP(bf16_t, WS_HM), (const char*)WSP(bf16_t, WS_WIN), WSP(bf16_t, WS_P), ggemm, F.bid}; pg8::gemm_phase(F.lds, S); }
                 else if (PROBE_DBL != 2 || _rep == 0) convert_experts(F, (F.bid - ggemm) * 8 + F.wave, gconv * 8, 0, ti_early(F.G)); } SEAM(2);
    if (IN(3)) REP(3) { p3a_tokens(F); if (PROBE_DBL == 3) { VM_WAIT(); __syncthreads(); } } SEAM(3);
    if (IN(4)) REP(4) { p3_prep(F); if (PROBE_DBL == 4) { VM_WAIT(); __syncthreads(); } } SEAM(4);
    if (IN(5)) { p4_scan(F); if (PROBE_DBL == 5) { VM_WAIT(); __syncthreads(); p4_scan(F); } } SEAM(5);
    if (IN(6)) REP(6) { p5_mix_out(F); if (PROBE_DBL == 6) { VM_WAIT(); __syncthreads(); } } SEAM(6);
    if (IN(7)) REP(7) { OutProj S{D, (const char*)WSP(bf16_t, WS_Y), (const char*)WSP(bf16_t, WS_WOUT), WSP(bf16_t, WS_V), F.in[I_X], WSP(const f32x2, WS_STAT0), F.in[I_LN0G], F.in[I_LN0B], WSP(const float, WS_MODF), F.G, F.bid};
                 pg8::gemm_phase(F.lds, S); } SEAM(7);
    if (IN(8)) { p7_ln1_router(F); } SEAM(8);
    if (IN(9) || IN(10) || IN(11)) moe_tables(F);
    if (IN(9)) REP(9) { const LAS int* cnt = (const LAS int*)(F.lds + TAB_OFF);
                 LAS int* gtab = (LAS int*)(F.lds + GTAB_OFF);
                 MoeUp S{D / 2, D, (const char*)WSP(unsigned char, WS_U), (const char*)WSP(unsigned char, WS_WG), (const char*)WSP(unsigned char, WS_WU), WSP(unsigned char, WS_H), F.in[I_BGATE], F.in[I_BUP], WSP(const int, WS_LIST), cnt, cnt + 32, gtab, F.G, F.bid};
                 { int gi[GTAB_UNITS / 2];
#pragma unroll
                   for (int k = 0; k < GTAB_UNITS / 2; ++k) { const int i = 2 * k + (F.tid >> 8); Unit u; gi[k] = -1; if (S.next(i, u)) gi[k] = (int)S.arow(u, F.tid & 255); }
#pragma unroll
                   for (int k = 0; k < GTAB_UNITS / 2; ++k) { const int i = 2 * k + (F.tid >> 8); if (gi[k] >= 0) gtab[i * 256 + (F.tid & 255)] = gi[k]; } }
                 __syncthreads();
                 pg8::gemm_phase(F.lds, S); } SEAM(9);
    if (IN(10)) REP(10) { const LAS int* cnt = (const LAS int*)(F.lds + TAB_OFF);
                 MoeDown S{D / 2, D, (const char*)WSP(unsigned char, WS_H), (const char*)WSP(unsigned char, WS_WD), WSP(unsigned char, WS_O), F.in[I_BDOWN], cnt + 32, F.G, F.bid};
                 pg8::gemm_phase(F.lds, S); } SEAM(10);
    if (IN(11)) { p10_final(F); }
#undef IN
#undef SEAM
}

extern "C" void kernel_launch(void* const* d_in, const int* in_sizes, int n_in, void* d_out, int out_size, void* d_ws, size_t ws_size, hipStream_t stream) {
    static int grid = 0;
    if (grid == 0) {
        if (n_in != 27 || out_size != ML * D || ws_size < WS_END) { fprintf(stderr, "kernel_launch: unexpected problem (n_in %d, out %d, ws %zu < %zu)\n", n_in, out_size, ws_size, (size_t)WS_END); grid = -1; return; }
        int dev = 0, cus = 0, per_cu = 0;
        if (hipGetDevice(&dev) != hipSuccess || hipDeviceGetAttribute(&cus, hipDeviceAttributeMultiprocessorCount, dev) != hipSuccess) { grid = -1; return; }
        if (hipFuncSetAttribute((const void*)fwd_kernel, hipFuncAttributeMaxDynamicSharedMemorySize, LDS_BYTES) != hipSuccess) { fprintf(stderr, "kernel_launch: hipFuncSetAttribute failed\n"); grid = -1; return; }
        if (hipOccupancyMaxActiveBlocksPerMultiprocessor(&per_cu, (const void*)fwd_kernel, 512, LDS_BYTES) != hipSuccess || per_cu < 1) { fprintf(stderr, "kernel_launch: occupancy query says %d\n", per_cu); }
        (void)hipGetLastError();
        grid = cus;
    }
    if (grid < 0) return;
    if (hipMemsetAsync((char*)d_ws + WS_CTL, 0, CTL_BYTES, stream) != hipSuccess) return;
    Args a{};
    for (int i = 0; i < 27; ++i) a.in[i] = (const float*)d_in[i];
    a.out = (float*)d_out; a.ws = (unsigned char*)d_ws; a.pad = 0;
#if MK_N_LAUNCHES == 1
    a.ph_lo = 0; a.ph_hi = NPHASE; a.li = 0;
    hipLaunchKernelGGL(fwd_kernel, dim3(grid), dim3(512), LDS_BYTES, stream, a);
#else
    for (int p = 0; p < NPHASE; ++p) { a.ph_lo = p; a.ph_hi = p + 1; a.li = 0; hipLaunchKernelGGL(fwd_kernel, dim3(grid), dim3(512), LDS_BYTES, stream, a); }
#endif
}
```

```cpp
#include <hip/hip_runtime.h>
#include <cstdio>
#include <cstdint>

#ifndef MK_N_LAUNCHES
#define MK_N_LAUNCHES 1
#endif

#define LAS __attribute__((address_space(3)))
#define GAS __attribute__((address_space(1)))
typedef unsigned short bf16_t;
typedef short bf16x8 __attribute__((ext_vector_type(8)));
typedef float f32x4 __attribute__((ext_vector_type(4)));
typedef float f32x2 __attribute__((ext_vector_type(2)));
typedef unsigned u32x4 __attribute__((ext_vector_type(4)));
typedef unsigned u32x2 __attribute__((ext_vector_type(2)));

constexpr int D = 2048, NBATCH = 2, SEQ = 8192, ML = NBATCH * SEQ, CTXL = 256, MC = NBATCH * CTXL, MTOT = ML + MC;
constexpr int NH = 8, DK = 128, GQK = 1024, GQKV = 3072, GIN = 3104, NIN = 7200, NINP = 7424;
constexpr int COL_A = 3072, COL_B = 3088, COL_Z = 3104, COL_SB = 4128, COL_SC = 5152, COL_SX = 6176;
constexpr int NE = 32, TOPK = 4, MAXROWS = ML * TOPK + NE * 256, MAXTILES = MAXROWS / 256;
constexpr float LN_EPS = 1e-5f, RMS_EPS = 1e-6f;
constexpr float DN_ALPHA = 1.189207115002721f;
constexpr int NPART = 8;

constexpr size_t MiB = 1ull << 20;
constexpr size_t WS_CTL = 0, CTL_BYTES = 64 * 1024;
constexpr size_t WS_MODP = 1 * MiB;
constexpr size_t WS_MODF = 3 * MiB;
constexpr size_t WS_STAT0 = 4 * MiB;
constexpr size_t WS_STAT1 = 4 * MiB + 512 * 1024;
constexpr size_t WS_TOKE = 5 * MiB;
constexpr size_t WS_TOKP = WS_TOKE + 256 * 1024;
constexpr size_t WS_TOKG = WS_TOKP + 256 * 1024;
constexpr size_t WS_LIST = 6 * MiB;
constexpr size_t WS_WIN = 8 * MiB;
constexpr size_t WS_WOUT = 38 * MiB;
constexpr size_t WS_WG = 48 * MiB, WS_WU = 304 * MiB, WS_WD = 560 * MiB;
constexpr size_t WS_HM = 816 * MiB;
constexpr size_t WS_P = 882 * MiB;
constexpr size_t WS_PREP = 1122 * MiB;
constexpr size_t WS_OGB = 1424 * MiB;
constexpr size_t WS_Y = 1488 * MiB;
constexpr size_t WS_V = 1552 * MiB;
constexpr size_t WS_H1B = 1616 * MiB;
constexpr size_t WS_U = 1680 * MiB;
constexpr size_t WS_H = 882 * MiB;
constexpr size_t WS_O = 1170 * MiB;
constexpr size_t WS_END = 1744 * MiB;
constexpr size_t WS_QKVB = WS_V;
constexpr size_t WS_GBF = WS_U;
#ifdef GDN_NAIVE
constexpr size_t WS_QKV = 1744 * MiB;
constexpr size_t WS_GB = 1942 * MiB;
constexpr size_t WS_OG = 1946 * MiB;
#endif
constexpr int NCHUNK = (CTXL + SEQ) / 64, NUNITS = NBATCH * NCHUNK * NH * 2;
constexpr int UNIT_BYTES = 74752, UO_NW = 0, UO_QD = 16384, UO_KDT = 32768, UO_QK = 49152, UO_U = 57344, UO_DL = 73728, UNIT_DMA = 74752;
static_assert(WS_WIN + (size_t)NINP * D * 2 <= WS_WOUT && WS_P + (size_t)MTOT * NINP * 2 <= WS_PREP && WS_PREP + (size_t)NUNITS * UNIT_BYTES <= WS_OGB, "ws map");
static_assert(WS_H + (size_t)MAXROWS * D * 2 <= WS_O && WS_O + (size_t)MAXROWS * D * 2 <= WS_Y && WS_OGB + (size_t)2 * ML * 1024 * 2 <= WS_Y, "ws map 2");
constexpr int CW_CNT = 1024;
constexpr int CW_BAR = 8192;

constexpr int LDS_BYTES = 155648;
constexpr int MISC_OFF = 155136;
constexpr int BIAS_OFF = 149504;
constexpr int GTAB_OFF = 131072, GTAB_UNITS = 18;
constexpr int TAB_OFF = 151552;

__device__ __forceinline__ unsigned cvt_pk_bf16(float lo, float hi) { unsigned r; asm volatile("v_cvt_pk_bf16_f32 %0, %1, %2" : "=v"(r) : "v"(lo), "v"(hi)); return r; }
__device__ __forceinline__ float bf_lo(unsigned w) { return __uint_as_float(w << 16); }
__device__ __forceinline__ float bf_hi(unsigned w) { return __uint_as_float(w & 0xffff0000u); }
__device__ __forceinline__ float bf2f(bf16_t b) { return __uint_as_float(((unsigned)b) << 16); }
__device__ __forceinline__ float silu_f(float x) { return x * __builtin_amdgcn_rcpf(1.0f + __expf(-x)); }
__device__ __forceinline__ float sigmoid_f(float x) { return __builtin_amdgcn_rcpf(1.0f + __expf(-x)); }
__device__ __forceinline__ float softplus_f(float x) { return x > 20.f ? x : log1pf(__expf(x)); }
__device__ __forceinline__ float wave_sum(float v) {
#pragma unroll
    for (int o = 1; o < 64; o <<= 1) v += __shfl_xor(v, o);
    return v;
}
typedef int i32x8 __attribute__((ext_vector_type(8)));
typedef int i32x4 __attribute__((ext_vector_type(4)));
__device__ __forceinline__ unsigned pk_fp8x4(float a, float b, float c, float d) { int w = __builtin_amdgcn_cvt_pk_fp8_f32(a, b, 0, false); w = __builtin_amdgcn_cvt_pk_fp8_f32(c, d, w, true); return (unsigned)w; }
constexpr float W8_SCALE = 64.f, H8_SCALE = 8.f, O8_SCALE = 16.f;
#define LDS_WAIT() asm volatile("s_waitcnt lgkmcnt(0)" ::: "memory")
#define VM_WAIT() asm volatile("s_waitcnt vmcnt(0)" ::: "memory")

#define XB_TMO      128
#define XB_XCNT(j)  (256  + 64 * (j))
#define XB_XSUB(j)  (1280 + 64 * (j))
#define XB_XGEN(j)  (2304 + 64 * (j))
#define XB_TOP      3328
#define XB_TOPGEN   3392
#define XCD_BAR_WORDS 3456
#define XB_SPIN_CAP (1u << 22)

__device__ __forceinline__ unsigned xb_ld(unsigned* p)              { return __hip_atomic_load(p, __ATOMIC_RELAXED, __HIP_MEMORY_SCOPE_AGENT); }
__device__ __forceinline__ unsigned xb_add(unsigned* p, unsigned v) { return __hip_atomic_fetch_add(p, v, __ATOMIC_RELAXED, __HIP_MEMORY_SCOPE_AGENT); }
__device__ __forceinline__ unsigned xb_xcc_id() { return (unsigned)__builtin_amdgcn_s_getreg((3 << 11) | 20) & 0xFu; }
#define XB_SPIN(cond, bar) do { unsigned _sp = 0; while (cond) { __builtin_amdgcn_s_sleep(1); \
    if ((++_sp & 255u) == 0u) { if (xb_ld(&(bar)[XB_TMO])) break; if (_sp > XB_SPIN_CAP) { atomicAdd(&(bar)[XB_TMO], 1u); break; } } } } while (0)

struct XcdBarrier { unsigned* bar; unsigned x; volatile LAS unsigned* st; };

__device__ __forceinline__ XcdBarrier xcd_barrier_post(unsigned* bar, volatile LAS unsigned* st) {
    XcdBarrier b; b.bar = bar; b.x = xb_xcc_id(); b.st = st;
    if (threadIdx.x == 0) (void)xb_add(&bar[XB_XCNT(b.x)], 1u);
    return b;
}
__device__ __forceinline__ void xcd_barrier_complete(unsigned* bar, unsigned x, unsigned& nloc, unsigned& nx) {
    const unsigned G = gridDim.x * gridDim.y * gridDim.z;
    unsigned sum, cnt, mine, sp = 0u;
    for (;;) {
        sum = 0u; cnt = 0u; mine = 0u;
#pragma unroll
        for (unsigned j = 0; j < 16; ++j) { const unsigned c = xb_ld(&bar[XB_XCNT(j)]); sum += c; cnt += (c > 0u) ? 1u : 0u; mine = (j == x) ? c : mine; }
        if (sum == G) break;
        __builtin_amdgcn_s_sleep(1);
        if ((++sp & 255u) == 0u) { if (xb_ld(&bar[XB_TMO])) break; if (sp > XB_SPIN_CAP) { atomicAdd(&bar[XB_TMO], 1u); break; } }
    }
    nloc = mine > 0u ? mine : 1u; nx = cnt > 0u ? cnt : 1u;
}
__device__ __forceinline__ void xcd_barrier(const XcdBarrier& b) {
    asm volatile("s_waitcnt vmcnt(0)" ::: "memory");
    __syncthreads();
    if (threadIdx.x == 0) {
        unsigned* bar = b.bar;
        __builtin_amdgcn_s_waitcnt(0);
        unsigned nloc = b.st[0], nx = b.st[1];
        if (nloc == 0u) { xcd_barrier_complete(bar, b.x, nloc, nx); b.st[0] = nloc; b.st[1] = nx; }
        const unsigned old = xb_add(&bar[XB_XSUB(b.x)], 1u);
        const unsigned gen = old / nloc;
        if (old + 1u == (gen + 1u) * nloc) {
            __builtin_amdgcn_fence(__ATOMIC_RELEASE, "agent");
            asm volatile("s_waitcnt vmcnt(0)" ::: "memory");
            const unsigned og = xb_add(&bar[XB_TOP], 1u);
            const unsigned tg = og / nx;
            if (og + 1u == (tg + 1u) * nx) xb_add(&bar[XB_TOPGEN], 1u);
            else XB_SPIN(xb_ld(&bar[XB_TOPGEN]) == tg, bar);
            __builtin_amdgcn_fence(__ATOMIC_ACQUIRE, "agent");
            xb_add(&bar[XB_XGEN(b.x)], 1u);
            asm volatile("s_waitcnt vmcnt(0)" ::: "memory");
        } else {
            XB_SPIN(xb_ld(&bar[XB_XGEN(b.x)]) == gen, bar);
            __builtin_amdgcn_fence(__ATOMIC_ACQUIRE, "agent");
            asm volatile("s_waitcnt vmcnt(0)" ::: "memory");
        }
    }
    __syncthreads();
}

struct Args { const float* in[27]; float* out; unsigned char* ws; int ph_lo, ph_hi, li, pad; };
enum { I_X = 0, I_C, I_CTX, I_CCTX, I_LN0G, I_LN0B, I_WADA, I_BADA, I_WIN, I_CONVQKV, I_ALOG, I_DTB, I_GNW, I_CONVSC, I_WOUT, I_LN1G, I_LN1B, I_WR, I_BR,
       I_WGATE, I_BGATE, I_WUP, I_BUP, I_WDOWN, I_BDOWN, I_LN2G, I_LN2B };

namespace pg8 {
constexpr int BM = 256, BK = 64, HALF = 128, HTB = HALF * BK * 2, STAGE_BYTES = 8 * HTB, NXCD = 8, WGM = 8;
__host__ __device__ __forceinline__ int lds_byte(int r, int c) { const int st = (r >> 4) * 2 + (c >> 5), rr = r & 15, cc = c & 31, ob = rr * 64 + cc * 2; return st * 1024 + (ob ^ (((ob >> 9) & 1) << 5)); }
__host__ __device__ __forceinline__ void stage_rc(int b, int& R, int& C) { const int st = b / 1024, sb = b % 1024, swz = sb ^ (((sb >> 9) & 1) << 5); R = (st >> 1) * 16 + swz / 64; C = (st & 1) * 32 + (swz % 64) / 2; }
__host__ __device__ __forceinline__ int perm32(int rho) { const int n = rho >> 4, i = rho & 15; return 8 * (i >> 2) + 4 * n + (i & 3); }

struct Unit { int pm, pn, e; };
__device__ __forceinline__ void tile_order(int L, int nM, int nN, int& pm, int& pn) {
    const int nwg = nM * nN; int wgid = L;
    { const int q = nwg / NXCD, r = nwg % NXCD, xcd = wgid % NXCD, off = wgid / NXCD; wgid = (xcd < r ? xcd * (q + 1) : r * (q + 1) + (xcd - r) * q) + off; }
    const int nig = WGM * nN, gid = wgid / nig, fm = gid * WGM, gsz = (nM - fm) < WGM ? (nM - fm) : WGM;
    pm = fm + ((wgid % nig) % gsz); pn = (wgid % nig) / gsz;
}

template <class P>
__device__ __forceinline__ void gemm_phase(LAS unsigned char* lds, const P& S) {
    int tid = threadIdx.x; asm volatile("" : "+v"(tid));
    const int wid = __builtin_amdgcn_readfirstlane(tid >> 6), lane = tid & 63, wr = wid >> 2, wc = wid & 3, fr = lane & 15, fq = lane >> 4;
    const int K = S.K, nt = K / BK;
    unsigned voffB[2]; int RA[2], CA[2];
#pragma unroll
    for (int i = 0; i < 2; ++i) { int R, C; stage_rc(tid * 16 + i * 8192, R, C); const int Rb = P::PERM ? ((R & ~31) + perm32(R & 31)) : R;
        RA[i] = R; CA[i] = C; if constexpr (P::BBLK) voffB[i] = (unsigned)((C >> 3) * S.NB + Rb) * 16u; else voffB[i] = (unsigned)(Rb * K + C) * 2u; }
    const size_t kstep = (size_t)(BK * 2);
    size_t kstepB = kstep; if constexpr (P::BBLK) kstepB = (size_t)128 * (size_t)S.NB;
    const unsigned ldsw = (unsigned)wid * 1024u;
    const int aoff = lds_byte(wr * 64 + fr, fq * 8), boff = lds_byte(wc * 32 + fr, fq * 8);
#define PG8_SA(b, h) (((b) * 2 + (h)) * HTB)
#define PG8_SB(b, h) ((4 + (b) * 2 + (h)) * HTB)
#define PG8_STAGE_B(bufoff, gbase) do { _Pragma("unroll") for (int _i = 0; _i < 2; ++_i) \
        __builtin_amdgcn_global_load_lds((const unsigned*)((const char*)(gbase) + voffB[_i]), (LAS unsigned*)(lds + (bufoff) + ldsw + _i * 8192), 16, 0, 0); } while (0)
#define PG8_STAGE_A(bufoff, AO, h, kb) do { _Pragma("unroll") for (int _i = 0; _i < 2; ++_i) \
        __builtin_amdgcn_global_load_lds((const unsigned*)(S.A + (size_t)(AO)[h][_i] + (size_t)(kb)), (LAS unsigned*)(lds + (bufoff) + ldsw + _i * 8192), 16, 0, 0); } while (0)
#define PG8_LDA(dst, b, h) do { _Pragma("unroll") for (int m = 0; m < 4; ++m) { dst[m].lo = *(const LAS i32x4*)(lds + PG8_SA(b, h) + aoff + m * 2048); dst[m].hi = *(const LAS i32x4*)(lds + PG8_SA(b, h) + aoff + m * 2048 + 1024); } } while (0)
#define PG8_LDB(dst, b, h) do { _Pragma("unroll") for (int n = 0; n < 2; ++n) { dst[n].lo = *(const LAS i32x4*)(lds + PG8_SB(b, h) + boff + n * 2048); dst[n].hi = *(const LAS i32x4*)(lds + PG8_SB(b, h) + boff + n * 2048 + 1024); } } while (0)
#define PG8_MMA(ai, bj, At, Bt) do { __builtin_amdgcn_s_setprio(1); \
        if constexpr (P::FP8) { _Pragma("unroll") for (int m = 0; m < 4; ++m) _Pragma("unroll") for (int n = 0; n < 2; ++n) \
            { FP8_MMA_ONE(acc[ai][bj][m][n], Bt[n], At[m]); } } \
        else { _Pragma("unroll") for (int m = 0; m < 4; ++m) _Pragma("unroll") for (int n = 0; n < 2; ++n) { \
            const i32x4 _bl = __builtin_shufflevector(Bt[n], Bt[n], 0, 1, 2, 3), _bh = __builtin_shufflevector(Bt[n], Bt[n], 4, 5, 6, 7), _al = __builtin_shufflevector(At[m], At[m], 0, 1, 2, 3), _ah = __builtin_shufflevector(At[m], At[m], 4, 5, 6, 7); \
            acc[ai][bj][m][n] = __builtin_amdgcn_mfma_f32_16x16x32_bf16(__builtin_bit_cast(bf16x8, _bl), __builtin_bit_cast(bf16x8, _al), acc[ai][bj][m][n], 0, 0, 0); \
            acc[ai][bj][m][n] = __builtin_amdgcn_mfma_f32_16x16x32_bf16(__builtin_bit_cast(bf16x8, _bh), __builtin_bit_cast(bf16x8, _ah), acc[ai][bj][m][n], 0, 0, 0); } } \
        __builtin_amdgcn_s_setprio(0); } while (0)
typedef int i32x2 __attribute__((ext_vector_type(2)));
#ifdef FP8_LEGACY_MFMA
#define FP8_MMA_ONE(c, b8, a8) do { \
        const i32x2 _b0 = __builtin_shufflevector(b8, b8, 0, 1), _b1 = __builtin_shufflevector(b8, b8, 2, 3), _b2 = __builtin_shufflevector(b8, b8, 4, 5), _b3 = __builtin_shufflevector(b8, b8, 6, 7); \
        const i32x2 _a0 = __builtin_shufflevector(a8, a8, 0, 1), _a1 = __builtin_shufflevector(a8, a8, 2, 3), _a2 = __builtin_shufflevector(a8, a8, 4, 5), _a3 = __builtin_shufflevector(a8, a8, 6, 7); \
        asm volatile("s_nop 1\n\tv_mfma_f32_16x16x32_fp8_fp8 %0, %1, %2, %0\n\ts_nop 7\n\tv_mfma_f32_16x16x32_fp8_fp8 %0, %3, %4, %0\n\ts_nop 7\n\tv_mfma_f32_16x16x32_fp8_fp8 %0, %5, %6, %0\n\ts_nop 7\n\tv_mfma_f32_16x16x32_fp8_fp8 %0, %7, %8, %0" \
                     : "+v"(c) : "v"(_b0), "v"(_a0), "v"(_b1), "v"(_a1), "v"(_b2), "v"(_a2), "v"(_b3), "v"(_a3)); } while (0)
#else
#define FP8_MMA_ONE(c, b8, a8) asm volatile("v_mfma_f32_16x16x128_f8f6f4 %0, %1, %2, %0" : "+v"(c) : "v"(b8), "v"(a8))
#endif
#define PG8_WAIT_V(n) asm volatile("s_waitcnt vmcnt(" #n ")" ::: "memory")
#define PG8_WAIT_L(n) asm volatile("s_waitcnt lgkmcnt(" #n ")" ::: "memory")
#define PG8_BAR __builtin_amdgcn_s_barrier()
#define PG8_SCHED __builtin_amdgcn_sched_barrier(0)
#define PG8_AOFF(AO, u, ord) do { _Pragma("unroll") for (int _h = 0; _h < 2; ++_h) _Pragma("unroll") for (int _i = 0; _i < 2; ++_i) \
        (AO)[_h][_i] = (unsigned)((size_t)S.arow_i((ord), (u), _h * HALF + RA[_i]) * (size_t)K + (size_t)CA[_i]) * 2u; } while (0)
    Unit cur, nxt; int ui = 0;
    if (!S.next(0, cur)) return;
    f32x4 acc[2][2][4][2];
#pragma unroll
    for (int a = 0; a < 2; ++a)
#pragma unroll
        for (int b = 0; b < 2; ++b)
#pragma unroll
            for (int m = 0; m < 4; ++m)
#pragma unroll
                for (int n = 0; n < 2; ++n) acc[a][b][m][n] = (f32x4){0.f, 0.f, 0.f, 0.f};
    i32x8 At[4], B0[2], B1[2];
    unsigned ac[2][2], a2[2][2];
    PG8_AOFF(ac, cur, 0);
    const char* cB0 = S.bptr(cur, 0); const char* cB1 = S.bptr(cur, 1);
    PG8_STAGE_B(PG8_SB(0, 0), cB0); PG8_STAGE_A(PG8_SA(0, 0), ac, 0, 0); PG8_STAGE_B(PG8_SB(0, 1), cB1); PG8_STAGE_A(PG8_SA(0, 1), ac, 1, 0);
    if (wr == 1) PG8_BAR;
    PG8_WAIT_V(4); PG8_BAR;
    PG8_STAGE_B(PG8_SB(1, 0), cB0 + kstepB); PG8_STAGE_A(PG8_SA(1, 0), ac, 0, kstep); PG8_STAGE_B(PG8_SB(1, 1), cB1 + kstepB);
    PG8_WAIT_V(6); PG8_BAR;
    for (;;) {
        const bool has_next = S.next(ui + 1, nxt);
        const char* nB0 = has_next ? S.bptr(nxt, 0) : cB0; const char* nB1 = has_next ? S.bptr(nxt, 1) : cB1;
        typename P::Pre pre{};
        for (int t = 0; t < nt; t += 2) {
            const bool last = (t == nt - 2);
            if (last) { S.bias_issue(cur, lds + BIAS_OFF, wid, lane); pre = S.prefetch(cur, wr, wc, fr, fq); }
            if (last && has_next) { PG8_AOFF(a2, nxt, ui + 1); } else {
#pragma unroll
                for (int _h = 0; _h < 2; ++_h)
#pragma unroll
                    for (int _i = 0; _i < 2; ++_i) a2[_h][_i] = last ? ac[_h][_i] : ac[_h][_i] + (unsigned)((t + 2) * (BK * 2)); }
            const size_t k1 = (size_t)(t + 1) * kstep;
            const char* b20 = last ? nB0 : cB0 + (size_t)(t + 2) * kstepB; const char* b21 = last ? nB1 : cB1 + (size_t)(t + 2) * kstepB;
            PG8_LDB(B0, 0, 0); PG8_SCHED; PG8_LDA(At, 0, 0); PG8_STAGE_A(PG8_SA(1, 1), ac, 1, k1);
            PG8_WAIT_L(8); PG8_BAR; PG8_WAIT_L(0); PG8_MMA(0, 0, At, B0); PG8_BAR; PG8_SCHED;
            PG8_LDB(B1, 0, 1); PG8_STAGE_B(PG8_SB(0, 0), b20);
            PG8_BAR; PG8_WAIT_L(0); PG8_MMA(0, 1, At, B1); PG8_BAR;
            PG8_LDA(At, 0, 1); PG8_STAGE_A(PG8_SA(0, 0), a2, 0, 0);
            PG8_BAR; PG8_WAIT_L(0); PG8_MMA(1, 0, At, B0); PG8_BAR; PG8_SCHED;
            PG8_STAGE_B(PG8_SB(0, 1), b21);
            PG8_WAIT_V(6); PG8_BAR; PG8_MMA(1, 1, At, B1); PG8_BAR;
            PG8_LDB(B0, 1, 0); PG8_SCHED; PG8_LDA(At, 1, 0); PG8_STAGE_A(PG8_SA(0, 1), a2, 1, 0);
            PG8_WAIT_L(8); PG8_BAR; PG8_WAIT_L(0); PG8_MMA(0, 0, At, B0); PG8_BAR; PG8_SCHED;
            PG8_LDB(B1, 1, 1); PG8_STAGE_B(PG8_SB(1, 0), b20 + kstepB);
            PG8_BAR; PG8_WAIT_L(0); PG8_MMA(0, 1, At, B1); PG8_BAR;
            PG8_LDA(At, 1, 1); PG8_STAGE_A(PG8_SA(1, 0), a2, 0, kstep);
            PG8_BAR; PG8_WAIT_L(0); PG8_MMA(1, 0, At, B0); PG8_BAR; PG8_SCHED;
            PG8_STAGE_B(PG8_SB(1, 1), b21 + kstepB);
            PG8_WAIT_V(6); PG8_BAR; PG8_MMA(1, 1, At, B1); PG8_BAR;
        }
        if constexpr (P::FP8) asm volatile("s_nop 15\n\ts_nop 15" ::: "memory");
        S.epi(acc, cur, wr, wc, fr, fq, S.bias_read(lds + BIAS_OFF, wc, fq, pre));
        if (!has_next) break;
#pragma unroll
        for (int a = 0; a < 2; ++a)
#pragma unroll
            for (int b = 0; b < 2; ++b)
#pragma unroll
                for (int m = 0; m < 4; ++m)
#pragma unroll
                    for (int n = 0; n < 2; ++n) acc[a][b][m][n] = (f32x4){0.f, 0.f, 0.f, 0.f};
        cur = nxt; cB0 = nB0; cB1 = nB1; ++ui;
#pragma unroll
        for (int _h = 0; _h < 2; ++_h)
#pragma unroll
            for (int _i = 0; _i < 2; ++_i) ac[_h][_i] = a2[_h][_i];
    }
    PG8_WAIT_V(0);
    if (wr == 0) PG8_BAR;
    PG8_BAR;
#undef PG8_SA
#undef PG8_SB
#undef PG8_STAGE_A
#undef PG8_STAGE_B
#undef PG8_LDA
#undef PG8_LDB
#undef PG8_MMA
#undef PG8_WAIT_V
#undef PG8_WAIT_L
#undef PG8_BAR
#undef PG8_SCHED
#undef PG8_AOFF
}
}
using pg8::Unit;

struct Frame {
    LAS unsigned char* lds;
    volatile LAS unsigned* MISC;
    unsigned* ctl;
    unsigned char* ws;
    int tid, lane, wave, G, bid;
    const float* const* in;
    float* out;
};
#define WSP(T, off) ((T*)(F.ws + (off)))

__device__ __forceinline__ void transpose_load(const float* __restrict__ W, int N, int item, int lane, f32x4 (&v)[16]) {
    const int nblk = (N + 63) / 64, kb = item / nblk, nb = item % nblk, k0 = 64 * kb, n0 = 64 * nb;
    const int lk = lane >> 4, ln = (lane & 15) * 4; const bool ok = n0 + ln < N;
#pragma unroll
    for (int i = 0; i < 16; ++i) v[i] = ok ? *(const f32x4*)(W + (size_t)(k0 + 4 * i + lk) * N + n0 + ln) : (f32x4){0.f, 0.f, 0.f, 0.f};
}
__device__ __forceinline__ void transpose_finish(int K, int N, bf16_t* __restrict__ WT, int row_off, LAS float* scr, int item, int lane, const f32x4 (&v)[16]) {
    const int nblk = (N + 63) / 64, kb = item / nblk, nb = item % nblk, k0 = 64 * kb, n0 = 64 * nb;
    const int lk = lane >> 4, ln = (lane & 15) * 4;
#pragma unroll
    for (int i = 0; i < 16; ++i) { LAS float* d = scr + (4 * i + lk) * 65 + ln; d[0] = v[i].x; d[1] = v[i].y; d[2] = v[i].z; d[3] = v[i].w; }
    LDS_WAIT(); asm volatile("" ::: "memory");
    const int c = lane & 7;
#pragma unroll
    for (int j = 0; j < 8; ++j) { const int n = (lane >> 3) + 8 * j; const LAS float* s = scr + (8 * c) * 65 + n;
        if (n0 + n < N) { u32x4 o; o.x = cvt_pk_bf16(s[0 * 65], s[1 * 65]); o.y = cvt_pk_bf16(s[2 * 65], s[3 * 65]); o.z = cvt_pk_bf16(s[4 * 65], s[5 * 65]); o.w = cvt_pk_bf16(s[6 * 65], s[7 * 65]);
            *(u32x4*)(WT + (size_t)(row_off + n0 + n) * K + k0 + 8 * c) = o; } }
    LDS_WAIT(); asm volatile("" ::: "memory");
}
constexpr int TI_PER_MAT = (D / 64) * (D / 64);
constexpr int TI_WIN = (D / 64) * ((NIN + 63) / 64);
constexpr int TI_SMALL = TI_WIN + TI_PER_MAT;
constexpr int TI_EXP = 3 * NE * TI_PER_MAT;
#ifndef NCONV_SCAN
#define NCONV_SCAN 168
#endif
#ifndef NCONV_WG
#define NCONV_WG 20
#endif
#ifndef TI_EARLY_PCT
#define TI_EARLY_PCT 12
#endif
__host__ __device__ constexpr int ti_early(int G) { return (G > 2 * NCONV_WG) ? (TI_EXP / 100) * TI_EARLY_PCT : 0; }
__device__ __forceinline__ void transpose_small_load(Frame& F, int it, f32x4 (&v)[16]) {
    if (it < TI_WIN) transpose_load(F.in[I_WIN], NIN, it, F.lane, v); else transpose_load(F.in[I_WOUT], D, it - TI_WIN, F.lane, v);
}
__device__ __forceinline__ void transpose_small_finish(Frame& F, int it, LAS float* scr, const f32x4 (&v)[16]) {
    if (it < TI_WIN) transpose_finish(D, NIN, WSP(bf16_t, WS_WIN), 0, scr, it, F.lane, v); else transpose_finish(D, D, WSP(bf16_t, WS_WOUT), 0, scr, it - TI_WIN, F.lane, v);
}
__device__ __forceinline__ void convert_load(Frame& F, int it, f32x4 (&v)[16]) {
    const int mat = it / TI_PER_MAT, r = it % TI_PER_MAT, type = mat / NE, e = mat % NE, kb = r >> 3, n4 = (r & 7) * 256 + F.lane * 4;
    const float* src = F.in[type == 0 ? I_WGATE : (type == 1 ? I_WUP : I_WDOWN)] + (size_t)e * D * D + (size_t)(kb * 16) * D + n4;
#pragma unroll
    for (int i = 0; i < 16; ++i) v[i] = __builtin_nontemporal_load((const f32x4*)(src + (size_t)i * D));
}
__device__ __forceinline__ void convert_store(Frame& F, int it, const f32x4 (&v)[16]) {
    const int mat = it / TI_PER_MAT, r = it % TI_PER_MAT, type = mat / NE, e = mat % NE, kb = r >> 3, n4 = (r & 7) * 256 + F.lane * 4;
    unsigned char* dst = F.ws + (type == 0 ? WS_WG : (type == 1 ? WS_WU : WS_WD)) + (size_t)e * D * D + ((size_t)kb * D + n4) * 16;
#pragma unroll
    for (int nn = 0; nn < 4; ++nn)
        *(u32x4*)(dst + nn * 16) = (u32x4){pk_fp8x4(v[0][nn] * W8_SCALE, v[1][nn] * W8_SCALE, v[2][nn] * W8_SCALE, v[3][nn] * W8_SCALE), pk_fp8x4(v[4][nn] * W8_SCALE, v[5][nn] * W8_SCALE, v[6][nn] * W8_SCALE, v[7][nn] * W8_SCALE),
                                          pk_fp8x4(v[8][nn] * W8_SCALE, v[9][nn] * W8_SCALE, v[10][nn] * W8_SCALE, v[11][nn] * W8_SCALE), pk_fp8x4(v[12][nn] * W8_SCALE, v[13][nn] * W8_SCALE, v[14][nn] * W8_SCALE, v[15][nn] * W8_SCALE)};
}
__device__ __forceinline__ void convert_experts(Frame& F, int gw, int NGW, int it0, int it1) {
    f32x4 A[16], B[16];
    for (int it = it0 + gw; it < it1; it += 2 * NGW) {
        const int i2 = it + NGW; const bool h2 = i2 < it1;
        convert_load(F, it, A); convert_load(F, h2 ? i2 : it, B); __builtin_amdgcn_sched_barrier(0);
        convert_store(F, it, A);
        if (h2) convert_store(F, i2, B);
    }
}
__device__ __forceinline__ void p0_prologue(Frame& F) {
    LAS float* red = (LAS float*)F.lds;
    const float* c = F.in[I_C]; const float* cctx = F.in[I_CCTX]; const float* wada = F.in[I_WADA];
    float* modp = WSP(float, WS_MODP);
    const int gw = F.bid * 8 + F.wave, NGW = F.G * 8;
    f32x4 tc[16], tn[16];
    if (gw < TI_SMALL) transpose_small_load(F, gw, tc);
    for (int it = F.bid; it < NPART * 32; it += F.G) {
        const int kq = it / 32, cg = it % 32, kb = kq * 256 + F.wave * 32, col = cg * 384 + F.lane * 4, col2 = cg * 384 + 256 + (F.lane & 31) * 4; const bool ex = F.lane < 32;
        f32x4 a0 = {0.f, 0.f, 0.f, 0.f}, a1 = a0, a2 = a0, b0 = a0, b1 = a0, b2 = a0;
#pragma unroll 8
        for (int i = 0; i < 32; ++i) { const int k = kb + i; const f32x4 wv = *(const f32x4*)(wada + (size_t)k * (6 * D) + col); f32x4 wx = {0.f, 0.f, 0.f, 0.f}; if (ex) wx = *(const f32x4*)(wada + (size_t)k * (6 * D) + col2);
            const float s0 = silu_f(c[k]), s1 = silu_f(c[D + k]), s2 = silu_f(cctx[k]); a0 += wv * s0; a1 += wv * s1; a2 += wv * s2; b0 += wx * s0; b1 += wx * s1; b2 += wx * s2; }
        *(LAS f32x4*)(red + (F.wave * 3 + 0) * 384 + F.lane * 4) = a0; *(LAS f32x4*)(red + (F.wave * 3 + 1) * 384 + F.lane * 4) = a1; *(LAS f32x4*)(red + (F.wave * 3 + 2) * 384 + F.lane * 4) = a2;
        if (ex) { *(LAS f32x4*)(red + (F.wave * 3 + 0) * 384 + 256 + F.lane * 4) = b0; *(LAS f32x4*)(red + (F.wave * 3 + 1) * 384 + 256 + F.lane * 4) = b1; *(LAS f32x4*)(red + (F.wave * 3 + 2) * 384 + 256 + F.lane * 4) = b2; }
        __syncthreads();
        for (int idx = F.tid; idx < 3 * 384; idx += 512) { const int v = idx / 384, cc = idx % 384; float s = 0.f;
#pragma unroll
            for (int w = 0; w < 8; ++w) s += red[(w * 3 + v) * 384 + cc];
            modp[(size_t)(kq * 3 + v) * (6 * D) + cg * 384 + cc] = s; }
        __syncthreads();
    }
    LAS float* scr = (LAS float*)(F.lds + F.wave * (64 * 65 * 4));
    for (int it = gw; it < TI_SMALL; it += NGW) {
        if (it + NGW < TI_SMALL) transpose_small_load(F, it + NGW, tn);
        transpose_small_finish(F, it, scr, tc);
#pragma unroll
        for (int i = 0; i < 16; ++i) tc[i] = tn[i];
    }
}

__device__ __forceinline__ const float* row_src(Frame& F, int row) { return row < ML ? F.in[I_X] + (size_t)row * D : F.in[I_CTX] + (size_t)(row - ML) * D; }
__device__ __forceinline__ int row_vec(int row) { return row < SEQ ? 0 : (row < ML ? 1 : 2); }
__device__ __forceinline__ void p1_ln0(Frame& F) {
    const int rpw = (MTOT + F.G - 1) / F.G, r0 = F.bid * rpw, r1 = (r0 + rpw < MTOT) ? r0 + rpw : MTOT;
    const float* modp = WSP(const float, WS_MODP); const float* bada = F.in[I_BADA];
    LAS float* SC = (LAS float*)F.lds;
    LAS float* SH = SC + 3 * D;
    if (r0 < r1) {
        const int vlo = row_vec(r0), vhi = row_vec(r1 - 1);
        for (int v = vlo; v <= vhi; ++v)
            for (int d = F.tid; d < D; d += 512) { float sh = bada[d], sc = bada[D + d];
#pragma unroll
                for (int p = 0; p < NPART; ++p) { sh += modp[(size_t)(p * 3 + v) * (6 * D) + d]; sc += modp[(size_t)(p * 3 + v) * (6 * D) + D + d]; }
                const float g0 = F.in[I_LN0G][d], b0 = F.in[I_LN0B][d];
                SC[v * D + d] = g0 * (1.f + sc); SH[v * D + d] = b0 * (1.f + sc) + sh; }
    }
    __syncthreads();
    bf16_t* HM = WSP(bf16_t, WS_HM); f32x2* st = WSP(f32x2, WS_STAT0);
    f32x4 xn[8];
    if (r0 + F.wave < r1) { const f32x4* xr = (const f32x4*)row_src(F, r0 + F.wave) + F.lane;
#pragma unroll
        for (int j = 0; j < 8; ++j) xn[j] = xr[64 * j]; }
    for (int row = r0 + F.wave; row < r1; row += 8) {
        const int v = row_vec(row);
        f32x4 x[8]; float s = 0.f;
#pragma unroll
        for (int j = 0; j < 8; ++j) { x[j] = xn[j]; s += (x[j].x + x[j].y) + (x[j].z + x[j].w); }
        if (row + 8 < r1) { const f32x4* xr = (const f32x4*)row_src(F, row + 8) + F.lane;
#pragma unroll
            for (int j = 0; j < 8; ++j) xn[j] = xr[64 * j]; }
        const float mean = wave_sum(s) * (1.f / D); float s2 = 0.f;
#pragma unroll
        for (int j = 0; j < 8; ++j) { x[j] = x[j] - mean; s2 += (x[j].x * x[j].x + x[j].y * x[j].y) + (x[j].z * x[j].z + x[j].w * x[j].w); }
        const float rstd = 1.f / sqrtf(wave_sum(s2) * (1.f / D) + LN_EPS);
        if (F.lane == 0) st[row] = (f32x2){mean, rstd};
        u32x2* o = (u32x2*)(HM + (size_t)row * D) + F.lane;
#pragma unroll
        for (int j = 0; j < 8; ++j) { const int d = 4 * F.lane + 256 * j; const f32x4 a = *(const LAS f32x4*)(SC + v * D + d), b = *(const LAS f32x4*)(SH + v * D + d);
            const f32x4 y = x[j] * rstd * a + b; u32x2 w; w.x = cvt_pk_bf16(y.x, y.y); w.y = cvt_pk_bf16(y.z, y.w); o[64 * j] = w; }
    }
    float* modf = WSP(float, WS_MODF);
    for (int idx = F.bid * 512 + F.tid; idx < 3 * 6 * D; idx += F.G * 512) { const int v = idx / (6 * D), n = idx % (6 * D); float s = bada[n];
#pragma unroll
        for (int p = 0; p < NPART; ++p) s += modp[(size_t)(p * 3 + v) * (6 * D) + n];
        modf[idx] = s; }
}

struct NoPre {};
struct InProj {
    static constexpr bool PERM = true, GATHER = false, FP8 = false, BBLK = false; typedef NoPre Pre;
    __device__ __forceinline__ Pre prefetch(const Unit&, int, int, int, int) const { return Pre{}; }
    __device__ __forceinline__ void bias_issue(const Unit&, LAS unsigned char*, int, int) const {}
    __device__ __forceinline__ Pre bias_read(const LAS unsigned char*, int, int, const Pre& p) const { return p; }
    int K; const char* A; const char* Bt; bf16_t* P; int G, c;
    __device__ __forceinline__ bool next(int i, Unit& u) const {
        const int L = i * G + c; constexpr int NMAIN = (ML / 256) * (NINP / 256), NCTXT = (GIN + 255) / 256;
        if (L < NMAIN) { pg8::tile_order(L, ML / 256, NINP / 256, u.pm, u.pn); u.e = 0; return true; }
        const int j = L - NMAIN; if (j >= (MC / 256) * NCTXT) return false;
        u.pm = ML / 256 + j / NCTXT; u.pn = j % NCTXT; u.e = 0; return true;
    }
    __device__ __forceinline__ const char* bptr(const Unit& u, int half) const { return Bt + (size_t)(u.pn * 256 + half * 128) * K * 2; }
    __device__ __forceinline__ unsigned arow_i(int, const Unit& u, int r) const { return (unsigned)(u.pm * 256 + r); }
    __device__ __forceinline__ void epi(const f32x4 (&acc)[2][2][4][2], const Unit& u, int wr, int wc, int fr, int fq, const Pre&) const {
        const int row0 = u.pm * 256 + wr * 64 + fr, col0 = u.pn * 256 + wc * 32 + 8 * fq;
#pragma unroll
        for (int ai = 0; ai < 2; ++ai)
#pragma unroll
            for (int m = 0; m < 4; ++m) { bf16_t* rowp = P + (size_t)(row0 + ai * 128 + m * 16) * NINP + col0;
#pragma unroll
                for (int bj = 0; bj < 2; ++bj) { const f32x4 v0 = acc[ai][bj][m][0], v1 = acc[ai][bj][m][1];
                    u32x4 w; w.x = cvt_pk_bf16(v0[0], v0[1]); w.y = cvt_pk_bf16(v0[2], v0[3]); w.z = cvt_pk_bf16(v1[0], v1[1]); w.w = cvt_pk_bf16(v1[2], v1[3]);
                    *(u32x4*)(rowp + bj * 128) = w; } }
    }
};

typedef float f32x16 __attribute__((ext_vector_type(16)));
typedef __bf16 bf2_t __attribute__((ext_vector_type(2)));
__device__ __forceinline__ unsigned pk(float a, float b) { f32x2 v = {a, b}; return __builtin_bit_cast(unsigned, __builtin_convertvector(v, bf2_t)); }
__device__ __forceinline__ bf16_t f2bf(float a) { return (bf16_t)(pk(a, 0.f) & 0xffffu); }
#define MFMA16(a, b, c) __builtin_amdgcn_mfma_f32_16x16x32_bf16((a), (b), (c), 0, 0, 0)
#define MFMA32(a, b, c) __builtin_amdgcn_mfma_f32_32x32x16_bf16((a), (b), (c), 0, 0, 0)
__device__ __forceinline__ void unit_rows(int b, int cidx, int& rowbase, int& segbase, int& len) {
    if (cidx < CTXL / 64) { segbase = ML + b * CTXL; len = CTXL; rowbase = segbase + cidx * 64; }
    else { segbase = b * SEQ; len = SEQ; rowbase = segbase + (cidx - CTXL / 64) * 64; }
}
constexpr int TOKB = 9;
__device__ __forceinline__ int tok_seg(int r) { return r < ML ? r / SEQ : NBATCH + (r - ML) / CTXL; }
template <bool MASKED>
__device__ __forceinline__ void tok_block(const bf16_t* P, bf16_t* QKVb, const float* cw, int b0, int nrow, int lane) {
#pragma unroll 1
    for (int jj = 0; jj < 6; ++jj) {
        const int col = jj * 512 + lane * 8;
        u32x4 R[TOKB + 4];
#pragma unroll
        for (int t = 0; t < TOKB + 4; ++t) { const int r = b0 - 2 + t; const bool ok = !MASKED || (r >= 0 && r < MTOT);
            R[t] = (u32x4){0u, 0u, 0u, 0u}; if (ok) R[t] = *(const u32x4*)(P + (size_t)r * NINP + col); }
        f32x4 cwr[5][2];
#pragma unroll
        for (int i = 0; i < 5; ++i) { cwr[i][0] = *(const f32x4*)(cw + i * GQKV + col); cwr[i][1] = *(const f32x4*)(cw + i * GQKV + col + 4); }
#pragma unroll
        for (int rr = 0; rr < TOKB; ++rr) {
            if (rr < nrow) { const int row = b0 + rr;
                float a[8];
#pragma unroll
                for (int q = 0; q < 8; ++q) a[q] = 0.f;
#pragma unroll
                for (int i = 0; i < 5; ++i) { const f32x4 w0 = cwr[i][0], w1 = cwr[i][1]; u32x4 p = R[rr + i];
                    if (MASKED) { const int tr = row + i - 2; const bool v = tr >= 0 && tr < MTOT && tok_seg(tr < 0 ? 0 : (tr < MTOT ? tr : MTOT - 1)) == tok_seg(row); if (!v) p = (u32x4){0u, 0u, 0u, 0u}; }
                    a[0] += bf_lo(p.x) * w0.x; a[1] += bf_hi(p.x) * w0.y; a[2] += bf_lo(p.y) * w0.z; a[3] += bf_hi(p.y) * w0.w;
                    a[4] += bf_lo(p.z) * w1.x; a[5] += bf_hi(p.z) * w1.y; a[6] += bf_lo(p.w) * w1.z; a[7] += bf_hi(p.w) * w1.w; }
                float ss = 0.f;
#pragma unroll
                for (int q = 0; q < 8; ++q) { a[q] = silu_f(a[q]); ss += a[q] * a[q]; }
                if (jj < 4) { ss += __shfl_xor(ss, 1); ss += __shfl_xor(ss, 2); ss += __shfl_xor(ss, 4); ss += __shfl_xor(ss, 8);
                    float sc = __builtin_amdgcn_rsqf(ss + 1e-6f); if (jj < 2) sc *= 0.08838834764831845f;
#pragma unroll
                    for (int q = 0; q < 8; ++q) a[q] *= sc; }
                *(u32x4*)(QKVb + (size_t)row * GQKV + col) = (u32x4){pk(a[0], a[1]), pk(a[2], a[3]), pk(a[4], a[5]), pk(a[6], a[7])}; }
        }
    }
}
__device__ __forceinline__ void p3a_tokens(Frame& F) {
    const bf16_t* P = WSP(const bf16_t, WS_P); bf16_t* QKVb = WSP(bf16_t, WS_QKVB); float* GBf = WSP(float, WS_GBF);
    const float* cw = F.in[I_CONVQKV];
    int tz_ = threadIdx.x; asm volatile("" : "+v"(tz_));
    const int lane_ = tz_ & 63, wave_ = __builtin_amdgcn_readfirstlane(tz_ >> 6);
    for (int blk = F.bid * 8 + wave_; blk * TOKB < MTOT; blk += F.G * 8) {
        const int b0 = blk * TOKB, nrow = (b0 + TOKB <= MTOT) ? TOKB : MTOT - b0;
        const bool clean = b0 >= 2 && b0 + TOKB + 1 < MTOT && tok_seg(b0 - 2) == tok_seg(b0 + TOKB + 1);
        if (clean) tok_block<false>(P, QKVb, cw, b0, nrow, lane_); else tok_block<true>(P, QKVb, cw, b0, nrow, lane_);
        if (lane_ < 32) { const int i = lane_ & 15; float gv[TOKB];
#pragma unroll
            for (int rr = 0; rr < TOKB; ++rr) gv[rr] = (rr < nrow) ? bf2f(P[(size_t)(b0 + rr) * NINP + (lane_ < 16 ? COL_A : COL_B) + i]) : 0.f;
            const float al = -__expf(F.in[I_ALOG][i]), dt = F.in[I_DTB][i];
#pragma unroll
            for (int rr = 0; rr < TOKB; ++rr) if (rr < nrow) { const float v = gv[rr]; GBf[(size_t)(b0 + rr) * 32 + lane_] = (lane_ < 16) ? al * softplus_f(v + dt) : sigmoid_f(v); } }
    }
}
constexpr int PL_QS = 0, PL_KS = 17408, PL_KBG = 34816, PL_VB = 53248, PL_AM = 71680, PL_QKM = 89088, PL_TB = 106496, PL_EGC = 115712, PL_EKD = 115968, PL_TF = 116224, PL_GC = 133632, PL_BETA = 133888;
constexpr int QP = 136, TP = 72, FP = 68;
#define MFMA4F(a, b, c) __builtin_amdgcn_mfma_f32_16x16x4f32((a), (b), (c), 0, 0, 0)
__device__ __forceinline__ void p3_prep(Frame& F) {
    const bf16_t* QKVb = WSP(const bf16_t, WS_QKVB); const float* GBf = WSP(const float, WS_GBF);
    LAS bf16_t* Qs = (LAS bf16_t*)(F.lds + PL_QS); LAS bf16_t* Ks = (LAS bf16_t*)(F.lds + PL_KS); LAS bf16_t* KbgT = (LAS bf16_t*)(F.lds + PL_KBG); LAS bf16_t* VbT = (LAS bf16_t*)(F.lds + PL_VB);
    LAS float* Am = (LAS float*)(F.lds + PL_AM); LAS float* QKm = (LAS float*)(F.lds + PL_QKM); LAS bf16_t* Tb = (LAS bf16_t*)(F.lds + PL_TB); LAS float* Tf = (LAS float*)(F.lds + PL_TF);
    LAS float* egc_s = (LAS float*)(F.lds + PL_EGC); LAS float* ekd_s = (LAS float*)(F.lds + PL_EKD); LAS float* gc_s = (LAS float*)(F.lds + PL_GC); LAS float* beta_s = (LAS float*)(F.lds + PL_BETA);
    LAS bf16_t* Ws = Qs; LAS bf16_t* Us = Ks;
    int tz = threadIdx.x; asm volatile("" : "+v"(tz));
    const int tid = tz, lane = tz & 63, w = __builtin_amdgcn_readfirstlane(tz >> 6), l15 = lane & 15, l4 = lane >> 4, r31 = lane & 31, hh = lane >> 5;
    u32x4 pre[3][2]; float pg = 0.f, pb = 0.f;
#define PREP_LOAD(uid_) do { const int _dir = (uid_) & 1, _h = ((uid_) >> 1) & 7, _cb = (uid_) >> 4, _cidx = _cb % NCHUNK, _b = _cb / NCHUNK; int _rb, _sb, _ln; unit_rows(_b, _cidx, _rb, _sb, _ln); \
        _Pragma("unroll") for (int _p = 0; _p < 3; ++_p) _Pragma("unroll") for (int _hf = 0; _hf < 2; ++_hf) { const int _r = 2 * (tid >> 4) + _hf; \
            pre[_p][_hf] = *(const u32x4*)(QKVb + (size_t)(_rb + (_dir ? 63 - _r : _r)) * GQKV + _p * GQK + _h * 128 + (tid & 15) * 8); } \
        { const size_t _pr = (size_t)(_rb + (_dir ? 63 - lane : lane)); pg = GBf[_pr * 32 + _dir * 8 + _h]; pb = GBf[_pr * 32 + 16 + _dir * 8 + _h]; } } while (0)
    if (F.bid < NUNITS) PREP_LOAD(F.bid);
    for (int uid = F.bid; uid < NUNITS; uid += F.G) {
        unsigned char* ub = F.ws + WS_PREP + (size_t)uid * UNIT_BYTES;
        float gc = pg; const float beta = pb;
#pragma unroll
        for (int off = 1; off < 64; off <<= 1) { const float t = __shfl_up(gc, off); if (lane >= off) gc += t; }
        const float glast = __shfl(gc, 63), egcv = __expf(gc);
        if (w == 0) { egc_s[lane] = egcv; ekd_s[lane] = __expf(glast - gc); gc_s[lane] = gc; beta_s[lane] = beta; }
        { const int r0 = 2 * (tid >> 4), c16 = tid & 15;
          const float br0 = __shfl(beta, r0), br1 = __shfl(beta, r0 + 1), sk0 = br0 * __shfl(egcv, r0), sk1 = br1 * __shfl(egcv, r0 + 1);
          const int rs = (((r0 >> 3) ^ (c16 >> 1)) << 3) + (r0 & 7);
          *(LAS u32x4*)(Qs + r0 * QP + c16 * 8) = pre[0][0]; *(LAS u32x4*)(Qs + (r0 + 1) * QP + c16 * 8) = pre[0][1];
          *(LAS u32x4*)(Ks + r0 * QP + c16 * 8) = pre[1][0]; *(LAS u32x4*)(Ks + (r0 + 1) * QP + c16 * 8) = pre[1][1];
#pragma unroll
          for (int e = 0; e < 4; ++e) { const unsigned k0 = pre[1][0][e], k1 = pre[1][1][e], v0 = pre[2][0][e], v1 = pre[2][1][e];
              *(LAS unsigned*)(KbgT + (c16 * 8 + 2 * e) * TP + rs) = pk(bf_lo(k0) * sk0, bf_lo(k1) * sk1); *(LAS unsigned*)(KbgT + (c16 * 8 + 2 * e + 1) * TP + rs) = pk(bf_hi(k0) * sk0, bf_hi(k1) * sk1);
              *(LAS unsigned*)(VbT + (c16 * 8 + 2 * e) * TP + rs) = pk(bf_lo(v0) * br0, bf_lo(v1) * br1); *(LAS unsigned*)(VbT + (c16 * 8 + 2 * e + 1) * TP + rs) = pk(bf_hi(v0) * br0, bf_hi(v1) * br1); } }
        if (uid + F.G < NUNITS) PREP_LOAD(uid + F.G);
        __syncthreads();
        { const bool isq = w >= 4; const int rt = w & 3; const LAS bf16_t* X = isq ? Qs : Ks; LAS float* OUT = isq ? QKm : Am;
          bf16x8 af[4], bfr[4][4];
#pragma unroll
          for (int ks = 0; ks < 4; ++ks) af[ks] = *(const LAS bf16x8*)(X + (rt * 16 + l15) * QP + 32 * ks + 8 * l4);
#pragma unroll
          for (int st = 0; st < 4; ++st)
#pragma unroll
              for (int ks = 0; ks < 4; ++ks) bfr[st][ks] = *(const LAS bf16x8*)(Ks + (st * 16 + l15) * QP + 32 * ks + 8 * l4);
          const f32x4 gcr4 = *(const LAS f32x4*)(gc_s + rt * 16 + 4 * l4), br4 = *(const LAS f32x4*)(beta_s + rt * 16 + 4 * l4);
          float gcs4[4];
#pragma unroll
          for (int st = 0; st < 4; ++st) gcs4[st] = gc_s[st * 16 + l15];
#pragma unroll
          for (int st = 0; st < 4; ++st) { f32x4 acc = {0.f, 0.f, 0.f, 0.f};
#pragma unroll
              for (int ks = 0; ks < 4; ++ks) acc = MFMA16(af[ks], bfr[st][ks], acc);
              const int sidx = st * 16 + l15; const float gcs = gcs4[st];
#pragma unroll
              for (int reg = 0; reg < 4; ++reg) { const int ridx = rt * 16 + 4 * l4 + reg; const float gcr = gcr4[reg], br = br4[reg];
                  const float e = __expf(fminf(gcr - gcs, 0.f));
                  const float val = isq ? (ridx >= sidx ? acc[reg] * e : 0.f) : (ridx > sidx ? br * acc[reg] * e : 0.f);
                  OUT[ridx * FP + sidx] = val; } } }
#pragma unroll
        for (int q2 = 0; q2 < 2; ++q2) { const int frag = w + 8 * q2;
            { const int mt = frag >> 3, kt = (frag >> 1) & 3, s2 = frag & 1, row = 32 * mt + r31, col0 = 32 * kt + 16 * s2 + 4 * hh; const float e = egc_s[row];
              const u32x2 lo = *(const LAS u32x2*)(Qs + row * QP + col0), hi = *(const LAS u32x2*)(Qs + row * QP + col0 + 8);
              *(u32x4*)(ub + UO_QD + frag * 1024 + lane * 16) = (u32x4){pk(bf_lo(lo.x) * e, bf_hi(lo.x) * e), pk(bf_lo(lo.y) * e, bf_hi(lo.y) * e), pk(bf_lo(hi.x) * e, bf_hi(hi.x) * e), pk(bf_lo(hi.y) * e, bf_hi(hi.y) * e)}; }
            { const int kt = frag >> 2, ct = (frag >> 1) & 1, s2 = frag & 1; float v[8];
#pragma unroll
              for (int j = 0; j < 8; ++j) { const int tok = 32 * ct + 16 * s2 + 8 * (j >> 2) + 4 * hh + (j & 3); v[j] = bf2f(Ks[tok * QP + 32 * kt + r31]); }
              { const int t0 = 32 * ct + 16 * s2 + 4 * hh; const f32x4 e0 = *(const LAS f32x4*)(ekd_s + t0), e1 = *(const LAS f32x4*)(ekd_s + t0 + 8);
                v[0] *= e0.x; v[1] *= e0.y; v[2] *= e0.z; v[3] *= e0.w; v[4] *= e1.x; v[5] *= e1.y; v[6] *= e1.z; v[7] *= e1.w; }
              *(u32x4*)(ub + UO_KDT + frag * 1024 + lane * 16) = (u32x4){pk(v[0], v[1]), pk(v[2], v[3]), pk(v[4], v[5]), pk(v[6], v[7])}; } }
        __syncthreads();
        if (w < 4) { float t[16];
            f32x4 ar[4];
#pragma unroll
            for (int c4 = 0; c4 < 4; ++c4) ar[c4] = *(const LAS f32x4*)(Am + (16 * w + l15) * FP + 16 * w + 4 * c4);
#pragma unroll
            for (int i = 0; i < 16; ++i) { float a0 = (i == lane) ? 1.f : 0.f;
#pragma unroll
                for (int m = 0; m < i; ++m) { const float av = ar[m >> 2][m & 3];
                    a0 -= __builtin_bit_cast(float, __builtin_amdgcn_readlane(__builtin_bit_cast(int, av), i)) * t[m]; }
                t[i] = a0; }
            if (lane < 16) {
#pragma unroll
                for (int i = 0; i < 16; ++i) Tf[(16 * w + i) * FP + 16 * w + lane] = t[i]; } }
        __syncthreads();
#pragma unroll
        for (int lv = 1; lv < 4; ++lv) {
            if (w < 4 - lv) { const int bj = w, bi = w + lv;
                f32x4 aop[3]; float bop[3][4];
#pragma unroll
                for (int t = 0; t < lv; ++t) { const int bk = bj + t; aop[t] = *(const LAS f32x4*)(Am + (16 * bi + l15) * FP + 16 * bk + 4 * l4);
#pragma unroll
                    for (int ks = 0; ks < 4; ++ks) bop[t][ks] = Tf[(16 * bk + 4 * l4 + ks) * FP + 16 * bj + l15]; }
                const f32x4 tdg = *(const LAS f32x4*)(Tf + (16 * bi + l15) * FP + 16 * bi + 4 * l4);
                f32x4 x = {0.f, 0.f, 0.f, 0.f};
#pragma unroll
                for (int t = 0; t < lv; ++t)
#pragma unroll
                    for (int ks = 0; ks < 4; ++ks) x = MFMA4F(aop[t][ks], bop[t][ks], x);
                f32x4 y = {0.f, 0.f, 0.f, 0.f};
#pragma unroll
                for (int ks = 0; ks < 4; ++ks) y = MFMA4F(tdg[ks], x[ks], y);
#pragma unroll
                for (int reg = 0; reg < 4; ++reg) Tf[(16 * bi + 4 * l4 + reg) * FP + 16 * bj + l15] = -y[reg]; }
            __syncthreads();
        }
#pragma unroll
        for (int q = 0; q < 4; ++q) { const int idx = tid + 512 * q, i = idx >> 5, j = (idx & 31) * 2; const f32x2 tv = *(const LAS f32x2*)(Tf + i * FP + j);
            *(LAS unsigned*)(Tb + i * TP + j) = pk(j <= i ? tv.x : 0.f, j + 1 <= i ? tv.y : 0.f); }
        __syncthreads();
        { bf16x8 bu[2], bw[2];
#pragma unroll
          for (int ks = 0; ks < 2; ++ks) { const int ch = 8 * ((4 * ks + l4) ^ w);
              bu[ks] = *(const LAS bf16x8*)(VbT + (w * 16 + l15) * TP + ch); bw[ks] = *(const LAS bf16x8*)(KbgT + (w * 16 + l15) * TP + ch); }
#pragma unroll
          for (int rt = 0; rt < 4; ++rt) { const bf16x8 a0 = *(const LAS bf16x8*)(Tb + (rt * 16 + l15) * TP + 8 * l4), a1 = *(const LAS bf16x8*)(Tb + (rt * 16 + l15) * TP + 32 + 8 * l4);
              f32x4 au = {0.f, 0.f, 0.f, 0.f}, aw = {0.f, 0.f, 0.f, 0.f};
              au = MFMA16(bu[0], a0, au); au = MFMA16(bu[1], a1, au); aw = MFMA16(bw[0], a0, aw); aw = MFMA16(bw[1], a1, aw);
              { const int r = rt * 16 + l15, f0 = w * 16 + 4 * l4;
                *(LAS u32x2*)(Us + r * QP + f0) = (u32x2){pk(au[0], au[1]), pk(au[2], au[3])}; *(LAS u32x2*)(Ws + r * QP + f0) = (u32x2){pk(-aw[0], -aw[1]), pk(-aw[2], -aw[3])}; } } }
        __syncthreads();
#pragma unroll
        for (int q2 = 0; q2 < 2; ++q2) { const int frag = w + 8 * q2, mt = frag >> 3, kt = (frag >> 1) & 3, s2 = frag & 1, row = 32 * mt + r31, col0 = 32 * kt + 16 * s2 + 4 * hh;
            const u32x2 lo = *(const LAS u32x2*)(Ws + row * QP + col0), hi = *(const LAS u32x2*)(Ws + row * QP + col0 + 8);
            *(u32x4*)(ub + UO_NW + frag * 1024 + lane * 16) = (u32x4){lo.x, lo.y, hi.x, hi.y}; }
        { const int mt = w >> 2, nt = w & 3; unsigned o[8];
#pragma unroll
          for (int p = 0; p < 8; ++p) { const int reg0 = 2 * p, row0 = 32 * mt + (reg0 & 3) + 8 * (reg0 >> 2) + 4 * hh;
              o[p] = (unsigned)Us[row0 * QP + 32 * nt + r31] | ((unsigned)Us[(row0 + 1) * QP + 32 * nt + r31] << 16); }
          *(u32x4*)(ub + UO_U + w * 2048 + lane * 32) = (u32x4){o[0], o[1], o[2], o[3]}; *(u32x4*)(ub + UO_U + w * 2048 + lane * 32 + 16) = (u32x4){o[4], o[5], o[6], o[7]}; }
        { const int mt = w >> 2, ct = (w >> 1) & 1, s2 = w & 1, row = 32 * mt + r31, col0 = 32 * ct + 16 * s2 + 4 * hh;
          const f32x4 x0 = *(const LAS f32x4*)(QKm + row * FP + col0), x1 = *(const LAS f32x4*)(QKm + row * FP + col0 + 8);
          *(u32x4*)(ub + UO_QK + w * 1024 + lane * 16) = (u32x4){pk(x0.x, x0.y), pk(x0.z, x0.w), pk(x1.x, x1.y), pk(x1.z, x1.w)}; }
        if (tid == 0) *(float*)(ub + UO_DL) = __expf(glast);
        __syncthreads();
    }
#undef PREP_LOAD
}

__device__ __forceinline__ bf16x8 pack_step(const f32x16& x, int s) { return __builtin_bit_cast(bf16x8, ((u32x4){pk(x[8 * s], x[8 * s + 1]), pk(x[8 * s + 2], x[8 * s + 3]), pk(x[8 * s + 4], x[8 * s + 5]), pk(x[8 * s + 6], x[8 * s + 7])})); }
__device__ __forceinline__ void p4_scan(Frame& F) {
    constexpr int NSCAN = NBATCH * NH * 2;
    if (F.bid >= NSCAN) {
        const int nconv = (F.G - NSCAN) < NCONV_SCAN ? (F.G - NSCAN) : NCONV_SCAN;
        if (F.bid - NSCAN < nconv) convert_experts(F, (F.bid - NSCAN) * 8 + F.wave, nconv * 8, ti_early(F.G), TI_EXP);
        return;
    }
    const int b = F.bid >> 4, h = (F.bid >> 1) & 7, dir = F.bid & 1, lane = F.lane;
    const unsigned char* prep = F.ws + WS_PREP;
#define STEP_CIDX(n) (dir ? ((n) < CTXL / 64 ? CTXL / 64 - 1 - (n) : NCHUNK + CTXL / 64 - 1 - (n)) : (n))
#define STEP_UNIT(n) (prep + (size_t)((((b * NCHUNK + STEP_CIDX(n)) * NH + h) * 2) + dir) * UNIT_BYTES)
    const int wv = F.wave;
#define ISSUE(n) do { const unsigned char* _ub = STEP_UNIT(n); LAS unsigned char* _lb = F.lds + ((n) & 1) * UNIT_DMA; _Pragma("unroll") for (int _p = 0; _p < 10; ++_p) \
            if (_p * 8 + wv < UNIT_DMA / 1024) __builtin_amdgcn_global_load_lds((const unsigned*)(_ub + (_p * 8 + wv) * 1024 + lane * 16), (LAS unsigned*)(_lb + (_p * 8 + wv) * 1024), 16, 0, 0); } while (0)
    ISSUE(0);
    if (F.wave >= 4) {
        for (int n = 0; n < NCHUNK; ++n) { VM_WAIT(); __builtin_amdgcn_s_barrier(); asm volatile("" ::: "memory"); if (n + 1 < NCHUNK) ISSUE(n + 1); }
        VM_WAIT();
        return;
    }
    const int nt = F.wave, c = lane & 31, hh = lane >> 5;
    bf16_t* OGb = WSP(bf16_t, WS_OGB) + (size_t)dir * ML * 1024;
    f32x16 S[4];
#pragma unroll
    for (int kt = 0; kt < 4; ++kt)
#pragma unroll
        for (int i = 0; i < 16; ++i) S[kt][i] = 0.f;
    bool stored = false;
#pragma unroll 1
    for (int n = 0; n < NCHUNK; ++n) {
        if (stored) asm volatile("s_waitcnt vmcnt(32)" ::: "memory"); else VM_WAIT();
        __builtin_amdgcn_s_barrier(); asm volatile("" ::: "memory");
        if (n + 1 < NCHUNK) ISSUE(n + 1);
        const LAS unsigned char* lb = F.lds + (n & 1) * UNIT_DMA;
        const float dlc = *(const LAS float*)(lb + UO_DL);
        u32x4 ucur[2][2];
#pragma unroll
        for (int mt = 0; mt < 2; ++mt) { ucur[mt][0] = *(const LAS u32x4*)(lb + UO_U + (mt * 4 + nt) * 2048 + lane * 32); ucur[mt][1] = *(const LAS u32x4*)(lb + UO_U + (mt * 4 + nt) * 2048 + lane * 32 + 16); }
#define FRAG(off, idx) (*(const LAS bf16x8*)(lb + (off) + (idx) * 1024 + lane * 16))
        f32x16 VN[2], O[2];
#pragma unroll
        for (int mt = 0; mt < 2; ++mt) {
#pragma unroll
            for (int p = 0; p < 4; ++p) { VN[mt][2 * p] = bf_lo(ucur[mt][0][p]); VN[mt][2 * p + 1] = bf_hi(ucur[mt][0][p]); VN[mt][8 + 2 * p] = bf_lo(ucur[mt][1][p]); VN[mt][8 + 2 * p + 1] = bf_hi(ucur[mt][1][p]); }
#pragma unroll
            for (int i = 0; i < 16; ++i) O[mt][i] = 0.f; }
#pragma unroll
        for (int kt = 0; kt < 4; ++kt) { const bf16x8 sb0 = pack_step(S[kt], 0), sb1 = pack_step(S[kt], 1);
#pragma unroll
            for (int mt = 0; mt < 2; ++mt) { const int fi = (mt * 4 + kt) * 2;
                VN[mt] = MFMA32(FRAG(UO_NW, fi), sb0, VN[mt]); VN[mt] = MFMA32(FRAG(UO_NW, fi + 1), sb1, VN[mt]);
                O[mt] = MFMA32(FRAG(UO_QD, fi), sb0, O[mt]); O[mt] = MFMA32(FRAG(UO_QD, fi + 1), sb1, O[mt]); } }
        bf16x8 vb[2][2];
#pragma unroll
        for (int ct = 0; ct < 2; ++ct) { vb[ct][0] = pack_step(VN[ct], 0); vb[ct][1] = pack_step(VN[ct], 1); }
#pragma unroll
        for (int mt = 0; mt < 2; ++mt)
#pragma unroll
            for (int ct = 0; ct < 2; ++ct) { const int fi = (mt * 2 + ct) * 2; O[mt] = MFMA32(FRAG(UO_QK, fi), vb[ct][0], O[mt]); O[mt] = MFMA32(FRAG(UO_QK, fi + 1), vb[ct][1], O[mt]); }
#pragma unroll
        for (int kt = 0; kt < 4; ++kt) {
#pragma unroll
            for (int i = 0; i < 16; ++i) S[kt][i] *= dlc;
#pragma unroll
            for (int ct = 0; ct < 2; ++ct) { const int fi = (kt * 2 + ct) * 2; S[kt] = MFMA32(FRAG(UO_KDT, fi), vb[ct][0], S[kt]); S[kt] = MFMA32(FRAG(UO_KDT, fi + 1), vb[ct][1], S[kt]); } }
#undef FRAG
        const int cidx = STEP_CIDX(n);
        stored = cidx >= CTXL / 64;
        if (cidx >= CTXL / 64) { const int rowbase = b * SEQ + (cidx - CTXL / 64) * 64;
#pragma unroll
            for (int mt = 0; mt < 2; ++mt)
#pragma unroll
                for (int reg = 0; reg < 16; ++reg) { const int row = 32 * mt + (reg & 3) + 8 * (reg >> 2) + 4 * hh, prow = rowbase + (dir ? 63 - row : row);
                    OGb[(size_t)prow * 1024 + h * 128 + 32 * nt + c] = f2bf(O[mt][reg]); } }
    }
    VM_WAIT();
#undef ISSUE
#undef STEP_CIDX
#undef STEP_UNIT
}

struct MixRow { u32x4 oa[2], ob[2], zz[2], sb[2], cv[3][2], xv[3][2]; };
__device__ __forceinline__ MixRow mix_load(const bf16_t* P, const bf16_t* OGb, int row, int f0, int c0, bool horiz) {
    MixRow m; const int t = row % SEQ, gr = t / 64, gc = t % 64, dlt = horiz ? 1 : 64;
    const bool hasp = horiz ? (gc > 0) : (gr > 0), hasn = horiz ? (gc < 63) : (gr < SEQ / 64 - 1);
#pragma unroll
    for (int q = 0; q < 2; ++q) { m.oa[q] = *(const u32x4*)(OGb + (size_t)row * 1024 + f0 + 8 * q); m.ob[q] = *(const u32x4*)(OGb + (size_t)ML * 1024 + (size_t)row * 1024 + f0 + 8 * q);
        m.zz[q] = *(const u32x4*)(P + (size_t)row * NINP + COL_Z + f0 + 8 * q); m.sb[q] = *(const u32x4*)(P + (size_t)row * NINP + COL_SB + c0 + 8 * q); }
#pragma unroll
    for (int i = 0; i < 3; ++i) { const bool ok = i == 1 || (i == 0 ? hasp : hasn); const size_t rr = (size_t)(row + (ok ? (i - 1) * dlt : 0));
#pragma unroll
        for (int q = 0; q < 2; ++q) { m.cv[i][q] = *(const u32x4*)(P + rr * NINP + COL_SC + c0 + 8 * q); m.xv[i][q] = *(const u32x4*)(P + rr * NINP + COL_SX + c0 + 8 * q);
            if (!ok) m.cv[i][q] = (u32x4){0u, 0u, 0u, 0u}; } }
    return m;
}
__device__ __forceinline__ void p5_mix_out(Frame& F) {
    const bf16_t* P = WSP(const bf16_t, WS_P); const bf16_t* OGb = WSP(const bf16_t, WS_OGB); bf16_t* Y = WSP(bf16_t, WS_Y);
    const float* nw = F.in[I_GNW]; const float* cs = F.in[I_CONVSC];
    const int gw = F.bid * 8 + F.wave, NGW = F.G * 8;
    const int f0 = F.lane * 16, c0 = F.lane * 16; const bool horiz = c0 < 512;
    LAS float* nwL = (LAS float*)F.lds; LAS float* csL = nwL + 128;
    if (F.tid < 128) nwL[F.tid] = nw[F.tid];
    for (int i = F.tid; i < 3 * 1024; i += 512) csL[i] = cs[i];
    __syncthreads();
    if (gw >= ML) return;
    MixRow nx = mix_load(P, OGb, gw, f0, c0, horiz);
    for (int row = gw; row < ML; row += NGW) {
        const MixRow m = nx;
        if (row + NGW < ML) nx = mix_load(P, OGb, row + NGW, f0, c0, horiz);
        { float o[16]; float ss = 0.f;
#pragma unroll
          for (int q = 0; q < 2; ++q)
#pragma unroll
              for (int e = 0; e < 4; ++e) { const float s0 = bf_lo(m.oa[q][e]) + bf_lo(m.ob[q][e]), s1 = bf_hi(m.oa[q][e]) + bf_hi(m.ob[q][e]); o[8 * q + 2 * e] = s0; o[8 * q + 2 * e + 1] = s1; ss += s0 * s0 + s1 * s1; }
          ss += __shfl_xor(ss, 1); ss += __shfl_xor(ss, 2); ss += __shfl_xor(ss, 4);
          const float r = __builtin_amdgcn_rsqf(ss * (1.f / 128.f) + RMS_EPS);
          unsigned ow[8];
#pragma unroll
          for (int q = 0; q < 8; ++q) { const int f = (f0 + 2 * q) & 127; const unsigned zw = m.zz[q >> 2][q & 3];
              const float y0 = o[2 * q] * r * nwL[f] * silu_f(bf_lo(zw)), y1 = o[2 * q + 1] * r * nwL[f + 1] * silu_f(bf_hi(zw)); ow[q] = cvt_pk_bf16(y0, y1); }
          *(u32x4*)(Y + (size_t)row * D + f0) = (u32x4){ow[0], ow[1], ow[2], ow[3]}; *(u32x4*)(Y + (size_t)row * D + f0 + 8) = (u32x4){ow[4], ow[5], ow[6], ow[7]}; }
        { float acc[16];
#pragma unroll
          for (int q = 0; q < 16; ++q) acc[q] = 0.f;
#pragma unroll
          for (int i = 0; i < 3; ++i)
#pragma unroll
              for (int hh = 0; hh < 2; ++hh)
#pragma unroll
                  for (int q = 0; q < 4; ++q) { const int ch = c0 + 8 * hh + 2 * q; const unsigned cw = m.cv[i][hh][q], xw = m.xv[i][hh][q];
                      acc[8 * hh + 2 * q] += bf_lo(cw) * bf_lo(xw) * csL[i * 1024 + ch]; acc[8 * hh + 2 * q + 1] += bf_hi(cw) * bf_hi(xw) * csL[i * 1024 + ch + 1]; }
          unsigned ow[8];
#pragma unroll
          for (int q = 0; q < 8; ++q) { const unsigned bw = m.sb[q >> 2][q & 3]; ow[q] = cvt_pk_bf16(bf_lo(bw) * acc[2 * q], bf_hi(bw) * acc[2 * q + 1]); }
          *(u32x4*)(Y + (size_t)row * D + 1024 + c0) = (u32x4){ow[0], ow[1], ow[2], ow[3]}; *(u32x4*)(Y + (size_t)row * D + 1024 + c0 + 8) = (u32x4){ow[4], ow[5], ow[6], ow[7]}; }
    }
}

struct OutProj {
    static constexpr bool PERM = true, GATHER = false, FP8 = false, BBLK = false; typedef NoPre Pre;
    __device__ __forceinline__ Pre prefetch(const Unit&, int, int, int, int) const { return Pre{}; }
    __device__ __forceinline__ void bias_issue(const Unit&, LAS unsigned char*, int, int) const {}
    __device__ __forceinline__ Pre bias_read(const LAS unsigned char*, int, int, const Pre& p) const { return p; }
    int K; const char* A; const char* Bt; bf16_t* V; const float* x; const f32x2* st0; const float* g0; const float* b0; const float* modf; int G, c;
    __device__ __forceinline__ bool next(int i, Unit& u) const { const int L = i * G + c; if (L >= (ML / 256) * (D / 256)) return false; pg8::tile_order(L, ML / 256, D / 256, u.pm, u.pn); u.e = 0; return true; }
    __device__ __forceinline__ const char* bptr(const Unit& u, int half) const { return Bt + (size_t)(u.pn * 256 + half * 128) * K * 2; }
    __device__ __forceinline__ unsigned arow_i(int, const Unit& u, int r) const { return (unsigned)(u.pm * 256 + r); }
    __device__ __forceinline__ void epi(const f32x4 (&acc)[2][2][4][2], const Unit& u, int wr, int wc, int fr, int fq, const Pre&) const {
        const int row0 = u.pm * 256 + wr * 64 + fr, col0 = u.pn * 256 + wc * 32 + 8 * fq;
        const float* gt1 = modf + (size_t)(u.pm * 256 / SEQ) * (6 * D) + 2 * D;
        constexpr int XW = 4;
        f32x4 XA[16], XB[16]; f32x2 SS[16]; f32x4 PG[2][2], PB[2][2], PT[2][2];
#define OP_ROW(it_) (row0 + (((it_) >> 2) & 1) * 128 + ((it_) & 3) * 16)
#define OP_COL(it_) (col0 + ((it_) >> 3) * 128)
#define OP_LOAD(it_) do { SS[it_] = st0[OP_ROW(it_)]; XA[it_] = *(const f32x4*)(x + (size_t)OP_ROW(it_) * D + OP_COL(it_)); XB[it_] = *(const f32x4*)(x + (size_t)OP_ROW(it_) * D + OP_COL(it_) + 4); } while (0)
#define OP_PARAMS(bj_) do { const int _c = col0 + (bj_) * 128; PG[bj_][0] = *(const f32x4*)(g0 + _c); PG[bj_][1] = *(const f32x4*)(g0 + _c + 4); PB[bj_][0] = *(const f32x4*)(b0 + _c); PB[bj_][1] = *(const f32x4*)(b0 + _c + 4); \
            PT[bj_][0] = *(const f32x4*)(gt1 + _c); PT[bj_][1] = *(const f32x4*)(gt1 + _c + 4); } while (0)
        OP_PARAMS(0);
#pragma unroll
        for (int it = 0; it < XW; ++it) OP_LOAD(it);
#pragma unroll
        for (int it = 0; it < 16; ++it) { const int bj = it >> 3, ai = (it >> 2) & 1, m = it & 3; const f32x2 sv = SS[it];
            const f32x4 va = ((XA[it] - sv.x) * sv.y * PG[bj][0] + PB[bj][0]) * DN_ALPHA + PT[bj][0] * acc[ai][bj][m][0], vb = ((XB[it] - sv.x) * sv.y * PG[bj][1] + PB[bj][1]) * DN_ALPHA + PT[bj][1] * acc[ai][bj][m][1];
            *(u32x4*)(V + (size_t)OP_ROW(it) * D + OP_COL(it)) = (u32x4){cvt_pk_bf16(va[0], va[1]), cvt_pk_bf16(va[2], va[3]), cvt_pk_bf16(vb[0], vb[1]), cvt_pk_bf16(vb[2], vb[3])};
            if (it == 3) OP_PARAMS(1);
            if (it + XW < 16) OP_LOAD(it + XW); }
#undef OP_ROW
#undef OP_COL
#undef OP_LOAD
#undef OP_PARAMS
    }
};

constexpr int UT_PITCH = D + 4;
__device__ __forceinline__ void p7_ln1_router(Frame& F) {
    int tz_ = threadIdx.x; asm volatile("" : "+v"(tz_));
    const int tid_ = tz_, lane_ = tz_ & 63, wave_ = __builtin_amdgcn_readfirstlane(tz_ >> 6);
    LAS float* uT = (LAS float*)F.lds;
    LAS float* part = uT + 16 * UT_PITCH;
    LAS float* logit = part + 8 * 16 * 32;
    const bf16_t* V = WSP(const bf16_t, WS_V); f32x2* st1 = WSP(f32x2, WS_STAT1); const float* modf = WSP(const float, WS_MODF); unsigned char* U8 = WSP(unsigned char, WS_U);
    const float* g1 = F.in[I_LN1G]; const float* b1 = F.in[I_LN1B]; const float* wrt = F.in[I_WR]; const float* brt = F.in[I_BR];
    int* toke = WSP(int, WS_TOKE); int* tokp = WSP(int, WS_TOKP); float* tokg = WSP(float, WS_TOKG); int* list = WSP(int, WS_LIST);
    const int r16 = lane_ & 15, kk = lane_ >> 4;
    u32x2 vw[2][8];
#define LN1_LOAD(tile_) do { _Pragma("unroll") for (int _rr = 0; _rr < 2; ++_rr) { const u32x2* _xr = (const u32x2*)(V + (size_t)((tile_) * 16 + wave_ * 2 + _rr) * D) + lane_; \
            _Pragma("unroll") for (int _j = 0; _j < 8; ++_j) vw[_rr][_j] = _xr[64 * _j]; } } while (0)
    if (F.bid < ML / 16) LN1_LOAD(F.bid);
    for (int tile = F.bid; tile < ML / 16; tile += F.G) {
        const int rbase = tile * 16; const int bidx = rbase / SEQ; const float* sh2 = modf + (size_t)bidx * (6 * D) + 3 * D; const float* sc2 = sh2 + D;
        f32x4 pa[8], pc[8];
        unsigned dofs = 4u * (unsigned)lane_; asm volatile("" : "+v"(dofs));
#pragma unroll
        for (int j = 0; j < 8; ++j) { const f32x4 sc = *(const f32x4*)((sc2 + 256 * j) + dofs) + 1.f;
            pa[j] = *(const f32x4*)((g1 + 256 * j) + dofs) * sc; pc[j] = *(const f32x4*)((b1 + 256 * j) + dofs) * sc + *(const f32x4*)((sh2 + 256 * j) + dofs);
            if (j == 3) asm volatile("" ::: "memory"); }
#pragma unroll
        for (int rr = 0; rr < 2; ++rr) {
            const int lr = wave_ * 2 + rr, row = rbase + lr;
            f32x4 x[8]; float s = 0.f;
#pragma unroll
            for (int j = 0; j < 8; ++j) { const u32x2 w = vw[rr][j]; x[j] = (f32x4){bf_lo(w.x), bf_hi(w.x), bf_lo(w.y), bf_hi(w.y)}; s += (x[j].x + x[j].y) + (x[j].z + x[j].w); }
            const float mean = wave_sum(s) * (1.f / D); float s2 = 0.f;
#pragma unroll
            for (int j = 0; j < 8; ++j) { x[j] = x[j] - mean; s2 += (x[j].x * x[j].x + x[j].y * x[j].y) + (x[j].z * x[j].z + x[j].w * x[j].w); }
            const float rstd = 1.f / sqrtf(wave_sum(s2) * (1.f / D) + LN_EPS);
            if (lane_ == 0) st1[row] = (f32x2){mean, rstd}; unsigned* uo = (unsigned*)(U8 + (size_t)row * D) + lane_;
#pragma unroll
            for (int j = 0; j < 8; ++j) { const int d = 4 * lane_ + 256 * j;
                const f32x4 u = (x[j] * rstd) * pa[j] + pc[j];
                uo[64 * j] = pk_fp8x4(u.x, u.y, u.z, u.w);
                *(LAS f32x4*)(uT + lr * UT_PITCH + d) = u; }
        }
        unsigned wlo = (unsigned)(4 * kk * NE + r16); asm volatile("" : "+v"(wlo));
        float wl[16][4][2]; asm volatile("" ::: "memory");
#define RW_LOAD(m_) do { _Pragma("unroll") for (int _j = 0; _j < 4; ++_j) _Pragma("unroll") for (int _nt = 0; _nt < 2; ++_nt) \
            wl[m_][_j][_nt] = (wrt + (256 * wave_ + 16 * (m_)) * NE)[wlo + (unsigned)(_j * NE + 16 * _nt)]; } while (0)
#pragma unroll
        for (int m = 0; m < 12; ++m) RW_LOAD(m);
        __syncthreads();
        f32x4 lacc[2] = {{0.f, 0.f, 0.f, 0.f}, {0.f, 0.f, 0.f, 0.f}};
#pragma unroll
        for (int m = 0; m < 16; ++m) { const f32x4 a = *(const LAS f32x4*)(uT + r16 * UT_PITCH + 256 * wave_ + 16 * m + 4 * kk);
#pragma unroll
            for (int j = 0; j < 4; ++j) { lacc[0] = __builtin_amdgcn_mfma_f32_16x16x4f32(a[j], wl[m][j][0], lacc[0], 0, 0, 0); lacc[1] = __builtin_amdgcn_mfma_f32_16x16x4f32(a[j], wl[m][j][1], lacc[1], 0, 0, 0); }
            if (m == 3) { __builtin_amdgcn_sched_barrier(0); RW_LOAD(12); RW_LOAD(13); RW_LOAD(14); RW_LOAD(15); __builtin_amdgcn_sched_barrier(0); } }
#undef RW_LOAD
#pragma unroll
        for (int nt = 0; nt < 2; ++nt)
#pragma unroll
            for (int q = 0; q < 4; ++q) part[(wave_ * 16 + 4 * kk + q) * 32 + 16 * nt + r16] = lacc[nt][q];
        __syncthreads();
        if (tile + F.G < ML / 16) LN1_LOAD(tile + F.G);
        { const int lr = tid_ >> 5, e = tid_ & 31; float s = brt[e];
#pragma unroll
          for (int w = 0; w < 8; ++w) s += part[(w * 16 + lr) * 32 + e];
          logit[lr * 32 + e] = s; }
        __syncthreads();
        if (tid_ < 16) { const int row = rbase + tid_; float lv[32];
#pragma unroll
            for (int e = 0; e < 32; ++e) lv[e] = logit[tid_ * 32 + e];
            float tv[4]; int ti[4];
#pragma unroll
            for (int s4 = 0; s4 < 4; ++s4) { float best = -3.0e38f; int bi = 0;
#pragma unroll
                for (int e = 0; e < 32; ++e) { const bool take = lv[e] > best; best = take ? lv[e] : best; bi = take ? e : bi; }
                tv[s4] = best; ti[s4] = bi;
#pragma unroll
                for (int e = 0; e < 32; ++e) lv[e] = (e == bi) ? -3.0e38f : lv[e]; }
            const float e0 = 1.f, e1 = __expf(tv[1] - tv[0]), e2 = __expf(tv[2] - tv[0]), e3 = __expf(tv[3] - tv[0]); const float inv = 1.f / (e0 + e1 + e2 + e3);
            const float gg[4] = {e0 * inv, e1 * inv, e2 * inv, e3 * inv};
            int pos[4];
#pragma unroll
            for (int s4 = 0; s4 < 4; ++s4) pos[s4] = (int)__hip_atomic_fetch_add(F.ctl + CW_CNT + 64 * ti[s4], 1u, __ATOMIC_RELAXED, __HIP_MEMORY_SCOPE_AGENT);
            *(i32x4*)(toke + row * 4) = (i32x4){ti[0], ti[1], ti[2], ti[3]}; *(f32x4*)(tokg + row * 4) = (f32x4){gg[0], gg[1], gg[2], gg[3]};
            *(i32x4*)(tokp + row * 4) = (i32x4){pos[0], pos[1], pos[2], pos[3]};
#pragma unroll
            for (int s4 = 0; s4 < 4; ++s4) list[(size_t)ti[s4] * ML + pos[s4]] = row; }
        __syncthreads();
    }
#undef LN1_LOAD
}

struct MoeTab { const LAS int* cnt; const LAS int* pstart; };
__device__ __forceinline__ void moe_tables(Frame& F) {
    LAS int* cnt = (LAS int*)(F.lds + TAB_OFF); LAS int* ps = cnt + 32;
    if (F.tid < 32) cnt[F.tid] = (int)__hip_atomic_load(F.ctl + CW_CNT + 64 * F.tid, __ATOMIC_RELAXED, __HIP_MEMORY_SCOPE_AGENT);
    __syncthreads();
    if (F.tid == 0) { int a = 0; for (int e = 0; e < 32; ++e) { ps[e] = a; a += (cnt[e] + 255) / 256 * 256; } ps[32] = a; }
    __syncthreads();
    if (F.tid < MAXTILES) { int e = 0; const int r = F.tid * 256;
#pragma unroll
        for (int q = 1; q < 32; ++q) e = (ps[q] <= r) ? q : e;
        ps[48 + F.tid] = e; }
    __syncthreads();
}
__device__ __forceinline__ int moe_tile_expert(const LAS int* ps, int tile) { return ps[48 + tile]; }

struct MoeUp {
    static constexpr bool PERM = true, GATHER = true, FP8 = true, BBLK = true;
    int K, NB; const char* A; const char* Wg; const char* Wu; unsigned char* H; const float* bg; const float* bu; const int* list; const LAS int* cnt; const LAS int* ps; const LAS int* gtab; int G, c;
    __device__ __forceinline__ bool next(int i, Unit& u) const {
        const int NT = ps[32] / 256, NU = NT * 16, L = i * G + c; if (L >= NU) return false;
        pg8::tile_order(L, NT, 16, u.pm, u.pn); u.e = moe_tile_expert(ps, u.pm); return true;
    }
    __device__ __forceinline__ const char* bptr(const Unit& u, int half) const { return (half ? Wu : Wg) + (size_t)u.e * D * D + (size_t)(u.pn * 128) * 16; }
    __device__ __forceinline__ unsigned arow(const Unit& u, int r) const { const int loc = u.pm * 256 + r - ps[u.e]; return loc < cnt[u.e] ? (unsigned)list[(size_t)u.e * ML + loc] : 0u; }
    __device__ __forceinline__ unsigned arow_i(int ord, const Unit&, int r) const { return (unsigned)gtab[ord * 256 + r]; }
    struct Pre { f32x4 g0, g1, u0, u1; };
    __device__ __forceinline__ Pre prefetch(const Unit&, int, int, int, int) const { return Pre{}; }
    __device__ __forceinline__ void bias_issue(const Unit& u, LAS unsigned char* dst, int wid, int lane) const {
        if (wid == 0) { const float* src = (lane < 32 ? bg : bu) + (size_t)u.e * D + u.pn * 128 + (lane & 31) * 4;
            __builtin_amdgcn_global_load_lds((const unsigned*)src, (LAS unsigned*)dst, 16, 0, 0); } }
    __device__ __forceinline__ Pre bias_read(const LAS unsigned char* src, int wc, int fq, const Pre&) const { const LAS float* b = (const LAS float*)src + wc * 32 + 8 * fq; Pre p;
        p.g0 = *(const LAS f32x4*)(b); p.g1 = *(const LAS f32x4*)(b + 4); p.u0 = *(const LAS f32x4*)(b + 128); p.u1 = *(const LAS f32x4*)(b + 132); return p; }
    __device__ __forceinline__ void epi(const f32x4 (&acc)[2][2][4][2], const Unit& u, int wr, int wc, int fr, int fq, const Pre& pre) const {
        const int row0 = u.pm * 256 + wr * 64 + fr, col0 = u.pn * 128 + wc * 32 + 8 * fq;
        const f32x4 g0 = pre.g0, g1 = pre.g1, u0 = pre.u0, u1 = pre.u1;
#pragma unroll
        for (int ai = 0; ai < 2; ++ai)
#pragma unroll
            for (int m = 0; m < 4; ++m) { float hv[8];
#pragma unroll
                for (int n = 0; n < 2; ++n)
#pragma unroll
                    for (int jp = 0; jp < 2; ++jp) { const int j = 2 * jp;
                        const f32x2 bgv = n ? (f32x2){g1[j], g1[j + 1]} : (f32x2){g0[j], g0[j + 1]}, buv = n ? (f32x2){u1[j], u1[j + 1]} : (f32x2){u0[j], u0[j + 1]};
                        f32x2 glu = (f32x2){acc[ai][0][m][n][j], acc[ai][0][m][n][j + 1]} * (1.f / W8_SCALE) + bgv, lin = (f32x2){acc[ai][1][m][n][j], acc[ai][1][m][n][j + 1]} * (1.f / W8_SCALE) + buv;
                        glu.x = fminf(glu.x, 7.0f); glu.y = fminf(glu.y, 7.0f); lin.x = __builtin_amdgcn_fmed3f(lin.x, -7.0f, 7.0f); lin.y = __builtin_amdgcn_fmed3f(lin.y, -7.0f, 7.0f);
                        const f32x2 ea = glu * (-1.702f * 1.4426950408889634f); f32x2 dn; dn.x = __builtin_amdgcn_exp2f(ea.x); dn.y = __builtin_amdgcn_exp2f(ea.y); dn = dn + 1.0f;
                        f32x2 sg; sg.x = __builtin_amdgcn_rcpf(dn.x); sg.y = __builtin_amdgcn_rcpf(dn.y);
                        const f32x2 hh2 = (glu * sg) * (lin * H8_SCALE + H8_SCALE); hv[4 * n + j] = hh2.x; hv[4 * n + j + 1] = hh2.y; }
                *(u32x2*)(H + (size_t)(row0 + ai * 128 + m * 16) * D + col0) = (u32x2){pk_fp8x4(hv[0], hv[1], hv[2], hv[3]), pk_fp8x4(hv[4], hv[5], hv[6], hv[7])}; }
    }
};
struct MoeDown {
    static constexpr bool PERM = true, GATHER = false, FP8 = true, BBLK = true;
    int K, NB; const char* A; const char* Wd; unsigned char* O; const float* bd; const LAS int* ps; int G, c;
    __device__ __forceinline__ bool next(int i, Unit& u) const {
        const int NT = ps[32] / 256, NU = NT * 8, L = i * G + c; if (L >= NU) return false;
        pg8::tile_order(L, NT, 8, u.pm, u.pn); u.e = moe_tile_expert(ps, u.pm); return true;
    }
    __device__ __forceinline__ const char* bptr(const Unit& u, int half) const { return Wd + (size_t)u.e * D * D + (size_t)(u.pn * 256 + half * 128) * 16; }
    __device__ __forceinline__ unsigned arow_i(int, const Unit& u, int r) const { return (unsigned)(u.pm * 256 + r); }
    struct Pre { f32x4 c[2][2]; };
    __device__ __forceinline__ Pre prefetch(const Unit&, int, int, int, int) const { return Pre{}; }
    __device__ __forceinline__ void bias_issue(const Unit& u, LAS unsigned char* dst, int wid, int lane) const {
        if (wid == 0) __builtin_amdgcn_global_load_lds((const unsigned*)(bd + (size_t)u.e * D + u.pn * 256 + lane * 4), (LAS unsigned*)dst, 16, 0, 0); }
    __device__ __forceinline__ Pre bias_read(const LAS unsigned char* src, int wc, int fq, const Pre&) const { const LAS float* b = (const LAS float*)src + wc * 32 + 8 * fq; Pre p;
#pragma unroll
        for (int bj = 0; bj < 2; ++bj) { p.c[bj][0] = *(const LAS f32x4*)(b + bj * 128); p.c[bj][1] = *(const LAS f32x4*)(b + bj * 128 + 4); }
        return p; }
    __device__ __forceinline__ void epi(const f32x4 (&acc)[2][2][4][2], const Unit& u, int wr, int wc, int fr, int fq, const Pre& pre) const {
        const int row0 = u.pm * 256 + wr * 64 + fr, col0 = u.pn * 256 + wc * 32 + 8 * fq;
#pragma unroll
        for (int bj = 0; bj < 2; ++bj) { const f32x4 c0 = pre.c[bj][0], c1 = pre.c[bj][1];
#pragma unroll
            for (int ai = 0; ai < 2; ++ai)
#pragma unroll
                for (int m = 0; m < 4; ++m) { const f32x4 v0 = acc[ai][bj][m][0] * (O8_SCALE / (W8_SCALE * H8_SCALE)) + c0 * O8_SCALE, v1 = acc[ai][bj][m][1] * (O8_SCALE / (W8_SCALE * H8_SCALE)) + c1 * O8_SCALE;
#define SAT8(x) __builtin_amdgcn_fmed3f((x), -448.f, 448.f)
                    *(u32x2*)(O + (size_t)(row0 + ai * 128 + m * 16) * D + col0 + bj * 128) = (u32x2){pk_fp8x4(SAT8(v0[0]), SAT8(v0[1]), SAT8(v0[2]), SAT8(v0[3])), pk_fp8x4(SAT8(v1[0]), SAT8(v1[1]), SAT8(v1[2]), SAT8(v1[3]))}; } }
#undef SAT8
    }
};

__device__ __forceinline__ void p10_final(Frame& F) {
    int tz_ = threadIdx.x; asm volatile("" : "+v"(tz_));
    const int tid_ = tz_, lane_ = tz_ & 63, wave_ = __builtin_amdgcn_readfirstlane(tz_ >> 6);
    const LAS int* ps = (const LAS int*)(F.lds + TAB_OFF) + 32;
    const unsigned char* O = WSP(const unsigned char, WS_O); const float* modf = WSP(const float, WS_MODF); const bf16_t* V = WSP(const bf16_t, WS_V); const f32x2* st1 = WSP(const f32x2, WS_STAT1);
    const float* g1 = F.in[I_LN1G]; const float* b1 = F.in[I_LN1B];
    const i32x4* toke = WSP(const i32x4, WS_TOKE); const i32x4* tokp = WSP(const i32x4, WS_TOKP); const f32x4* tokg = WSP(const f32x4, WS_TOKG);
    const float* g2 = F.in[I_LN2G]; const float* b2 = F.in[I_LN2B];
    const int gw = F.bid * 8 + wave_, NGW = F.G * 8;
    LAS float* PL = (LAS float*)F.lds;
    for (int i = tid_; i < D; i += 512) { PL[i] = g1[i]; PL[D + i] = b1[i]; PL[2 * D + i] = g2[i]; PL[3 * D + i] = b2[i]; PL[4 * D + i] = modf[5 * D + i]; PL[5 * D + i] = modf[(size_t)(6 * D) + 5 * D + i]; }
    __syncthreads();
    if (gw >= ML) return;
    i32x4 ne = toke[gw], np = tokp[gw]; f32x4 ng = tokg[gw];
    unsigned own[4][8]; u32x2 hwn[8]; f32x2 srn; f32x4 cgn;
#define FIN_GATHER(row_) do { _Pragma("unroll") for (int _s = 0; _s < 4; ++_s) { const unsigned* _or = (const unsigned*)(O + (size_t)(ps[ne[_s]] + np[_s]) * D) + lane_; \
            _Pragma("unroll") for (int _j = 0; _j < 8; ++_j) own[_s][_j] = _or[64 * _j]; } \
        { const u32x2* _hr = (const u32x2*)(V + (size_t)(row_) * D) + lane_; _Pragma("unroll") for (int _j = 0; _j < 8; ++_j) hwn[_j] = _hr[64 * _j]; } \
        srn = st1[row_]; cgn = ng; } while (0)
    FIN_GATHER(gw);
    if (gw + NGW < ML) { ne = toke[gw + NGW]; np = tokp[gw + NGW]; ng = tokg[gw + NGW]; }
    for (int row = gw; row < ML; row += NGW) {
        unsigned ow[4][8]; u32x2 hw[8];
#pragma unroll
        for (int s4 = 0; s4 < 4; ++s4)
#pragma unroll
            for (int j = 0; j < 8; ++j) ow[s4][j] = own[s4][j];
#pragma unroll
        for (int j = 0; j < 8; ++j) hw[j] = hwn[j];
        const f32x2 sr = srn; const f32x4 cg = cgn;
        if (row + NGW < ML) { FIN_GATHER(row + NGW);
            if (row + 2 * NGW < ML) { ne = toke[row + 2 * NGW]; np = tokp[row + 2 * NGW]; ng = tokg[row + 2 * NGW]; } }
        const LAS float* gt2 = PL + 4 * D + (row / SEQ) * D;
        f32x4 f[8]; float s = 0.f;
#pragma unroll
        for (int j = 0; j < 8; ++j) { f32x4 a = {0.f, 0.f, 0.f, 0.f};
#pragma unroll
            for (int s4 = 0; s4 < 4; ++s4) { const unsigned w = ow[s4][j]; const f32x2 lo = __builtin_amdgcn_cvt_pk_f32_fp8((int)w, false), hi = __builtin_amdgcn_cvt_pk_f32_fp8((int)w, true); a += (f32x4){lo.x, lo.y, hi.x, hi.y} * (cg[s4] * (1.f / O8_SCALE)); }
            const int d = 4 * lane_ + 256 * j; const u32x2 h = hw[j];
            const f32x4 h1 = ((f32x4){bf_lo(h.x), bf_hi(h.x), bf_lo(h.y), bf_hi(h.y)} - sr.x) * sr.y * *(const LAS f32x4*)(PL + d) + *(const LAS f32x4*)(PL + D + d);
            f[j] = h1 * DN_ALPHA + *(const LAS f32x4*)(gt2 + d) * a; s += (f[j].x + f[j].y) + (f[j].z + f[j].w);
            if (j & 1) __builtin_amdgcn_sched_barrier(0); }
        const float mean = wave_sum(s) * (1.f / D); float s2 = 0.f;
#pragma unroll
        for (int j = 0; j < 8; ++j) { f[j] = f[j] - mean; s2 += (f[j].x * f[j].x + f[j].y * f[j].y) + (f[j].z * f[j].z + f[j].w * f[j].w); }
        const float rstd = __builtin_amdgcn_rsqf(wave_sum(s2) * (1.f / D) + LN_EPS);
        f32x4* orw = (f32x4*)(F.out + (size_t)row * D) + lane_;
#pragma unroll
        for (int j = 0; j < 8; ++j) { const int d = 4 * lane_ + 256 * j; orw[64 * j] = f[j] * rstd * *(const LAS f32x4*)(PL + 2 * D + d) + *(const LAS f32x4*)(PL + 3 * D + d); }
    }
#undef FIN_GATHER
}

constexpr int NPHASE = 12;
__global__ void __launch_bounds__(512, 2) fwd_kernel(Args args) {
    extern __shared__ __attribute__((aligned(16))) unsigned char lds_raw[];
    Frame F;
    F.lds = (LAS unsigned char*)lds_raw; F.MISC = (volatile LAS unsigned*)(F.lds + MISC_OFF);
    F.tid = threadIdx.x; F.lane = F.tid & 63; F.wave = __builtin_amdgcn_readfirstlane(F.tid >> 6); F.G = gridDim.x; F.bid = blockIdx.x;
    F.ws = args.ws; F.ctl = (unsigned*)(args.ws + WS_CTL); F.in = args.in; F.out = args.out;
    if (F.tid < 128) ((LAS unsigned*)(F.lds + MISC_OFF))[F.tid] = 0u;
    __syncthreads();
    const int lo = args.ph_lo, hi = args.ph_hi;
    XcdBarrier bar; bar.bar = F.ctl + CW_BAR + args.li * XCD_BAR_WORDS; bar.x = 0; bar.st = nullptr;
    if (hi - lo > 1) bar = xcd_barrier_post(F.ctl + CW_BAR + args.li * XCD_BAR_WORDS, F.MISC);
#ifndef PH_MASK
#define PH_MASK 0xfff
#endif
#define IN(k) (((PH_MASK >> (k)) & 1) && lo <= (k) && (k) < hi)
#define SEAM(k) do { if (IN(k) && IN((k) + 1)) xcd_barrier(bar); } while (0)
#ifndef PROBE_DBL
#define PROBE_DBL -1
#endif
#define REP(k) for (int _rep = 0; _rep < ((PROBE_DBL == (k)) ? 2 : 1); ++_rep)
    if (IN(0)) REP(0) { p0_prologue(F); if (PROBE_DBL == 0) { VM_WAIT(); __syncthreads(); } } SEAM(0);
    if (IN(1)) REP(1) { p1_ln0(F); if (PROBE_DBL == 1) { VM_WAIT(); __syncthreads(); } } SEAM(1);
    if (IN(2)) REP(2) { const int gconv = (F.G > 2 * NCONV_WG) ? NCONV_WG : 0, ggemm = F.G - gconv;
                 if (F.bid < ggemm) { InProj S{D, (const char*)WSP(bf16_t, WS_HM), (const char*)WSP(bf16_t, WS_WIN), WSP(bf16_t, WS_P), ggemm, F.bid}; pg8::gemm_phase(F.lds, S); }
                 else if (PROBE_DBL != 2 || _rep == 0) convert_experts(F, (F.bid - ggemm) * 8 + F.wave, gconv * 8, 0, ti_early(F.G)); } SEAM(2);
    if (IN(3)) REP(3) { p3a_tokens(F); if (PROBE_DBL == 3) { VM_WAIT(); __syncthreads(); } } SEAM(3);
    if (IN(4)) REP(4) { p3_prep(F); if (PROBE_DBL == 4) { VM_WAIT(); __syncthreads(); } } SEAM(4);
    if (IN(5)) { p4_scan(F); if (PROBE_DBL == 5) { VM_WAIT(); __syncthreads(); p4_scan(F); } } SEAM(5);
    if (IN(6)) REP(6) { p5_mix_out(F); if (PROBE_DBL == 6) { VM_WAIT(); __syncthreads(); } } SEAM(6);
    if (IN(7)) REP(7) { OutProj S{D, (const char*)WSP(bf16_t, WS_Y), (const char*)WSP(bf16_t, WS_WOUT), WSP(bf16_t, WS_V), F.in[I_X], WSP(const f32x2, WS_STAT0), F.in[I_LN0G], F.in[I_LN0B], WSP(const float, WS_MODF), F.G, F.bid};
                 pg8::gemm_phase(F.lds, S); } SEAM(7);
    if (IN(8)) { p7_ln1_router(F); } SEAM(8);
    if (IN(9) || IN(10) || IN(11)) moe_tables(F);
    if (IN(9)) REP(9) { const LAS int* cnt = (const LAS int*)(F.lds + TAB_OFF);
                 LAS int* gtab = (LAS int*)(F.lds + GTAB_OFF);
                 MoeUp S{D / 2, D, (const char*)WSP(unsigned char, WS_U), (const char*)WSP(unsigned char, WS_WG), (const char*)WSP(unsigned char, WS_WU), WSP(unsigned char, WS_H), F.in[I_BGATE], F.in[I_BUP], WSP(const int, WS_LIST), cnt, cnt + 32, gtab, F.G, F.bid};
                 { int gi[GTAB_UNITS / 2];
#pragma unroll
                   for (int k = 0; k < GTAB_UNITS / 2; ++k) { const int i = 2 * k + (F.tid >> 8); Unit u; gi[k] = -1; if (S.next(i, u)) gi[k] = (int)S.arow(u, F.tid & 255); }
#pragma unroll
                   for (int k = 0; k < GTAB_UNITS / 2; ++k) { const int i = 2 * k + (F.tid >> 8); if (gi[k] >= 0) gtab[i * 256 + (F.tid & 255)] = gi[k]; } }
                 __syncthreads();
                 pg8::gemm_phase(F.lds, S); } SEAM(9);
    if (IN(10)) REP(10) { const LAS int* cnt = (const LAS int*)(F.lds + TAB_OFF);
                 MoeDown S{D / 2, D, (const char*)WSP(unsigned char, WS_H), (const char*)WSP(unsigned char, WS_WD), WSP(unsigned char, WS_O), F.in[I_BDOWN], cnt + 32, F.G, F.bid};
                 pg8::gemm_phase(F.lds, S); } SEAM(10);
    if (IN(11)) { p10_final(F); }
#undef IN
#undef SEAM
}

extern "C" void kernel_launch(void* const* d_in, const int* in_sizes, int n_in, void* d_out, int out_size, void* d_ws, size_t ws_size, hipStream_t stream) {
    static int grid = 0;
    if (grid == 0) {
        if (n_in != 27 || out_size != ML * D || ws_size < WS_END) { fprintf(stderr, "kernel_launch: unexpected problem (n_in %d, out %d, ws %zu < %zu)\n", n_in, out_size, ws_size, (size_t)WS_END); grid = -1; return; }
        int dev = 0, cus = 0, per_cu = 0;
        if (hipGetDevice(&dev) != hipSuccess || hipDeviceGetAttribute(&cus, hipDeviceAttributeMultiprocessorCount, dev) != hipSuccess) { grid = -1; return; }
        if (hipFuncSetAttribute((const void*)fwd_kernel, hipFuncAttributeMaxDynamicSharedMemorySize, LDS_BYTES) != hipSuccess) { fprintf(stderr, "kernel_launch: hipFuncSetAttribute failed\n"); grid = -1; return; }
        if (hipOccupancyMaxActiveBlocksPerMultiprocessor(&per_cu, (const void*)fwd_kernel, 512, LDS_BYTES) != hipSuccess || per_cu < 1) { fprintf(stderr, "kernel_launch: occupancy query says %d\n", per_cu); }
        (void)hipGetLastError();
        grid = cus;
    }
    if (grid < 0) return;
    if (hipMemsetAsync((char*)d_ws + WS_CTL, 0, CTL_BYTES, stream) != hipSuccess) return;
    Args a{};
    for (int i = 0; i < 27; ++i) a.in[i] = (const float*)d_in[i];
    a.out = (float*)d_out; a.ws = (unsigned char*)d_ws; a.pad = 0;
#if MK_N_LAUNCHES == 1
    a.ph_lo = 0; a.ph_hi = NPHASE; a.li = 0;
    hipLaunchKernelGGL(fwd_kernel, dim3(grid), dim3(512), LDS_BYTES, stream, a);
#else
    for (int p = 0; p < NPHASE; ++p) { a.ph_lo = p; a.ph_hi = p + 1; a.li = 0; hipLaunchKernelGGL(fwd_kernel, dim3(grid), dim3(512), LDS_BYTES, stream, a); }
#endif
}
```
